# Optimizing an MI355X kernel written in HIP

```python
import jax, jax.numpy as jnp
from jax import lax
import numpy as np

D_MODEL = 1024
BATCH = 32
SEQ = 2048
DEPTH = 4

GRID_W = 64
CTX_LEN = 256
HEAD_DIM = 64
ATTN_W = D_MODEL // 2
N_Q_HEADS = ATTN_W // HEAD_DIM
N_KV_HEADS = N_Q_HEADS // 4
Q_PER_KV = N_Q_HEADS // N_KV_HEADS
KV_W = N_KV_HEADS * HEAD_DIM
POOL_W = D_MODEL // 4
POOL_WINDOWS = (2, 4, 8, 16)
N_POOL_GROUPS = len(POOL_WINDOWS)
POOL_GROUP_W = POOL_W // N_POOL_GROUPS
FFT_W = D_MODEL // 4
N_FFT_GROUPS = 4
FFT_GROUP_W = FFT_W // N_FFT_GROUPS
MIX_W = ATTN_W + POOL_W + FFT_W
IN_W = ATTN_W + 2 * KV_W + POOL_W + FFT_W
D_FF = ((8 * D_MODEL // 3 + 127) // 128) * 128
ROPE_THETA = 10000.0
Q_BLOCK = 128
N_MOD = 9
EPS = 1e-6
ATTN_SCALE = HEAD_DIM ** -0.5

kernel_name = 'hybrid_attn_pool_fourier_dit_block'


def rms_norm(x):
    xf = x.astype(jnp.float32)
    return (xf * lax.rsqrt(jnp.mean(xf * xf, axis=-1, keepdims=True) + EPS)).astype(x.dtype)


def modulate(h, shift, scale):
    return h * (1 + scale[:, None, :]) + shift[:, None, :]


def swiglu(h, w_gu, w_down):
    g, u = jnp.split(h @ w_gu, 2, axis=-1)
    return (jax.nn.silu(g) * u) @ w_down


def axial_rope_tables(length):
    rows = length // GRID_W
    row = jnp.repeat(jnp.arange(rows), GRID_W).astype(jnp.float32)
    col = jnp.tile(jnp.arange(GRID_W), rows).astype(jnp.float32)
    n_freq = HEAD_DIM // 4
    inv_freq = ROPE_THETA ** (-jnp.arange(n_freq, dtype=jnp.float32) / n_freq)
    ang = jnp.concatenate([row[:, None] * inv_freq, col[:, None] * inv_freq], axis=-1)
    return jnp.cos(ang), jnp.sin(ang)


def apply_rope(x, cos, sin):
    shape = (1, cos.shape[0]) + (1,) * (x.ndim - 3) + (cos.shape[1],)
    cos = cos.reshape(shape).astype(x.dtype)
    sin = sin.reshape(shape).astype(x.dtype)
    half = HEAD_DIM // 2
    x1, x2 = x[..., :half], x[..., half:]
    return jnp.concatenate([x1 * cos - x2 * sin, x1 * sin + x2 * cos], axis=-1)


def split_in(z):
    b = [ATTN_W, ATTN_W + KV_W, ATTN_W + 2 * KV_W, ATTN_W + 2 * KV_W + POOL_W]
    return jnp.split(z, b, axis=-1)


def q_heads(q, gain):
    q = q.reshape(q.shape[:2] + (N_KV_HEADS, Q_PER_KV, HEAD_DIM))
    return rms_norm(q) * gain


def kv_heads(t):
    return t.reshape(t.shape[:2] + (N_KV_HEADS, HEAD_DIM))


def attend_latent(q, k, v, k_ctx, v_ctx):
    k_all = jnp.concatenate([k, k_ctx], axis=1)
    v_all = jnp.concatenate([v, v_ctx], axis=1)
    bsz, length = q.shape[:2]
    n_blk = length // Q_BLOCK
    qb = q.reshape((bsz, n_blk, Q_BLOCK) + q.shape[2:]).transpose(1, 0, 2, 3, 4, 5)

    def one_block(q_blk):
        s = jnp.einsum('bqkgd,bskd->bkgqs', q_blk, k_all).astype(jnp.float32) * ATTN_SCALE
        p = jax.nn.softmax(s, axis=-1).astype(v_all.dtype)
        return jnp.einsum('bkgqs,bskd->bqkgd', p, v_all)

    o = lax.map(one_block, qb)
    return o.transpose(1, 0, 2, 3, 4, 5).reshape(bsz, length, ATTN_W)


def attend_context(q, k, v):
    s = jnp.einsum('bqkgd,bskd->bkgqs', q, k).astype(jnp.float32) * ATTN_SCALE
    p = jax.nn.softmax(s, axis=-1).astype(v.dtype)
    o = jnp.einsum('bkgqs,bskd->bqkgd', p, v)
    return o.reshape(q.shape[0], q.shape[1], ATTN_W)


def pool_minus_self(u):
    bsz, length, _ = u.shape
    ug = u.reshape(bsz, length, N_POOL_GROUPS, POOL_GROUP_W).astype(jnp.float32)
    cs = jnp.cumsum(ug, axis=1)
    cs = jnp.concatenate([jnp.zeros_like(cs[:, :1]), cs], axis=1)
    t = jnp.arange(length)
    means = []
    for g, w in enumerate(POOL_WINDOWS):
        lo = jnp.clip(t - w // 2, 0, length)
        hi = jnp.clip(t + w - w // 2, 0, length)
        cs_g = cs[:, :, g]
        s = jnp.take(cs_g, hi, axis=1) - jnp.take(cs_g, lo, axis=1)
        cnt = (hi - lo).astype(jnp.float32)[None, :, None]
        means.append(s / cnt)
    mean = jnp.stack(means, axis=2)
    return (mean - ug).astype(u.dtype)


def fourier_2d(u):
    bsz, length, _ = u.shape
    ug = u.reshape(bsz, length, N_FFT_GROUPS, FFT_GROUP_W).astype(jnp.float32)
    f = jnp.fft.fft2(ug, axes=(1, 3), norm='ortho').real
    return f.reshape(bsz, length, FFT_W).astype(u.dtype)


def merge_mixers(attn_out, u_pool, u_fft, pool_w_l, pool_scale_l, fft_w_l, w_out_l):
    bsz, length, _ = u_pool.shape
    yp = jnp.einsum('blgc,gcd->blgd', pool_minus_self(u_pool), pool_w_l).reshape(bsz, length, POOL_W) * pool_scale_l
    yf = fourier_2d(u_fft) @ fft_w_l
    return jnp.concatenate([attn_out, yp, yf], axis=-1) @ w_out_l


def setup_inputs(seed: int = 0) -> dict:
    key = jax.random.key(seed)
    ks = jax.random.split(key, 20)

    def nrm(k, shape, std):
        return jax.random.normal(k, shape, jnp.float32) * std

    return {
        'x': nrm(ks[0], (BATCH, SEQ, D_MODEL), 1.0),
        'c': nrm(ks[1], (BATCH, D_MODEL), 1.0),
        'ctx': nrm(ks[2], (BATCH, CTX_LEN, D_MODEL), 1.0),
        'c_ctx': nrm(ks[3], (D_MODEL,), 1.0),
        'ada_w': nrm(ks[4], (DEPTH, D_MODEL, N_MOD * D_MODEL), 0.5 * D_MODEL ** -0.5),
        'ada_b': nrm(ks[5], (DEPTH, N_MOD * D_MODEL), 0.01),
        'ffn1_w_gu': nrm(ks[6], (DEPTH, D_MODEL, 2 * D_FF), D_MODEL ** -0.5),
        'ffn1_w_down': nrm(ks[7], (DEPTH, D_FF, D_MODEL), D_FF ** -0.5),
        'w_in': nrm(ks[8], (DEPTH, D_MODEL, IN_W), D_MODEL ** -0.5),
        'q_gain': 1.0 + nrm(ks[9], (DEPTH, HEAD_DIM), 0.1),
        'k_gain': 1.0 + nrm(ks[10], (DEPTH, HEAD_DIM), 0.1),
        'pool_w': nrm(ks[11], (DEPTH, N_POOL_GROUPS, POOL_GROUP_W, POOL_GROUP_W), POOL_GROUP_W ** -0.5),
        'pool_scale': 1.0 + nrm(ks[12], (DEPTH, POOL_W), 0.1),
        'fft_w': nrm(ks[13], (DEPTH, FFT_W, FFT_W), FFT_W ** -0.5),
        'w_out': nrm(ks[14], (DEPTH, MIX_W, D_MODEL), MIX_W ** -0.5),
        'ffn2_w_gu': nrm(ks[15], (DEPTH, D_MODEL, 2 * D_FF), D_MODEL ** -0.5),
        'ffn2_w_down': nrm(ks[16], (DEPTH, D_FF, D_MODEL), D_FF ** -0.5),
        'final_gain': 1.0 + nrm(ks[17], (D_MODEL,), 0.1),
    }


def reference(x, c, ctx, c_ctx, ada_w, ada_b, ffn1_w_gu, ffn1_w_down, w_in, q_gain, k_gain,
              pool_w, pool_scale, fft_w, w_out, ffn2_w_gu, ffn2_w_down, final_gain):
    cos, sin = axial_rope_tables(x.shape[1])
    for layer in range(DEPTH):
        last = layer == DEPTH - 1
        mx = jnp.split(jax.nn.silu(c) @ ada_w[layer] + ada_b[layer], N_MOD, axis=-1)
        mc = jnp.split((jax.nn.silu(c_ctx) @ ada_w[layer] + ada_b[layer])[None, :], N_MOD, axis=-1)

        x = x + 0.5 * mx[2][:, None] * swiglu(modulate(rms_norm(x), mx[0], mx[1]), ffn1_w_gu[layer], ffn1_w_down[layer])
        ctx = ctx + 0.5 * mc[2][:, None] * swiglu(modulate(rms_norm(ctx), mc[0], mc[1]), ffn1_w_gu[layer], ffn1_w_down[layer])

        hx = modulate(rms_norm(x), mx[3], mx[4])
        hc = modulate(rms_norm(ctx), mc[3], mc[4])
        if last:
            kc, vc = jnp.split(hc @ w_in[layer, :, ATTN_W:ATTN_W + 2 * KV_W], 2, axis=-1)
        else:
            qc, kc, vc, upc, ufc = split_in(hc @ w_in[layer])
        kc = rms_norm(kv_heads(kc)) * k_gain[layer]
        vc = kv_heads(vc)

        qx, kx, vx, upx, ufx = split_in(hx @ w_in[layer])
        qx = apply_rope(q_heads(qx, q_gain[layer]), cos, sin)
        kx = apply_rope(rms_norm(kv_heads(kx)) * k_gain[layer], cos, sin)
        vx = kv_heads(vx)
        ax = attend_latent(qx, kx, vx, kc, vc)
        x = x + mx[5][:, None] * merge_mixers(ax, upx, ufx, pool_w[layer], pool_scale[layer], fft_w[layer], w_out[layer])

        x = x + 0.5 * mx[8][:, None] * swiglu(modulate(rms_norm(x), mx[6], mx[7]), ffn2_w_gu[layer], ffn2_w_down[layer])

        if not last:
            ac = attend_context(q_heads(qc, q_gain[layer]), kc, vc)
            ctx = ctx + mc[5][:, None] * merge_mixers(ac, upc, ufc, pool_w[layer], pool_scale[layer], fft_w[layer], w_out[layer])
            ctx = ctx + 0.5 * mc[8][:, None] * swiglu(modulate(rms_norm(ctx), mc[6], mc[7]), ffn2_w_gu[layer], ffn2_w_down[layer])

    return rms_norm(x) * final_gain
```

```cpp
#include <hip/hip_runtime.h>
#include <hip/hip_cooperative_groups.h>
#include <hip/hip_bf16.h>
#include <cstdio>
#include <cstdint>
#include <cmath>
namespace cg = cooperative_groups;
constexpr int NLAT = 65536, NCTX = 8192, NROW = NLAT + NCTX, DMODEL = 1024, DFF = 2816, MODW = 9216, KVROWS = 2304;
constexpr float QC2 = 0.125f * 1.4426950408889634f;
__device__ __forceinline__ int fresh_tid() { int t = threadIdx.x; asm volatile("" : "+v"(t)); return t; }
namespace pg8 {
#define PG8_LAS __attribute__((address_space(3)))
typedef unsigned short bf16_t;
typedef short bf16x8 __attribute__((ext_vector_type(8)));
typedef float f32x4 __attribute__((ext_vector_type(4)));
typedef unsigned u32x4 __attribute__((ext_vector_type(4)));
constexpr int BM = 256, BK = 64, HALF = 128, HTB = HALF * BK * 2  , STAGE_BYTES = 8 * HTB, NXCD = 8, WGM = 8;

__host__ __device__ __forceinline__ int lds_byte(int r, int c) { const int st = (r >> 4) * 2 + (c >> 5), rr = r & 15, cc = c & 31, ob = rr * 64 + cc * 2; return st * 1024 + (ob ^ (((ob >> 9) & 1) << 5)); }
__host__ __device__ __forceinline__ void stage_rc(int b, int& R, int& C) { const int st = b / 1024, sb = b % 1024, swz = sb ^ (((sb >> 9) & 1) << 5); R = (st >> 1) * 16 + swz / 64; C = (st & 1) * 32 + (swz % 64) / 2; }
__host__ __device__ __forceinline__ int perm32(int rho) { const int n = rho >> 4, i = rho & 15; return 8 * (i >> 2) + 4 * n + (i & 3); }

struct Unit { int pm, pn; };
struct Gemm { const bf16_t* A; const bf16_t* Bt; int M, N, K; };

struct StaticOrder {
    int nM, nN, nwg, G, c;
    __host__ __device__ void init(int M, int N, int G_, int c_) { nM = M / BM; nN = N / BM; nwg = nM * nN; G = G_; c = c_; }
    __host__ __device__ bool next(int i, Unit& u) const {
        const long L = (long)i * G + c; if (L >= nwg) return false;
        int wgid = (int)L; { const int q = nwg / NXCD, r = nwg % NXCD, xcd = wgid % NXCD, off = wgid / NXCD; wgid = (xcd < r ? xcd * (q + 1) : r * (q + 1) + (xcd - r) * q) + off; }
        const int nig = WGM * nN, gid = wgid / nig, fm = gid * WGM, gsz = (nM - fm) < WGM ? (nM - fm) : WGM;
        u.pm = fm + ((wgid % nig) % gsz); u.pn = (wgid % nig) / gsz; return true;
    }
    __device__ __forceinline__ void a_ready(const Unit&) const {}
    __device__ __forceinline__ void done(const Unit&) const {}
};

__device__ __forceinline__ unsigned cvt_pk_bf16(float lo, float hi) { unsigned r; asm volatile("v_cvt_pk_bf16_f32 %0, %1, %2" : "=v"(r) : "v"(lo), "v"(hi)); return r; }
typedef float f32x2 __attribute__((ext_vector_type(2)));
__device__ __forceinline__ unsigned f2bf1(float f) { unsigned u = __builtin_bit_cast(unsigned, f); return (u + 0x7fffu + ((u >> 16) & 1u)) >> 16; }
__device__ __forceinline__ float silu_f(float g) { return g * __builtin_amdgcn_rcpf(1.0f + __expf(-g)); }
struct EpiGU {
    static constexpr bool PERM = true, AFTER_DRAIN = false;
    bf16_t* H;
    __device__ __forceinline__ void operator()(const f32x4 (&acc)[2][2][4][2], const Unit& u, int wr, int wc, int fr, int fq) const {
        const int row0 = u.pm * BM + wr * 64 + fr, col0 = u.pn * 128 + wc * 32 + 8 * fq;
#pragma unroll
        for (int ai = 0; ai < 2; ++ai)
#pragma unroll
            for (int m = 0; m < 4; ++m) {
                bf16_t* p = H + (size_t)(row0 + ai * HALF + m * 16) * DFF + col0;
                const f32x4 g0 = acc[ai][0][m][0], g1 = acc[ai][0][m][1], u0 = acc[ai][1][m][0], u1 = acc[ai][1][m][1];
                u32x4 w;
                w.x = cvt_pk_bf16(silu_f(g0[0]) * u0[0], silu_f(g0[1]) * u0[1]); w.y = cvt_pk_bf16(silu_f(g0[2]) * u0[2], silu_f(g0[3]) * u0[3]);
                w.z = cvt_pk_bf16(silu_f(g1[0]) * u1[0], silu_f(g1[1]) * u1[1]); w.w = cvt_pk_bf16(silu_f(g1[2]) * u1[2], silu_f(g1[3]) * u1[3]);
                *(u32x4*)p = w;
            }
    }
};
struct EpiRes {
    static constexpr bool PERM = false, AFTER_DRAIN = false;
    const float* resL; const float* resC; float* outL; float* outC; const float* gate; float gs;
    __device__ __forceinline__ void operator()(const f32x4 (&acc)[2][2][4][2], const Unit& u, int wr, int wc, int fr, int fq) const {
        const int pm = u.pm; const bool lat = pm < 256;
        const float* rb = lat ? resL + (size_t)pm * BM * DMODEL : resC + (size_t)(pm - 256) * BM * DMODEL;
        float* ob = lat ? outL + (size_t)pm * BM * DMODEL : outC + (size_t)(pm - 256) * BM * DMODEL;
        const int b = lat ? (pm >> 3) : 32;
        const float* gp = gate + (size_t)b * MODW;
        const int rl = wr * 64 + fr, col0 = u.pn * BM + wc * 32 + 4 * fq;
        f32x4 gv[2][2];
#pragma unroll
        for (int bj = 0; bj < 2; ++bj)
#pragma unroll
            for (int n = 0; n < 2; ++n) gv[bj][n] = *(const f32x4*)(gp + col0 + bj * HALF + n * 16) * gs;
#pragma unroll
        for (int ai = 0; ai < 2; ++ai)
#pragma unroll
            for (int m = 0; m < 4; ++m) { const size_t off = (size_t)(rl + ai * HALF + m * 16) * DMODEL + col0;
#pragma unroll
                for (int bj = 0; bj < 2; ++bj)
#pragma unroll
                    for (int n = 0; n < 2; ++n) { const f32x4 r = *(const f32x4*)(rb + off + bj * HALF + n * 16); const f32x4 o = r + gv[bj][n] * acc[ai][bj][m][n]; *(f32x4*)(ob + off + bj * HALF + n * 16) = o; } }
    }
};
struct EpiIN {
    static constexpr bool PERM = true, AFTER_DRAIN = false;
    bf16_t *Q, *Kb, *Vb, *UP, *VT, *VTC; const float *qg, *kg, *ropeC, *ropeS;
    __device__ __forceinline__ void operator()(const f32x4 (&acc)[2][2][4][2], const Unit& u, int wr, int wc, int fr, int fq) const {
        const int pn = u.pn, pm = u.pm; const bool lat = pm < 256;
        const int rbase = pm * BM + wr * 64 + fr;
        if (pn <= 2) {
            if (pn == 2 && wc >= 2) {
#pragma unroll
                for (int ai = 0; ai < 2; ++ai)
#pragma unroll
                    for (int m = 0; m < 4; ++m) { const int row = rbase + ai * HALF + m * 16;
                        const int kvrow = lat ? (row >> 11) * KVROWS + (row & 2047) : ((row - NLAT) >> 8) * KVROWS + 2048 + (row & 255);
                        bf16_t* p = Vb + (size_t)kvrow * 128 + (wc - 2) * 64 + 8 * fq;
#pragma unroll
                        for (int bj = 0; bj < 2; ++bj) { const f32x4 a = acc[ai][bj][m][0], c = acc[ai][bj][m][1]; u32x4 w; w.x = cvt_pk_bf16(a[0], a[1]); w.y = cvt_pk_bf16(a[2], a[3]); w.z = cvt_pk_bf16(c[0], c[1]); w.w = cvt_pk_bf16(c[2], c[3]); *(u32x4*)(p + 32 * bj) = w; } }
            } else {
                const bool isq = pn < 2; const float* gp = isq ? qg : kg; const float osc = isq ? QC2 : 1.0f;
                f32x4 gn[2][2];
#pragma unroll
                for (int bj = 0; bj < 2; ++bj)
#pragma unroll
                    for (int n = 0; n < 2; ++n) gn[bj][n] = *(const f32x4*)(gp + 32 * bj + 8 * fq + 4 * n);
#pragma unroll
                for (int ai = 0; ai < 2; ++ai)
#pragma unroll
                    for (int m = 0; m < 4; ++m) { const int row = rbase + ai * HALF + m * 16;
                        float ss = 0.f;
#pragma unroll
                        for (int bj = 0; bj < 2; ++bj)
#pragma unroll
                            for (int n = 0; n < 2; ++n) { const f32x4 x = acc[ai][bj][m][n]; ss += (x[0] * x[0] + x[1] * x[1]) + (x[2] * x[2] + x[3] * x[3]); }
                        ss += __shfl_xor(ss, 16); ss += __shfl_xor(ss, 32);
                        const float rstd = 1.0f / sqrtf(ss * (1.0f / 64.0f) + 1e-6f);
                        f32x4 o1[2], o2[2];
#pragma unroll
                        for (int n = 0; n < 2; ++n) { o1[n] = acc[ai][0][m][n] * rstd * gn[0][n]; o2[n] = acc[ai][1][m][n] * rstd * gn[1][n]; }
                        if (lat) { const int t = row & 2047;
#pragma unroll
                            for (int n = 0; n < 2; ++n) { const f32x4 c = *(const f32x4*)(ropeC + t * 32 + 8 * fq + 4 * n), s = *(const f32x4*)(ropeS + t * 32 + 8 * fq + 4 * n);
                                const f32x4 a = o1[n] * c - o2[n] * s, bq = o1[n] * s + o2[n] * c; o1[n] = a; o2[n] = bq; } }
                        bf16_t* p;
                        if (isq) p = Q + (size_t)row * 512 + (4 * pn + wc) * 64 + 8 * fq;
                        else { const int kvrow = lat ? (row >> 11) * KVROWS + (row & 2047) : ((row - NLAT) >> 8) * KVROWS + 2048 + (row & 255); p = Kb + (size_t)kvrow * 128 + wc * 64 + 8 * fq; }
                        u32x4 w;
                        w.x = cvt_pk_bf16(o1[0][0] * osc, o1[0][1] * osc); w.y = cvt_pk_bf16(o1[0][2] * osc, o1[0][3] * osc); w.z = cvt_pk_bf16(o1[1][0] * osc, o1[1][1] * osc); w.w = cvt_pk_bf16(o1[1][2] * osc, o1[1][3] * osc);
                        *(u32x4*)p = w;
                        w.x = cvt_pk_bf16(o2[0][0] * osc, o2[0][1] * osc); w.y = cvt_pk_bf16(o2[0][2] * osc, o2[0][3] * osc); w.z = cvt_pk_bf16(o2[1][0] * osc, o2[1][1] * osc); w.w = cvt_pk_bf16(o2[1][2] * osc, o2[1][3] * osc);
                        *(u32x4*)(p + 32) = w; }
            }
        } else if (pn == 3) {
#pragma unroll
            for (int ai = 0; ai < 2; ++ai)
#pragma unroll
                for (int m = 0; m < 4; ++m) { const int row = rbase + ai * HALF + m * 16; bf16_t* p = UP + (size_t)row * 256 + wc * 32 + 8 * fq;
#pragma unroll
                    for (int bj = 0; bj < 2; ++bj) { const f32x4 a = acc[ai][bj][m][0], c = acc[ai][bj][m][1]; u32x4 w; w.x = cvt_pk_bf16(a[0], a[1]); w.y = cvt_pk_bf16(a[2], a[3]); w.z = cvt_pk_bf16(c[0], c[1]); w.w = cvt_pk_bf16(c[2], c[3]); *(u32x4*)(p + HALF * bj) = w; } }
        } else {
            const int half = pn - 4;
#pragma unroll
            for (int ai = 0; ai < 2; ++ai)
#pragma unroll
                for (int m = 0; m < 4; ++m) { const int row = rbase + ai * HALF + m * 16;
                    if (lat) { const int b = row >> 11, t = row & 2047; bf16_t* p = VT + ((size_t)b * 256 + 32 * wc + 8 * fq) * 4096 + half * 2048 + t; asm volatile("" : "+v"(p)); __attribute__((address_space(1))) bf16_t* gp = (__attribute__((address_space(1))) bf16_t*)p;
#pragma unroll
                        for (int bj = 0; bj < 2; ++bj)
#pragma unroll
                            for (int n = 0; n < 2; ++n)
#pragma unroll
                                for (int e = 0; e < 4; ++e) gp[(size_t)(128 * bj + 4 * n + e) * 4096] = (bf16_t)f2bf1(acc[ai][bj][m][n][e]); }
                    else { const int b = (row - NLAT) >> 8, t = row & 255; bf16_t* p = VTC + ((size_t)b * 256 + 32 * wc + 8 * fq) * 512 + half * 256 + t; asm volatile("" : "+v"(p)); __attribute__((address_space(1))) bf16_t* gp = (__attribute__((address_space(1))) bf16_t*)p;
#pragma unroll
                        for (int bj = 0; bj < 2; ++bj)
#pragma unroll
                            for (int n = 0; n < 2; ++n)
#pragma unroll
                                for (int e = 0; e < 4; ++e) gp[(size_t)(128 * bj + 4 * n + e) * 512] = (bf16_t)f2bf1(acc[ai][bj][m][n][e]); } }
        }
    }
};
struct EpiDFT {
    static constexpr bool PERM = true, AFTER_DRAIN = false;
    bf16_t* AM; int rowbase, L; float sc;
    __device__ __forceinline__ void operator()(const f32x4 (&acc)[2][2][4][2], const Unit& u, int wr, int wc, int fr, int fq) const {
        const int r0 = rowbase + u.pn * L + u.pm * BM + wr * 64 + fr;
#pragma unroll
        for (int ai = 0; ai < 2; ++ai)
#pragma unroll
            for (int m = 0; m < 4; ++m) { bf16_t* p = AM + (size_t)(r0 + ai * HALF + m * 16) * DMODEL + 768 + wc * 32 + 8 * fq;
#pragma unroll
                for (int bj = 0; bj < 2; ++bj) { const f32x4 a = acc[ai][bj][m][0] * sc, c = acc[ai][bj][m][1] * sc; u32x4 w; w.x = cvt_pk_bf16(a[0], a[1]); w.y = cvt_pk_bf16(a[2], a[3]); w.z = cvt_pk_bf16(c[0], c[1]); w.w = cvt_pk_bf16(c[2], c[3]); *(u32x4*)(p + HALF * bj) = w; } }
    }
};
template <class Epi, class Sched, bool ALIGN_EPI = false, bool SP2 = false>
__device__ __forceinline__ void gemm_phase(PG8_LAS unsigned char* lds, const Gemm g, const Sched& S, const Epi& E) {
    const int tid = fresh_tid(), wid = __builtin_amdgcn_readfirstlane(tid >> 6), lane = tid & 63, wr = wid >> 2, wc = wid & 3, fr = lane & 15, fq = lane >> 4;
    const int K = g.K, nt = K / BK;
    unsigned voffA[2], voffB[2];
#pragma unroll
    for (int i = 0; i < 2; ++i) { int R, C; stage_rc(tid * 16 + i * 8192, R, C); const int Rb = Epi::PERM ? ((R & ~31) + perm32(R & 31)) : R;
        voffA[i] = (unsigned)(R * K + C) * 2u; voffB[i] = (unsigned)(Rb * K + C) * 2u; }
    const size_t kstep = (size_t)(BK * 2);
    const size_t hstep = (size_t)HALF * K * 2;
    const size_t tstep = 2 * hstep;
    const unsigned ldsw = (unsigned)wid * 1024u;
    const int aoff = lds_byte(wr * 64 + fr, fq * 8), boff = lds_byte(wc * 32 + fr, fq * 8);
#define PG8_SA(b, h) (((b) * 2 + (h)) * HTB)
#define PG8_SB(b, h) ((4 + (b) * 2 + (h)) * HTB)
#define PG8_STAGE(bufoff, gbase, voff) do { _Pragma("unroll") for (int _i = 0; _i < 2; ++_i) \
        __builtin_amdgcn_global_load_lds((const unsigned*)((const char*)(gbase) + (voff)[_i]), (PG8_LAS unsigned*)(lds + (bufoff) + ldsw + _i * 8192), 16, 0, 0); } while (0)
#define PG8_LDA(dst, b, h) do { _Pragma("unroll") for (int m = 0; m < 4; ++m) _Pragma("unroll") for (int k = 0; k < 2; ++k) dst[m][k] = *(const PG8_LAS bf16x8*)(lds + PG8_SA(b, h) + aoff + m * 2048 + k * 1024); } while (0)
#define PG8_LDB(dst, b, h) do { _Pragma("unroll") for (int n = 0; n < 2; ++n) _Pragma("unroll") for (int k = 0; k < 2; ++k) dst[n][k] = *(const PG8_LAS bf16x8*)(lds + PG8_SB(b, h) + boff + n * 2048 + k * 1024); } while (0)
#define PG8_MMA(ai, bj, At, Bt) do { __builtin_amdgcn_s_setprio(1); _Pragma("unroll") for (int m = 0; m < 4; ++m) _Pragma("unroll") for (int n = 0; n < 2; ++n) _Pragma("unroll") for (int k = 0; k < 2; ++k) \
        acc[ai][bj][m][n] = __builtin_amdgcn_mfma_f32_16x16x32_bf16(Bt[n][k], At[m][k], acc[ai][bj][m][n], 0, 0, 0); __builtin_amdgcn_s_setprio(0); } while (0)
#define PG8_WAIT_V(n) asm volatile("s_waitcnt vmcnt(" #n ")" ::: "memory")
#define PG8_WAIT_L(n) asm volatile("s_waitcnt lgkmcnt(" #n ")" ::: "memory")
#define PG8_BAR __builtin_amdgcn_s_barrier()
#define PG8_SCHED __builtin_amdgcn_sched_barrier(0)
    Unit cur, nxt; int ui = 0;
    if (!S.next(0, cur)) return;
    f32x4 acc[2][2][4][2];
#pragma unroll
    for (int a = 0; a < 2; ++a)
#pragma unroll
        for (int b = 0; b < 2; ++b)
#pragma unroll
            for (int m = 0; m < 4; ++m)
#pragma unroll
                for (int n = 0; n < 2; ++n) acc[a][b][m][n] = (f32x4){0.f, 0.f, 0.f, 0.f};
    bf16x8 At[4][2], B0[2][2], B1[2][2];
    const char* cA = (const char*)g.A + (size_t)cur.pm * tstep; const char* cB = (const char*)g.Bt + (size_t)cur.pn * tstep;
    S.a_ready(cur);
    if constexpr (SP2) {
        PG8_STAGE(PG8_SB(0, 0), cB, voffB); PG8_STAGE(PG8_SB(0, 1), cB + hstep, voffB); PG8_STAGE(PG8_SA(0, 0), cA, voffA); PG8_STAGE(PG8_SA(0, 1), cA + hstep, voffA);
        if (wr == 1) PG8_BAR;
        PG8_WAIT_V(2); PG8_BAR;
        PG8_STAGE(PG8_SB(1, 0), cB + kstep, voffB); PG8_STAGE(PG8_SA(1, 0), cA + kstep, voffA); PG8_STAGE(PG8_SB(1, 1), cB + hstep + kstep, voffB);
        PG8_WAIT_V(6); PG8_BAR;
    } else {
        PG8_STAGE(PG8_SB(0, 0), cB, voffB); PG8_STAGE(PG8_SA(0, 0), cA, voffA); PG8_STAGE(PG8_SB(0, 1), cB + hstep, voffB); PG8_STAGE(PG8_SA(0, 1), cA + hstep, voffA);
        if (wr == 1) PG8_BAR;
        PG8_WAIT_V(4); PG8_BAR;
        PG8_STAGE(PG8_SB(1, 0), cB + kstep, voffB); PG8_STAGE(PG8_SA(1, 0), cA + kstep, voffA); PG8_STAGE(PG8_SB(1, 1), cB + hstep + kstep, voffB);
        PG8_WAIT_V(6); PG8_BAR;
    }
    for (;;) {
        const bool has_next = S.next(ui + 1, nxt);
        const char* nA = has_next ? (const char*)g.A + (size_t)nxt.pm * tstep : cA; const char* nB = has_next ? (const char*)g.Bt + (size_t)nxt.pn * tstep : cB;
        for (int t = 0; t < nt; t += 2) {
            const bool last = (t == nt - 2);
            const char* a1 = cA + (size_t)(t + 1) * kstep;
            const char* a2 = last ? nA : cA + (size_t)(t + 2) * kstep; const char* b2 = last ? nB : cB + (size_t)(t + 2) * kstep;
            const char* a3 = a2 + kstep; const char* b3 = b2 + kstep;
            if (last && has_next) S.a_ready(nxt);
            if constexpr (SP2) {
            PG8_LDB(B0, 0, 0); PG8_LDB(B1, 0, 1); PG8_SCHED; PG8_LDA(At, 0, 0); PG8_STAGE(PG8_SA(1, 1), a1 + hstep, voffA);
            PG8_WAIT_V(8); PG8_WAIT_L(0); PG8_BAR; PG8_MMA(0, 0, At, B0); PG8_MMA(0, 1, At, B1); PG8_BAR; PG8_SCHED;
            PG8_LDA(At, 0, 1); PG8_STAGE(PG8_SB(0, 0), b2, voffB); PG8_STAGE(PG8_SB(0, 1), b2 + hstep, voffB); PG8_STAGE(PG8_SA(0, 0), a2, voffA);
            PG8_WAIT_V(8); PG8_WAIT_L(0); PG8_BAR; PG8_MMA(1, 0, At, B0); PG8_MMA(1, 1, At, B1); PG8_BAR; PG8_SCHED;
            PG8_LDB(B0, 1, 0); PG8_LDB(B1, 1, 1); PG8_SCHED; PG8_LDA(At, 1, 0); PG8_STAGE(PG8_SA(0, 1), a2 + hstep, voffA);
            PG8_WAIT_V(8); PG8_WAIT_L(0); PG8_BAR; PG8_MMA(0, 0, At, B0); PG8_MMA(0, 1, At, B1); PG8_BAR; PG8_SCHED;
            PG8_LDA(At, 1, 1); PG8_STAGE(PG8_SB(1, 0), b3, voffB); PG8_STAGE(PG8_SB(1, 1), b3 + hstep, voffB); PG8_STAGE(PG8_SA(1, 0), a3, voffA);
            PG8_WAIT_V(8); PG8_WAIT_L(0); PG8_BAR; PG8_MMA(1, 0, At, B0); PG8_MMA(1, 1, At, B1); PG8_BAR; PG8_SCHED;
            } else {
            PG8_LDB(B0, 0, 0); PG8_SCHED; PG8_LDA(At, 0, 0); PG8_STAGE(PG8_SA(1, 1), a1 + hstep, voffA);
            PG8_WAIT_L(8); PG8_BAR; PG8_WAIT_L(0); PG8_MMA(0, 0, At, B0); PG8_BAR; PG8_SCHED;
            PG8_LDB(B1, 0, 1); PG8_STAGE(PG8_SB(0, 0), b2, voffB);
            PG8_BAR; PG8_WAIT_L(0); PG8_MMA(0, 1, At, B1); PG8_BAR;
            PG8_LDA(At, 0, 1); PG8_STAGE(PG8_SA(0, 0), a2, voffA);
            PG8_BAR; PG8_WAIT_L(0); PG8_MMA(1, 0, At, B0); PG8_BAR; PG8_SCHED;
            PG8_STAGE(PG8_SB(0, 1), b2 + hstep, voffB);
            PG8_WAIT_V(6); PG8_BAR; PG8_MMA(1, 1, At, B1); PG8_BAR;
            PG8_LDB(B0, 1, 0); PG8_SCHED; PG8_LDA(At, 1, 0); PG8_STAGE(PG8_SA(0, 1), a2 + hstep, voffA);
            PG8_WAIT_L(8); PG8_BAR; PG8_WAIT_L(0); PG8_MMA(0, 0, At, B0); PG8_BAR; PG8_SCHED;
            PG8_LDB(B1, 1, 1); PG8_STAGE(PG8_SB(1, 0), b3, voffB);
            PG8_BAR; PG8_WAIT_L(0); PG8_MMA(0, 1, At, B1); PG8_BAR;
            PG8_LDA(At, 1, 1); PG8_STAGE(PG8_SA(1, 0), a3, voffA);
            PG8_BAR; PG8_WAIT_L(0); PG8_MMA(1, 0, At, B0); PG8_BAR; PG8_SCHED;
            PG8_STAGE(PG8_SB(1, 1), b3 + hstep, voffB);
            PG8_WAIT_V(6); PG8_BAR; PG8_MMA(1, 1, At, B1); PG8_BAR;
            }
        }
        if constexpr (ALIGN_EPI) { if (wr == 0) PG8_BAR; }
        if constexpr (!Epi::AFTER_DRAIN) { E(acc, cur, wr, wc, fr, fq); S.done(cur); }
        if (!has_next) break;
#pragma unroll
        for (int a = 0; a < 2; ++a)
#pragma unroll
            for (int b = 0; b < 2; ++b)
#pragma unroll
                for (int m = 0; m < 4; ++m)
#pragma unroll
                    for (int n = 0; n < 2; ++n) acc[a][b][m][n] = (f32x4){0.f, 0.f, 0.f, 0.f};
        cur = nxt; cA = nA; cB = nB; ++ui;
        if constexpr (ALIGN_EPI) { if (wr == 1) PG8_BAR; }
    }
    PG8_WAIT_V(0);
    if constexpr (!ALIGN_EPI) { if (wr == 0) PG8_BAR; }
    PG8_BAR;
    if constexpr (Epi::AFTER_DRAIN) { E.fused(acc, cur, wr, wc, fr, fq, lds, wid, lane); S.done(cur); }
#undef PG8_SA
#undef PG8_SB
#undef PG8_STAGE
#undef PG8_LDA
#undef PG8_LDB
#undef PG8_MMA
#undef PG8_WAIT_V
#undef PG8_WAIT_L
#undef PG8_BAR
#undef PG8_SCHED
}
}
#include <hip/hip_bf16.h>
#include <cmath>
namespace attn_body {
using bf16=__hip_bfloat16;
using bf16x8=__attribute__((ext_vector_type(8)))short;
using s16x4=__attribute__((ext_vector_type(4)))short;
using f32x16=__attribute__((ext_vector_type(16)))float;
using u32x4=__attribute__((ext_vector_type(4)))unsigned;
constexpr int D=64,QP=512,KVP=128,OP=1024;
constexpr int NW=8,QBLK=32,QB=QBLK*NW,KVBLK=64;
__device__ __forceinline__ int crow(int r,int hi){return (r&3)+8*(r>>2)+4*hi;}
#define SBAR() __builtin_amdgcn_sched_barrier(0)
constexpr int NSLOT=3, SLOTB=8192;
constexpr int LDS_K=0, LDS_V=NSLOT*SLOTB, LDS_WS=2*NSLOT*SLOTB, LDS_OST=LDS_WS+NW*64*4, LDS_BYTES=LDS_OST+NW*4096;
constexpr float C2=0.125f*1.4426950408889634f;
__device__ __forceinline__ void glds16(const void*gsrc,unsigned lds_dst){unsigned keep;
  asm volatile("s_mov_b32 %0, m0\n\ts_mov_b32 m0, %2\n\ts_nop 0\n\tglobal_load_lds_dwordx4 %1, off\n\ts_mov_b32 m0, %0":"=&s"(keep):"v"(gsrc),"s"(lds_dst):"memory");}
__device__ __forceinline__ float max3f(float a,float b,float c){float r;asm("v_max3_f32 %0, %1, %2, %3":"=v"(r):"v"(a),"v"(b),"v"(c));return r;}
__device__ __forceinline__ float max2f(float a,float b){float r;asm("v_max_f32_e32 %0, %1, %2":"=v"(r):"v"(a),"v"(b));return r;}
__device__ __forceinline__ float fadd_s(float a,float b){float r;asm("v_add_f32_e32 %0, %1, %2":"=v"(r):"v"(a),"v"(b));return r;}
__device__ __forceinline__ float fsub_s(float a,float b){float r;asm("v_sub_f32_e32 %0, %1, %2":"=v"(r):"v"(a),"v"(b));return r;}
typedef float f32x2_t __attribute__((ext_vector_type(2))); typedef __bf16 bf16x2_t __attribute__((ext_vector_type(2)));
__device__ __forceinline__ unsigned cvtpk_s(float lo,float hi){f32x2_t v={lo,hi};bf16x2_t b=__builtin_convertvector(v,bf16x2_t);return __builtin_bit_cast(unsigned,b);}
#define WAIT_BAR(N) asm volatile("s_waitcnt vmcnt(" #N ") lgkmcnt(0)\n\ts_barrier":::"memory")

__device__ __forceinline__ void qkt(f32x16&p0,f32x16&p1,const char*Kslot,const bf16x8*qr,const f32x16&negm,int r32,int hi){
  const char*kb=Kslot+hi*1024+r32*16;
  #pragma unroll
  for(int d0=0;d0<4;++d0){
    const bf16x8 b0=*reinterpret_cast<const bf16x8*>(kb+d0*2048);
    const bf16x8 b1=*reinterpret_cast<const bf16x8*>(kb+d0*2048+512);
    if(d0==0){p0=__builtin_amdgcn_mfma_f32_32x32x16_bf16(b0,qr[0],negm,0,0,0);p1=__builtin_amdgcn_mfma_f32_32x32x16_bf16(b1,qr[0],negm,0,0,0);}
    else{p0=__builtin_amdgcn_mfma_f32_32x32x16_bf16(b0,qr[d0],p0,0,0,0);p1=__builtin_amdgcn_mfma_f32_32x32x16_bf16(b1,qr[d0],p1,0,0,0);}}
}
typedef __attribute__((address_space(3))) const char* lds_cptr;
typedef short v4i16_t __attribute__((ext_vector_type(4)));
__device__ __forceinline__ void kload8(bf16x8*kf,lds_cptr kp){
  kf[0]=*(const __attribute__((address_space(3))) bf16x8*)(kp);      kf[1]=*(const __attribute__((address_space(3))) bf16x8*)(kp+512);
  kf[2]=*(const __attribute__((address_space(3))) bf16x8*)(kp+2048); kf[3]=*(const __attribute__((address_space(3))) bf16x8*)(kp+2560);
  kf[4]=*(const __attribute__((address_space(3))) bf16x8*)(kp+4096); kf[5]=*(const __attribute__((address_space(3))) bf16x8*)(kp+4608);
  kf[6]=*(const __attribute__((address_space(3))) bf16x8*)(kp+6144); kf[7]=*(const __attribute__((address_space(3))) bf16x8*)(kp+6656);
}
__device__ __forceinline__ void kload2(bf16x8*kf,lds_cptr kp,int j){ kf[2*j]=*(const __attribute__((address_space(3))) bf16x8*)(kp+j*2048); kf[2*j+1]=*(const __attribute__((address_space(3))) bf16x8*)(kp+j*2048+512); }
__device__ __forceinline__ s16x4 vtr(lds_cptr p){ return __builtin_bit_cast(s16x4,__builtin_amdgcn_ds_read_tr16_b64_v4i16((__attribute__((address_space(3))) v4i16_t*)p)); }
__device__ __forceinline__ float rowmax(const f32x16&p0,const f32x16&p1){
  float a=max3f(p0[0],p0[1],p1[0]),b=max3f(p0[2],p0[3],p1[1]);a=max3f(a,p1[2],p1[3]);
  #pragma unroll
  for(int r=4;r<16;r+=4){a=max3f(a,p0[r],p0[r+1]);b=max3f(b,p0[r+2],p0[r+3]);a=max3f(a,p1[r],p1[r+1]);b=max3f(b,p1[r+2],p1[r+3]);}
  const float m=max2f(a,b);
  auto rr=__builtin_amdgcn_permlane32_swap(__float_as_uint(m),__float_as_uint(m),false,false);
  return max2f(__uint_as_float(rr[0]),__uint_as_float(rr[1]));
}
__device__ __forceinline__ void pv(f32x16*o,int vb,bf16x8 pa0,bf16x8 pa1,bf16x8 pa2,bf16x8 pa3){
  #pragma unroll
  for(int d0=0;d0<2;++d0){s16x4 lo[4],hi[4];
    #pragma unroll
    for(int ks=0;ks<4;++ks){
      asm volatile("ds_read_b64_tr_b16 %0,%1 offset:%c2":"=&v"(lo[ks]):"v"(vb),"i"(d0*4096+ks*1024):"memory");
      asm volatile("ds_read_b64_tr_b16 %0,%1 offset:%c2":"=&v"(hi[ks]):"v"(vb),"i"(d0*4096+ks*1024+512):"memory");}
    asm volatile("s_waitcnt lgkmcnt(0)":::"memory");SBAR();
    #define PK(k) (bf16x8){lo[k][0],lo[k][1],lo[k][2],lo[k][3],hi[k][0],hi[k][1],hi[k][2],hi[k][3]}
    o[d0]=__builtin_amdgcn_mfma_f32_32x32x16_bf16(pa0,PK(0),o[d0],0,0,0);
    o[d0]=__builtin_amdgcn_mfma_f32_32x32x16_bf16(pa1,PK(1),o[d0],0,0,0);
    o[d0]=__builtin_amdgcn_mfma_f32_32x32x16_bf16(pa2,PK(2),o[d0],0,0,0);
    o[d0]=__builtin_amdgcn_mfma_f32_32x32x16_bf16(pa3,PK(3),o[d0],0,0,0);
    #undef PK
  }
}

#ifndef ATTN_STORE16
#define ATTN_STORE16(p,v) (*(u32x4*)(p)=(v))
#endif
template<int THRL> __device__ __forceinline__ void attn_unit(const bf16*Qb,const bf16*Kh,const bf16*Vh,bf16*Ob,const int NT,char*shm){
  const int tid=fresh_tid(),lane=tid&63,r32=lane&31,hi=lane>>5; const int wid=__builtin_amdgcn_readfirstlane(tid>>6);
  const bf16*Qw=Qb+(long)(wid*QBLK)*QP;
  const unsigned lds0=(unsigned)(uintptr_t)shm;
  float*wsf=(float*)(shm+LDS_WS)+wid*64;
  const bf16*ksrc=Kh+(long)lane*KVP+wid*8;
  const bf16*vsrc=Vh+(long)(16*(wid&3)+(lane>>2))*KVP+(wid>>2)*32+(lane&3)*8;
  const unsigned kdst=lds0+LDS_K+wid*1024, vdst=lds0+LDS_V+wid*1024;
  #define DMA_K(t,slot) glds16(ksrc+(long)(t)*KVBLK*KVP,(unsigned)__builtin_amdgcn_readfirstlane(kdst+(slot)))
  #define DMA_V(t,slot) glds16(vsrc+(long)(t)*KVBLK*KVP,(unsigned)__builtin_amdgcn_readfirstlane(vdst+(slot)))
  const int vb0=(int)(lds0+LDS_V)+((lane>>4)&1)*32+(lane&3)*8+(4*hi+((lane&15)>>2))*64;
  const char*Kbase=shm+LDS_K; bf16x8 kf[8];
  const lds_cptr shm3=(lds_cptr)shm; const lds_cptr kp0=shm3+LDS_K+hi*1024+r32*16; const lds_cptr vp0=shm3+LDS_V+((lane>>4)&1)*32+(lane&3)*8+(4*hi+((lane&15)>>2))*64;
  DMA_K(0,0);DMA_V(0,0);DMA_K(1,SLOTB);
  bf16x8 qr[4];
  #pragma unroll
  for(int d0=0;d0<4;++d0)qr[d0]=*reinterpret_cast<const bf16x8*>(&Qw[(long)r32*QP+d0*16+hi*8]);
  float mhat=0.f,l_reg=0.f;f32x16 o[2];o[0]=f32x16{};o[1]=f32x16{};f32x16 negm=f32x16{};asm volatile("":"+v"(negm));
  const int qrel=wid*QBLK+r32;
  #define CMASK(P0,P1,t) do{}while(0)
  bool resc=false;
  #define START(P0,P1) do{ const float rm=rowmax(P0,P1); resc=false; \
    { const float dl=rm; mhat=fadd_s(mhat,dl); \
      _Pragma("unroll") for(int r=0;r<16;++r){P0[r]=fsub_s(P0[r],dl);P1[r]=fsub_s(P1[r],dl);} \
      _Pragma("unroll") for(int r=0;r<16;++r)negm[r]=-mhat; asm volatile("":"+v"(negm)); } \
    _Pragma("unroll") for(int r=0;r<16;++r)P0[r]=__builtin_amdgcn_exp2f(P0[r]); }while(0)
  #define RESC() do{ if(resc){ asm volatile("s_waitcnt lgkmcnt(0)":::"memory"); \
      _Pragma("unroll") for(int d_=0;d_<2;++d_) _Pragma("unroll") for(int r=0;r<16;++r)o[d_][r]*=wsf[crow(r,hi)]; } }while(0)
  f32x16 pA0,pA1,pB0,pB1;
  int sl_prev=0,sl_cur=0,sl_next=SLOTB;
  #define ROT() do{sl_prev=sl_cur;sl_cur=sl_next;sl_next=(sl_next==(NSLOT-1)*SLOTB)?0:sl_next+SLOTB;}while(0)
  DMA_K(2,2*SLOTB);
  WAIT_BAR(3);
  qkt(pA0,pA1,Kbase,qr,negm,r32,hi);asm volatile("s_nop 15\n\ts_nop 7":"+v"(pA0),"+v"(pA1));CMASK(pA0,pA1,0);
  START(pA0,pA1);
  _Pragma("unroll") for(int r=0;r<16;++r)pA1[r]=__builtin_amdgcn_exp2f(pA1[r]);
  WAIT_BAR(0);
  DMA_K(3,0);DMA_V(1,SLOTB);
  ROT();
  kload8(kf,kp0+sl_cur);
  WAIT_BAR(2);
  s16x4 vlo[8],vhi[8]; u32x4 pw0,pw1,pw2,pw3;
  #define PKW(P,B) cvtpk_s(P[B],P[B+1])
  #define PAF(k) __builtin_bit_cast(bf16x8,pw##k)
  #define VFR(i) (bf16x8){vlo[i][0],vlo[i][1],vlo[i][2],vlo[i][3],vhi[i][0],vhi[i][1],vhi[i][2],vhi[i][3]}
  #define PIN(x) asm volatile("":"+v"(x))
  #define MX3(a,b,c) __builtin_fmaxf(__builtin_fmaxf((a),(b)),(c))
  #define GAPA(MF,A0,A1,A2,A3,W0,W1,PW) do{ MF; sacc+=A0; sacc+=A1; sacc+=A2; sacc+=A3; PIN(sacc); W0; W1; PIN(PW); SBAR(); }while(0)
  #define EX(v) __builtin_amdgcn_exp2f(v)
  #define GAPB(MF,X,B) do{ MF; X[B]=EX(X[B]); X[B+1]=EX(X[B+1]); X[B+2]=EX(X[B+2]); X[B+3]=EX(X[B+3]); PIN(X); SBAR(); }while(0)
  #define VRD(i) do{ vlo[i]=vtr(vp_+(((i)>>2)*4096+((i)&3)*1024)); vhi[i]=vtr(vp_+(((i)>>2)*4096+((i)&3)*1024+512)); }while(0)
  #define KRD(G,j) do{ if(G){ kload2(kf,kp0+sl_next,j); SBAR(); } }while(0)
  #define STEP(C0,C1,P0,P1,t,GK,GV,GL) do{ SBAR(); \
    const lds_cptr vp_=vp0+sl_prev; \
    VRD(0); SBAR(); float sacc=(P0[0]+P0[1]); \
    GAPA(C0=__builtin_amdgcn_mfma_f32_32x32x16_bf16(kf[0],qr[0],negm,0,0,0), P0[2],P0[3],P0[4],P0[5],     pw0[0]=PKW(P0,0), pw0[1]=PKW(P0,2), pw0); \
    VRD(4); SBAR(); GAPA(C1=__builtin_amdgcn_mfma_f32_32x32x16_bf16(kf[1],qr[0],negm,0,0,0), P0[6],P0[7],P0[8],P0[9],     pw0[2]=PKW(P0,4), pw0[3]=PKW(P0,6), pw0); \
    VRD(1); SBAR(); GAPA(C0=__builtin_amdgcn_mfma_f32_32x32x16_bf16(kf[2],qr[1],C0,0,0,0),   P0[10],P0[11],P0[12],P0[13], pw1[0]=PKW(P0,8), pw1[1]=PKW(P0,10), pw1); \
    VRD(5); SBAR(); GAPA(C1=__builtin_amdgcn_mfma_f32_32x32x16_bf16(kf[3],qr[1],C1,0,0,0),   P0[14],P0[15],P1[0],P1[1],   pw1[2]=PKW(P0,12),pw1[3]=PKW(P0,14), pw1); \
    VRD(2); SBAR(); GAPA(C0=__builtin_amdgcn_mfma_f32_32x32x16_bf16(kf[4],qr[2],C0,0,0,0),   P1[2],P1[3],P1[4],P1[5],     pw2[0]=PKW(P1,0), pw2[1]=PKW(P1,2), pw2); \
    VRD(6); SBAR(); GAPA(C1=__builtin_amdgcn_mfma_f32_32x32x16_bf16(kf[5],qr[2],C1,0,0,0),   P1[6],P1[7],P1[8],P1[9],     pw2[2]=PKW(P1,4), pw2[3]=PKW(P1,6), pw2); \
    VRD(3); SBAR(); GAPA(C0=__builtin_amdgcn_mfma_f32_32x32x16_bf16(kf[6],qr[3],C0,0,0,0),   P1[10],P1[11],P1[12],P1[13], pw3[0]=PKW(P1,8), pw3[1]=PKW(P1,10), pw3); \
    VRD(7); SBAR(); GAPA(C1=__builtin_amdgcn_mfma_f32_32x32x16_bf16(kf[7],qr[3],C1,0,0,0),   P1[14],P1[15],0.f,0.f,       pw3[2]=PKW(P1,12),pw3[3]=PKW(P1,14), pw3); \
    l_reg+=sacc; \
    if(GK){DMA_K((t)+3,sl_cur);} if(GV){DMA_V((t)+1,sl_next);} \
    CMASK(C0,C1,t); \
    { float a=MX3(C0[0],C0[1],C1[0]),b=MX3(C0[2],C0[3],C1[1]); a=MX3(a,C1[2],C1[3]); \
      _Pragma("unroll") for(int r=4;r<16;r+=4){a=MX3(a,C0[r],C0[r+1]);b=MX3(b,C0[r+2],C0[r+3]);a=MX3(a,C1[r],C1[r+1]);b=MX3(b,C1[r+2],C1[r+3]);} \
      float rm=__builtin_fmaxf(a,b); { auto rr=__builtin_amdgcn_permlane32_swap(__float_as_uint(rm),__float_as_uint(rm),false,false); rm=__builtin_fmaxf(__uint_as_float(rr[0]),__uint_as_float(rr[1])); } \
      resc=false; \
      if(__builtin_expect(__any(rm>(float)THRL),0)){ const float dl=__builtin_fmaxf(rm,0.f); mhat+=dl; \
        _Pragma("unroll") for(int r=0;r<16;++r){C0[r]-=dl;C1[r]-=dl;} \
        _Pragma("unroll") for(int r=0;r<16;++r)negm[r]=-mhat; asm volatile("":"+v"(negm)); \
        const float f=__builtin_amdgcn_exp2f(-dl); l_reg*=f; if(hi==0)wsf[r32]=f; resc=true; } } \
    SBAR(); \
    GAPB(o[0]=__builtin_amdgcn_mfma_f32_32x32x16_bf16(PAF(0),VFR(0),o[0],0,0,0), C0,0); \
    GAPB(o[1]=__builtin_amdgcn_mfma_f32_32x32x16_bf16(PAF(0),VFR(4),o[1],0,0,0), C0,4); \
    KRD(GL,0); GAPB(o[0]=__builtin_amdgcn_mfma_f32_32x32x16_bf16(PAF(1),VFR(1),o[0],0,0,0), C0,8); \
    KRD(GL,1); GAPB(o[1]=__builtin_amdgcn_mfma_f32_32x32x16_bf16(PAF(1),VFR(5),o[1],0,0,0), C0,12); \
    KRD(GL,2); GAPB(o[0]=__builtin_amdgcn_mfma_f32_32x32x16_bf16(PAF(2),VFR(2),o[0],0,0,0), C1,0); \
    KRD(GL,3); GAPB(o[1]=__builtin_amdgcn_mfma_f32_32x32x16_bf16(PAF(2),VFR(6),o[1],0,0,0), C1,4); \
    GAPB(o[0]=__builtin_amdgcn_mfma_f32_32x32x16_bf16(PAF(3),VFR(3),o[0],0,0,0), C1,8); \
    GAPB(o[1]=__builtin_amdgcn_mfma_f32_32x32x16_bf16(PAF(3),VFR(7),o[1],0,0,0), C1,12); \
    }while(0)
  int t=1;
  #undef CMASK
  #define CMASK(P0,P1,t) do{}while(0)
  for(;t+5<NT;t+=2){
    STEP(pB0,pB1,pA0,pA1,t,true,true,true);     WAIT_BAR(2); RESC(); ROT();
    STEP(pA0,pA1,pB0,pB1,t+1,true,true,true);   WAIT_BAR(2); RESC(); ROT();
  }
  #undef CMASK
  #define CMASK(P0,P1,t) do{}while(0)
  #define ENDW(tt) do{ if((tt)+3<NT){WAIT_BAR(2);} else if((tt)+2<NT){WAIT_BAR(1);} else {WAIT_BAR(0);} }while(0)
  for(;t+1<NT;t+=2){
    STEP(pB0,pB1,pA0,pA1,t,(t+3<NT),(t+1<NT),(t+1<NT));       ENDW(t);   RESC(); ROT();
    STEP(pA0,pA1,pB0,pB1,t+1,(t+4<NT),(t+2<NT),(t+2<NT));     ENDW(t+1); RESC(); ROT();
  }
  STEP(pB0,pB1,pA0,pA1,NT-1,false,false,false); RESC();
  { float sacc=pB0[0]+pB0[1]; _Pragma("unroll") for(int r=2;r<16;++r)sacc+=pB0[r]; _Pragma("unroll") for(int r=0;r<16;++r)sacc+=pB1[r]; l_reg+=sacc;
    pw0=(u32x4){PKW(pB0,0),PKW(pB0,2),PKW(pB0,4),PKW(pB0,6)};pw1=(u32x4){PKW(pB0,8),PKW(pB0,10),PKW(pB0,12),PKW(pB0,14)};pw2=(u32x4){PKW(pB1,0),PKW(pB1,2),PKW(pB1,4),PKW(pB1,6)};pw3=(u32x4){PKW(pB1,8),PKW(pB1,10),PKW(pB1,12),PKW(pB1,14)};
    SBAR(); pv(o,vb0+sl_cur,PAF(0),PAF(1),PAF(2),PAF(3)); }
  #undef PKW
  #undef PAF
  #undef VFR
  #undef PIN
  #undef MX3
  #undef GAPA
  #undef GAPB
  #undef EX
  #undef VRD
  #undef KRD
  #undef STEP
  #undef ENDW
  {auto rr=__builtin_amdgcn_permlane32_swap(__float_as_uint(l_reg),__float_as_uint(l_reg),false,false);l_reg=__uint_as_float(rr[0])+__uint_as_float(rr[1]);}
  if(hi==0)wsf[32+r32]=l_reg;asm volatile("s_waitcnt lgkmcnt(0)":::"memory");
  float rli[16];
  #pragma unroll
  for(int r=0;r<16;++r)rli[r]=__builtin_amdgcn_rcpf(wsf[32+crow(r,hi)]);
  bf16*Ow=Ob+(long)(wid*QBLK)*OP;
  { bf16*stg=(bf16*)(shm+LDS_OST)+wid*2048;
    #pragma unroll
    for(int r=0;r<16;++r){const int orow=crow(r,hi);
      #pragma unroll
      for(int d0=0;d0<2;++d0)stg[orow*64+d0*32+r32]=__float2bfloat16(o[d0][r]*rli[r]);}
    asm volatile("s_waitcnt lgkmcnt(0)":::"memory");
    #pragma unroll
    for(int i=0;i<4;++i){const int row=i*8+(lane>>3),ch=lane&7; const u32x4 v=*(const u32x4*)(stg+row*64+ch*8); ATTN_STORE16(Ow+(long)row*OP+ch*8,v);} }
  asm volatile("s_waitcnt lgkmcnt(0)\n\ts_barrier":::"memory");
  #undef DMA_K
  #undef DMA_V
  #undef CMASK
  #undef START
  #undef RESC
  #undef ROT
}
constexpr int ATTN_LDS_BYTES=LDS_BYTES;
#undef SBAR
#undef WAIT_BAR
}
#define LAS __attribute__((address_space(3)))
typedef unsigned short bf16;
typedef float f32x4 __attribute__((ext_vector_type(4)));
typedef unsigned v4u __attribute__((ext_vector_type(4)));
typedef unsigned v2u __attribute__((ext_vector_type(2)));
constexpr size_t MiB = 1u << 20;
constexpr size_t WS_MOD = 1 * MiB;
constexpr size_t WS_ROPE = 6 * MiB;
constexpr size_t WS_ACAT = 7 * MiB;
constexpr size_t WS_ACATC = 23 * MiB;
constexpr size_t WS_WGU = 24 * MiB;
constexpr size_t WS_WDN = 112 * MiB;
constexpr size_t WS_WIN = 156 * MiB;
constexpr size_t WS_WOUT = 168 * MiB;
constexpr size_t WS_XC = 176 * MiB;
constexpr size_t WS_A = 208 * MiB;
constexpr size_t WS_HID = 352 * MiB;
constexpr size_t WS_Q = WS_HID;
constexpr size_t WS_K = WS_HID + 72 * MiB;
constexpr size_t WS_V = WS_HID + 90 * MiB;
constexpr size_t WS_UP = WS_HID + 108 * MiB;
constexpr size_t WS_VT = WS_HID + 144 * MiB;
constexpr size_t WS_VTC = WS_HID + 208 * MiB;
constexpr size_t WS_MODP = WS_HID;
constexpr size_t WS_END = 748 * MiB;
constexpr int LDS_BYTES = 147456, TAB_OFF = 131072;

struct Args { const float* in[18]; float* out; unsigned char* ws; };

__device__ __forceinline__ float wave_sum(float v) {
#pragma unroll
    for (int o = 1; o < 64; o <<= 1) v += __shfl_xor(v, o);
    return v;
}
__device__ __forceinline__ unsigned pk2(float lo, float hi) { return pg8::f2bf1(lo) | (pg8::f2bf1(hi) << 16); }
__device__ __forceinline__ int map_row(int mode, int n) {
    if (mode == 0) return n;
    if (mode == 1) { const int isu = n >= DFF ? 1 : 0; const int j = n - isu * DFF; return 256 * (j >> 7) + 128 * isu + (j & 127); }
    if (n < 512) { const int h = n >> 6, d = n & 63; return 256 * (h >> 2) + 128 * (d >> 5) + 32 * (h & 3) + (d & 31); }
    if (n < 768) { const int wc = (n - 512) >> 6, d = n & 63; return 512 + 128 * (d >> 5) + 32 * wc + (d & 31); }
    return n;
}
__device__ __forceinline__ void transpose_item(const float* W, int ldw, bf16* WT, int ldt, int mode, LAS float* scr, int kb, int nb, int lane) {
    const int k0 = 64 * kb, n0 = 32 * nb;
#pragma unroll 8
    for (int i = 0; i < 32; ++i) { const int kk = 2 * i + (lane >> 5); scr[kk * 33 + (lane & 31)] = W[(size_t)(k0 + kk) * ldw + n0 + (lane & 31)]; }
    asm volatile("s_waitcnt lgkmcnt(0)" ::: "memory");
    const int c = lane & 7; const int r0 = map_row(mode, n0);
#pragma unroll
    for (int j = 0; j < 4; ++j) { const int n = (lane >> 3) + 8 * j; const LAS float* s = scr + (8 * c) * 33 + n;
        v4u o; o.x = pk2(s[0 * 33], s[1 * 33]); o.y = pk2(s[2 * 33], s[3 * 33]); o.z = pk2(s[4 * 33], s[5 * 33]); o.w = pk2(s[6 * 33], s[7 * 33]);
        *(v4u*)(WT + (size_t)(r0 + n) * ldt + k0 + 8 * c) = o; }
    asm volatile("s_waitcnt lgkmcnt(0)" ::: "memory");
}
__device__ __forceinline__ void norm_rows(const float* srcL, const float* srcC, bf16* A, const float* modl, int sidx, int nrows, int gw_, int NGW) {
    const int ft = fresh_tid(); const int lane = ft & 63; const int gw = gw_ + __builtin_amdgcn_readfirstlane(ft >> 6);
    for (int row = gw; row < nrows; row += NGW) {
        const float* xr = row < NLAT ? srcL + (size_t)row * DMODEL : srcC + (size_t)(row - NLAT) * DMODEL;
        const int b = row < NLAT ? (row >> 11) : 32;
        const float* sh = modl + (size_t)b * MODW + sidx * 1024; const float* sc = sh + 1024;
        f32x4 v[4]; float s = 0.f;
#pragma unroll
        for (int j = 0; j < 4; ++j) { v[j] = ((const f32x4*)xr)[lane + 64 * j]; s += (v[j].x * v[j].x + v[j].y * v[j].y) + (v[j].z * v[j].z + v[j].w * v[j].w); }
        const float rstd = 1.0f / sqrtf(wave_sum(s) * (1.0f / DMODEL) + 1e-6f);
        v2u* o8 = (v2u*)(A + (size_t)row * DMODEL) + lane;
#pragma unroll
        for (int j = 0; j < 4; ++j) { const f32x4 shv = ((const f32x4*)sh)[lane + 64 * j], scv = ((const f32x4*)sc)[lane + 64 * j];
            const f32x4 o = v[j] * rstd * (scv + 1.0f) + shv; v2u w; w.x = pk2(o.x, o.y); w.y = pk2(o.z, o.w); o8[64 * j] = w; }
    }
}

__global__ void __launch_bounds__(512, 2) fwd_mega(Args args) {
    extern __shared__ __attribute__((aligned(16))) unsigned char lds[];
    cg::grid_group grid = cg::this_grid();
    LAS unsigned char* L = (LAS unsigned char*)lds;
    const int tid = threadIdx.x, lane = tid & 63, wave = __builtin_amdgcn_readfirstlane(tid >> 6);
    const int G = gridDim.x, bx = blockIdx.x; const int vcu = (G % 8 == 0) ? (bx % 8) * (G / 8) + bx / 8 : bx;
    const int gw = vcu * 8 + wave, NGW = G * 8; const int gtid = bx * 512 + tid, NTHR = G * 512;
    unsigned char* ws = args.ws;
    const float* x_in = args.in[0]; const float* c_in = args.in[1]; const float* ctx_in = args.in[2]; const float* cctx_in = args.in[3];
    const float* ada_w = args.in[4]; const float* ada_b = args.in[5];
    const float* w_in = args.in[8]; const float* q_gain = args.in[9]; const float* k_gain = args.in[10];
    const float* pool_w = args.in[11]; const float* pool_scale = args.in[12]; const float* fft_w = args.in[13]; const float* w_out = args.in[14];
    const float* final_gain = args.in[17];
    float* XL = args.out; float* XC = (float*)(ws + WS_XC);
    float* MOD = (float*)(ws + WS_MOD); float* MODP = (float*)(ws + WS_MODP);
    float* ROPEC = (float*)(ws + WS_ROPE); float* ROPES = ROPEC + 2048 * 32;
    bf16* ACAT = (bf16*)(ws + WS_ACAT); bf16* ACATC = (bf16*)(ws + WS_ACATC);
    bf16* WGU = (bf16*)(ws + WS_WGU); bf16* WDN = (bf16*)(ws + WS_WDN); bf16* WIN = (bf16*)(ws + WS_WIN); bf16* WOUT = (bf16*)(ws + WS_WOUT);
    bf16* AB = (bf16*)(ws + WS_A); bf16* HID = (bf16*)(ws + WS_HID);
    bf16* QB_ = (bf16*)(ws + WS_Q); bf16* KB_ = (bf16*)(ws + WS_K); bf16* VB_ = (bf16*)(ws + WS_V); bf16* UP = (bf16*)(ws + WS_UP); bf16* VT = (bf16*)(ws + WS_VT); bf16* VTC = (bf16*)(ws + WS_VTC);

    {
        LAS float* scr = (LAS float*)(L + wave * 16384);
        constexpr int I_GU = 16 * 176, I_DN = 44 * 32, I_IN = 16 * 32, I_OUT = 8 * 32;
        constexpr int NITEMS = 8 * I_GU + 8 * I_DN + 4 * I_IN + 4 * I_OUT;
        for (int it = gw; it < NITEMS; it += NGW) {
            int r = it;
            if (r < 8 * I_GU) { const int mi = r / I_GU; r %= I_GU; const int l = mi >> 1, f = mi & 1;
                transpose_item(args.in[f ? 15 : 6] + (size_t)l * 1024 * 5632, 5632, WGU + (size_t)mi * 5632 * 1024, 1024, 1, scr, r / 176, r % 176, lane); continue; }
            r -= 8 * I_GU;
            if (r < 8 * I_DN) { const int mi = r / I_DN; r %= I_DN; const int l = mi >> 1, f = mi & 1;
                transpose_item(args.in[f ? 16 : 7] + (size_t)l * 2816 * 1024, 1024, WDN + (size_t)mi * 1024 * 2816, 2816, 0, scr, r / 32, r % 32, lane); continue; }
            r -= 8 * I_DN;
            if (r < 4 * I_IN) { const int l = r / I_IN; r %= I_IN;
                transpose_item(w_in + (size_t)l * 1024 * 1280, 1280, WIN + (size_t)l * 1536 * 1024, 1024, 2, scr, r / 32, r % 32, lane); continue; }
            r -= 4 * I_IN;
            { const int l = r / I_OUT; r %= I_OUT;
                transpose_item(w_out + (size_t)l * 1024 * 1024, 1024, WOUT + (size_t)l * 1024 * 1024, 1024, 0, scr, r / 32, r % 32, lane); }
        }
    }
    __syncthreads();
    LAS float* T2048 = (LAS float*)(L + TAB_OFF); LAS float* T64 = T2048 + 2048;
    for (int i = tid; i < 2048; i += 512) T2048[i] = cospif((float)i * (1.0f / 1024.0f));
    if (tid < 64) T64[tid] = cospif((float)tid * (1.0f / 32.0f));
    __syncthreads();
    for (int idx = bx * 512 + fresh_tid(); idx < 4 * 262144; idx += NTHR) {
        const int l = idx >> 18, rem = idx & 262143, cc = rem >> 10, k = rem & 1023, g = cc >> 6, cp = cc & 63;
        const float* src = w_in + ((size_t)l * 1024 + k) * 1280 + 1024 + 64 * g;
        float ac = 0.f, as = 0.f;
#pragma unroll 4
        for (int c4 = 0; c4 < 16; ++c4) { const f32x4 w = *(const f32x4*)(src + 4 * c4);
#pragma unroll
            for (int e = 0; e < 4; ++e) { const int m = (4 * c4 + e) * cp; ac += w[e] * T64[m & 63]; as += w[e] * T64[(m - 16) & 63]; } }
        bf16* d = WIN + (size_t)l * 1536 * 1024 + k;
        d[(size_t)(1024 + cc) * 1024] = (bf16)pg8::f2bf1(ac * 0.125f); d[(size_t)(1280 + cc) * 1024] = (bf16)pg8::f2bf1(as * 0.125f);
    }
    for (int idx = bx * 512 + fresh_tid(); idx < 4 * 32768; idx += NTHR) {
        const int l = idx >> 15, rem = idx & 32767, n = rem & 1023, gc = rem >> 10, g = gc >> 3, c0 = (gc & 7) * 8;
        const float* wo = w_out + (size_t)l * 1024 * 1024 + (size_t)(512 + 64 * g) * 1024 + n;
        const float* ps = pool_scale + l * 256 + 64 * g; const float* pw = pool_w + ((size_t)(l * 4 + g) * 64 + c0) * 64;
        float a[8];
#pragma unroll
        for (int i = 0; i < 8; ++i) a[i] = 0.f;
        for (int d = 0; d < 64; ++d) { const float w = ps[d] * wo[(size_t)d * 1024];
#pragma unroll
            for (int i = 0; i < 8; ++i) a[i] += pw[i * 64 + d] * w; }
        v4u o; o.x = pk2(a[0], a[1]); o.y = pk2(a[2], a[3]); o.z = pk2(a[4], a[5]); o.w = pk2(a[6], a[7]);
        *(v4u*)(WOUT + (size_t)l * 1024 * 1024 + (size_t)n * 1024 + 512 + 64 * g + c0) = o;
    }
    for (int idx = bx * 512 + fresh_tid(); idx < 4 * 32768; idx += NTHR) {
        const int l = idx >> 15, rem = idx & 32767, n = rem & 1023, i0 = (rem >> 10) * 8;
        const float* wo = w_out + (size_t)l * 1024 * 1024 + (size_t)768 * 1024 + n;
        const float* fw = fft_w + (size_t)l * 65536 + (size_t)i0 * 256;
        float a[8];
#pragma unroll
        for (int i = 0; i < 8; ++i) a[i] = 0.f;
        for (int j = 0; j < 256; ++j) { const float w = wo[(size_t)j * 1024];
#pragma unroll
            for (int i = 0; i < 8; ++i) a[i] += fw[i * 256 + j] * w; }
        v4u o; o.x = pk2(a[0], a[1]); o.y = pk2(a[2], a[3]); o.z = pk2(a[4], a[5]); o.w = pk2(a[6], a[7]);
        *(v4u*)(WOUT + (size_t)l * 1024 * 1024 + (size_t)n * 1024 + 768 + i0) = o;
    }
    for (int idx = bx * 512 + fresh_tid(); idx < 65536; idx += NTHR) {
        const int t = idx >> 5, i = idx & 31; const int pos = i < 16 ? (t >> 6) : (t & 63);
        const float inv = powf(10000.0f, -(float)(i & 15) * (1.0f / 16.0f)); const float ang = (float)pos * inv;
        ROPEC[idx] = cosf(ang); ROPES[idx] = sinf(ang);
    }
    for (int idx = bx * 512 + fresh_tid(); idx < 2048 * 512; idx += NTHR) {
        const int kp = idx >> 9, ch = idx & 511; unsigned w[4];
#pragma unroll
        for (int e2 = 0; e2 < 4; ++e2) { unsigned pr[2];
#pragma unroll
            for (int q = 0; q < 2; ++q) { const int np = ch * 8 + e2 * 2 + q; const int m = np < 2048 ? (kp * np) & 2047 : (kp * (np - 2048) + 512) & 2047; pr[q] = pg8::f2bf1(T2048[m]); }
            w[e2] = pr[0] | (pr[1] << 16); }
        v4u o; o.x = w[0]; o.y = w[1]; o.z = w[2]; o.w = w[3];
        *(v4u*)(ACAT + (size_t)kp * 4096 + ch * 8) = o;
    }
    for (int idx = bx * 512 + fresh_tid(); idx < 256 * 64; idx += NTHR) {
        const int kp = idx >> 6, ch = idx & 63; unsigned w[4];
#pragma unroll
        for (int e2 = 0; e2 < 4; ++e2) { unsigned pr[2];
#pragma unroll
            for (int q = 0; q < 2; ++q) { const int np = ch * 8 + e2 * 2 + q; const int m = np < 256 ? (8 * kp * np) & 2047 : (8 * kp * (np - 256) + 512) & 2047; pr[q] = pg8::f2bf1(T2048[m]); }
            w[e2] = pr[0] | (pr[1] << 16); }
        v4u o; o.x = w[0]; o.y = w[1]; o.z = w[2]; o.w = w[3];
        *(v4u*)(ACATC + (size_t)kp * 512 + ch * 8) = o;
    }
    {
        LAS float* sc = (LAS float*)L;
        for (int task = bx; task < 576; task += G) {
            const int ks = task / 72, cb = task % 72;
            __syncthreads();
            for (int e = tid; e < 128 * 33; e += 512) { const int kk = e / 33, b = e % 33; const int k = ks * 128 + kk;
                const float cv = b < 32 ? c_in[b * 1024 + k] : cctx_in[k]; sc[kk * 36 + b] = cv / (1.0f + expf(-cv)); }
            __syncthreads();
            const int j = cb * 512 + tid; const int l = j / MODW, jj = j % MODW;
            const float* wp = ada_w + ((size_t)l * 1024 + ks * 128) * MODW + jj;
            float a[33];
#pragma unroll
            for (int b = 0; b < 33; ++b) a[b] = 0.f;
            for (int kk = 0; kk < 128; ++kk) { const float w = wp[(size_t)kk * MODW];
#pragma unroll
                for (int q = 0; q < 8; ++q) { const f32x4 s = *(const LAS f32x4*)(sc + kk * 36 + 4 * q); a[4 * q] += w * s.x; a[4 * q + 1] += w * s.y; a[4 * q + 2] += w * s.z; a[4 * q + 3] += w * s.w; }
                a[32] += w * sc[kk * 36 + 32]; }
#pragma unroll
            for (int b = 0; b < 33; ++b) MODP[((size_t)ks * 33 + b) * 36864 + j] = a[b];
        }
    }
    grid.sync();
    for (int idx = bx * 512 + fresh_tid(); idx < 33 * 36864; idx += NTHR) {
        const int b = idx / 36864, j = idx % 36864, l = j / MODW, jj = j % MODW;
        float s = ada_b[j];
#pragma unroll
        for (int ks = 0; ks < 8; ++ks) s += MODP[((size_t)ks * 33 + b) * 36864 + j];
        MOD[((size_t)l * 33 + b) * MODW + jj] = s;
    }
    grid.sync();

    for (int l = 0; l < 4; ++l) {
        const bool last = (l == 3);
        const float* modl = MOD + (size_t)l * 33 * MODW;
        for (int f = 0; f < 2; ++f) {
            const bool first = (l == 0 && f == 0);
            const int nrows = (last && f == 1) ? NLAT : NROW;
            const float* sL = first ? x_in : XL; const float* sC = first ? ctx_in : XC;
            norm_rows(sL, sC, AB, modl, f == 0 ? 0 : 6, nrows, vcu * 8, NGW);
            grid.sync();
            {   pg8::Gemm g{AB, WGU + (size_t)(l * 2 + f) * 5632 * 1024, nrows, 5632, 1024}; pg8::StaticOrder S; S.init(nrows, 5632, G, bx);
                pg8::EpiGU E{HID};
                pg8::gemm_phase<pg8::EpiGU, pg8::StaticOrder, true, true>(L, g, S, E); }
            grid.sync();
            {   pg8::Gemm g{HID, WDN + (size_t)(l * 2 + f) * 1024 * 2816, nrows, 1024, 2816}; pg8::StaticOrder S; S.init(nrows, 1024, G, bx);
                pg8::EpiRes E{sL, sC, XL, XC, modl + (f == 0 ? 2 : 8) * 1024, 0.5f};
                pg8::gemm_phase<pg8::EpiRes, pg8::StaticOrder, true, true>(L, g, S, E); }
            grid.sync();
            if (f == 0) {
                norm_rows(XL, XC, AB, modl, 3, NROW, vcu * 8, NGW);
                grid.sync();
                {   pg8::Gemm g{AB, WIN + (size_t)l * 1536 * 1024, NROW, 1536, 1024}; pg8::StaticOrder S; S.init(NROW, 1536, G, bx);
                    pg8::EpiIN E{QB_, KB_, VB_, UP, VT, VTC, q_gain + l * 64, k_gain + l * 64, ROPEC, ROPES};
                    pg8::gemm_phase<pg8::EpiIN, pg8::StaticOrder, true, true>(L, g, S, E); }
                grid.sync();
                for (int v = vcu; v < 256; v += G) {
                    const int p = v >> 2, s = v & 3, b = p >> 1, kvh = p & 1, h = 4 * kvh + s;
                    const attn_body::bf16* Kh = (const attn_body::bf16*)KB_ + (size_t)b * KVROWS * 128 + kvh * 64;
                    const attn_body::bf16* Vh = (const attn_body::bf16*)VB_ + (size_t)b * KVROWS * 128 + kvh * 64;
                    for (int qb = 0; qb < 8; ++qb) { const size_t r0 = (size_t)b * 2048 + qb * 256;
                        attn_body::attn_unit<8>((const attn_body::bf16*)QB_ + r0 * 512 + h * 64, Kh, Vh, (attn_body::bf16*)AB + r0 * 1024 + h * 64, 36, (char*)lds); }
                    if (!last) { const int cb = v >> 3, ch = v & 7; const size_t r0 = (size_t)NLAT + cb * 256;
                        const attn_body::bf16* Kc = (const attn_body::bf16*)KB_ + ((size_t)cb * KVROWS + 2048) * 128 + (ch >> 2) * 64;
                        const attn_body::bf16* Vc = (const attn_body::bf16*)VB_ + ((size_t)cb * KVROWS + 2048) * 128 + (ch >> 2) * 64;
                        attn_body::attn_unit<8>((const attn_body::bf16*)QB_ + r0 * 512 + ch * 64, Kc, Vc, (attn_body::bf16*)AB + r0 * 1024 + ch * 64, 4, (char*)lds); }
                }
                {   const int prow = last ? NLAT : NROW;
                    for (int idx = bx * 512 + fresh_tid(); idx < prow * 32; idx += NTHR) {
                        const int row = idx >> 5, ch = idx & 31, c0 = ch * 8, g = ch >> 3, w2 = 1 << g, w = 2 << g;
                        int Ls, t; if (row < NLAT) { Ls = 2048; t = row & 2047; } else { Ls = 256; t = row & 255; }
                        const int base = row - t; const int lo = max(t - w2, 0), hi = min(t + w - w2, Ls);
                        float s[8];
#pragma unroll
                        for (int i = 0; i < 8; ++i) s[i] = 0.f;
                        for (int j = lo; j < hi; ++j) { const v4u q = *(const v4u*)(UP + (size_t)(base + j) * 256 + c0);
                            s[0] += __uint_as_float(q.x << 16); s[1] += __uint_as_float(q.x & 0xffff0000u); s[2] += __uint_as_float(q.y << 16); s[3] += __uint_as_float(q.y & 0xffff0000u);
                            s[4] += __uint_as_float(q.z << 16); s[5] += __uint_as_float(q.z & 0xffff0000u); s[6] += __uint_as_float(q.w << 16); s[7] += __uint_as_float(q.w & 0xffff0000u); }
                        const v4u q = *(const v4u*)(UP + (size_t)row * 256 + c0); const float ic = 1.0f / (float)(hi - lo);
                        v4u o;
                        o.x = pk2(s[0] * ic - __uint_as_float(q.x << 16), s[1] * ic - __uint_as_float(q.x & 0xffff0000u));
                        o.y = pk2(s[2] * ic - __uint_as_float(q.y << 16), s[3] * ic - __uint_as_float(q.y & 0xffff0000u));
                        o.z = pk2(s[4] * ic - __uint_as_float(q.z << 16), s[5] * ic - __uint_as_float(q.z & 0xffff0000u));
                        o.w = pk2(s[6] * ic - __uint_as_float(q.w << 16), s[7] * ic - __uint_as_float(q.w & 0xffff0000u));
                        *(v4u*)(AB + (size_t)row * 1024 + 512 + c0) = o;
                    }
                }
                {   pg8::Gemm g{ACAT, VT, 2048, 8192, 4096}; pg8::StaticOrder S; S.init(2048, 8192, G, bx);
                    pg8::EpiDFT E{AB, 0, 2048, 0.022097086912079608f};
                    pg8::gemm_phase<pg8::EpiDFT, pg8::StaticOrder, true, true>(L, g, S, E); }
                if (!last) { pg8::Gemm g{ACATC, VTC, 256, 8192, 512}; pg8::StaticOrder S; S.init(256, 8192, G, bx);
                    pg8::EpiDFT E{AB, NLAT, 256, 0.0625f};
                    pg8::gemm_phase<pg8::EpiDFT, pg8::StaticOrder, true, true>(L, g, S, E); }
                grid.sync();
                {   const int mrows = last ? NLAT : NROW;
                    pg8::Gemm g{AB, WOUT + (size_t)l * 1024 * 1024, mrows, 1024, 1024}; pg8::StaticOrder S; S.init(mrows, 1024, G, bx);
                    pg8::EpiRes E{XL, XC, XL, XC, modl + 5 * 1024, 1.0f};
                    pg8::gemm_phase<pg8::EpiRes, pg8::StaticOrder, true, true>(L, g, S, E); }
                grid.sync();
            }
        }
    }
    const int ftf = fresh_tid(); const int lanef = ftf & 63;
    for (int row = vcu * 8 + __builtin_amdgcn_readfirstlane(ftf >> 6); row < NLAT; row += NGW) {
        f32x4* xr = (f32x4*)(XL + (size_t)row * DMODEL);
        f32x4 v[4]; float s = 0.f;
#pragma unroll
        for (int j = 0; j < 4; ++j) { v[j] = xr[lanef + 64 * j]; s += (v[j].x * v[j].x + v[j].y * v[j].y) + (v[j].z * v[j].z + v[j].w * v[j].w); }
        const float rstd = 1.0f / sqrtf(wave_sum(s) * (1.0f / DMODEL) + 1e-6f);
#pragma unroll
        for (int j = 0; j < 4; ++j) { const f32x4 gv = ((const f32x4*)final_gain)[lanef + 64 * j]; xr[lanef + 64 * j] = v[j] * rstd * gv; }
    }
}

extern "C" void kernel_launch(void* const* d_in, const int* in_sizes, int n_in, void* d_out, int out_size, void* d_ws, size_t ws_size, hipStream_t stream) {
    static int grid = 0;
    if (grid == 0) {
        if (n_in != 18 || out_size != NLAT * DMODEL || ws_size < WS_END) { fprintf(stderr, "kernel_launch: unexpected shapes (n_in %d, out %d, ws %zu)\n", n_in, out_size, ws_size); grid = -1; return; }
        int dev = 0, cus = 0, per_cu = 0;
        hipGetDevice(&dev); hipDeviceGetAttribute(&cus, hipDeviceAttributeMultiprocessorCount, dev);
        hipFuncSetAttribute((const void*)fwd_mega, hipFuncAttributeMaxDynamicSharedMemorySize, LDS_BYTES);
        if (hipOccupancyMaxActiveBlocksPerMultiprocessor(&per_cu, (const void*)fwd_mega, 512, LDS_BYTES) != hipSuccess || per_cu < 1) { fprintf(stderr, "kernel_launch: occupancy query says %d\n", per_cu); per_cu = 1; }
        (void)hipGetLastError();
        grid = cus * (per_cu > 1 ? 1 : per_cu);
        if (grid <= 0) grid = 256;
    }
    if (grid < 0) return;
    Args a{};
    for (int i = 0; i < 18; ++i) a.in[i] = (const float*)d_in[i];
    a.out = (float*)d_out; a.ws = (unsigned char*)d_ws;
    void* params[] = {&a};
    hipError_t e = hipLaunchCooperativeKernel((const void*)fwd_mega, dim3(grid), dim3(512), params, LDS_BYTES, stream);
    if (e != hipSuccess) fprintf(stderr, "cooperative launch failed: %s (grid %d)\n", hipGetErrorString(e), grid);
}
```

```cpp
#include <hip/hip_runtime.h>
#include <hip/hip_cooperative_groups.h>
#include <hip/hip_bf16.h>
#include <cstdio>
#include <cstdint>
#include <cmath>
namespace cg = cooperative_groups;
constexpr int NLAT = 65536, NCTX = 8192, NROW = NLAT + NCTX, DMODEL = 1024, DFF = 2816, MODW = 9216, KVROWS = 2304;
constexpr float QC2 = 0.125f * 1.4426950408889634f;
__device__ __forceinline__ int fresh_tid() { int t = threadIdx.x; asm volatile("" : "+v"(t)); return t; }
namespace pg8 {
#define PG8_LAS __attribute__((address_space(3)))
typedef unsigned short bf16_t;
typedef short bf16x8 __attribute__((ext_vector_type(8)));
typedef float f32x4 __attribute__((ext_vector_type(4)));
typedef unsigned u32x4 __attribute__((ext_vector_type(4)));
constexpr int BM = 256, BK = 64, HALF = 128, HTB = HALF * BK * 2  , STAGE_BYTES = 8 * HTB, NXCD = 8, WGM = 8;

__host__ __device__ __forceinline__ int lds_byte(int r, int c) { const int st = (r >> 4) * 2 + (c >> 5), rr = r & 15, cc = c & 31, ob = rr * 64 + cc * 2; return st * 1024 + (ob ^ (((ob >> 9) & 1) << 5)); }
__host__ __device__ __forceinline__ void stage_rc(int b, int& R, int& C) { const int st = b / 1024, sb = b % 1024, swz = sb ^ (((sb >> 9) & 1) << 5); R = (st >> 1) * 16 + swz / 64; C = (st & 1) * 32 + (swz % 64) / 2; }
__host__ __device__ __forceinline__ int perm32(int rho) { const int n = rho >> 4, i = rho & 15; return 8 * (i >> 2) + 4 * n + (i & 3); }

struct Unit { int pm, pn; };
struct Gemm { const bf16_t* A; const bf16_t* Bt; int M, N, K; int ablk; };

struct StaticOrder {
    int nM, nN, nwg, G, c;
    __host__ __device__ void init(int M, int N, int G_, int c_) { nM = M / BM; nN = N / BM; nwg = nM * nN; G = G_; c = c_; }
    __host__ __device__ bool next(int i, Unit& u) const {
        const long L = (long)i * G + c; if (L >= nwg) return false;
        int wgid = (int)L; { const int q = nwg / NXCD, r = nwg % NXCD, xcd = wgid % NXCD, off = wgid / NXCD; wgid = (xcd < r ? xcd * (q + 1) : r * (q + 1) + (xcd - r) * q) + off; }
        const int nig = WGM * nN, gid = wgid / nig, fm = gid * WGM, gsz = (nM - fm) < WGM ? (nM - fm) : WGM;
        u.pm = fm + ((wgid % nig) % gsz); u.pn = (wgid % nig) / gsz; return true;
    }
    __device__ __forceinline__ void a_ready(const Unit&) const {}
    __device__ __forceinline__ void done(const Unit&) const {}
};

__device__ __forceinline__ unsigned cvt_pk_bf16(float lo, float hi) { unsigned r; asm volatile("v_cvt_pk_bf16_f32 %0, %1, %2" : "=v"(r) : "v"(lo), "v"(hi)); return r; }
typedef float f32x2 __attribute__((ext_vector_type(2)));
__device__ __forceinline__ unsigned f2bf1(float f) { unsigned u = __builtin_bit_cast(unsigned, f); return (u + 0x7fffu + ((u >> 16) & 1u)) >> 16; }
__device__ __forceinline__ float silu_f(float g) { return g * __builtin_amdgcn_rcpf(1.0f + __expf(-g)); }
struct EpiGU {
    static constexpr bool PERM = true, AFTER_DRAIN = false;
    bf16_t* H; const float* SS; const float* SWT;
    __device__ __forceinline__ void operator()(const f32x4 (&acc)[2][2][4][2], const Unit& u, int wr, int wc, int fr, int fq) const {
        asm volatile("" : "+v"(fr), "+v"(fq));
        const int row0 = u.pm * BM + wr * 64 + fr, col0 = u.pn * 128 + wc * 32 + 8 * fq;
        const int b = u.pm < 256 ? (u.pm >> 3) : 32;
        const float* swp = SWT + ((size_t)u.pn * 33 + b) * 256 + wc * 32 + 8 * fq;
        const f32x4 sg0 = *(const f32x4*)(swp), sg1 = *(const f32x4*)(swp + 4), su0 = *(const f32x4*)(swp + 128), su1 = *(const f32x4*)(swp + 132);
        float ssv[2][4];
#pragma unroll
        for (int ai = 0; ai < 2; ++ai)
#pragma unroll
            for (int m = 0; m < 4; ++m) ssv[ai][m] = SS[row0 + ai * HALF + m * 16];
#pragma unroll
        for (int ai = 0; ai < 2; ++ai)
#pragma unroll
            for (int m = 0; m < 4; ++m) {
                const float rs = __builtin_amdgcn_rsqf(ssv[ai][m] * (1.0f / 1024.0f) + 1e-6f);
                bf16_t* p = H + ((size_t)(u.pm * 44 + u.pn * 2 + (wc >> 1)) * 256 + (wr * 64 + fr + ai * HALF + m * 16)) * 64 + (wc & 1) * 32 + 8 * fq;
                const f32x2 rs2 = {rs, rs}; u32x4 w;
#define SILU2(G, U, SG, SU) ({ const f32x2 g_ = (G) * rs2 + (SG), u_ = (U) * rs2 + (SU); const f32x2 t_ = g_ * (-1.4426950408889634f); f32x2 d_; d_.x = __builtin_amdgcn_exp2f(t_.x); d_.y = __builtin_amdgcn_exp2f(t_.y); d_ = d_ + 1.0f; \
                    f32x2 r_; r_.x = __builtin_amdgcn_rcpf(d_.x); r_.y = __builtin_amdgcn_rcpf(d_.y); const f32x2 h_ = (g_ * u_) * r_; cvt_pk_bf16(h_.x, h_.y); })
                w.x = SILU2(acc[ai][0][m][0].xy, acc[ai][1][m][0].xy, sg0.xy, su0.xy); w.y = SILU2(acc[ai][0][m][0].zw, acc[ai][1][m][0].zw, sg0.zw, su0.zw);
                w.z = SILU2(acc[ai][0][m][1].xy, acc[ai][1][m][1].xy, sg1.xy, su1.xy); w.w = SILU2(acc[ai][0][m][1].zw, acc[ai][1][m][1].zw, sg1.zw, su1.zw);
#undef SILU2
                __builtin_nontemporal_store(w, (u32x4*)p);
            }
    }
};
__device__ __forceinline__ f32x4 clamp_m(f32x4 s) { f32x4 m = s + 1.0f;
#pragma unroll
    for (int e = 0; e < 4; ++e) m[e] = __builtin_fabsf(m[e]) < 1e-6f ? __builtin_copysignf(1e-6f, m[e]) : m[e];
    return m; }
typedef unsigned u32x2 __attribute__((ext_vector_type(2)));
__device__ __forceinline__ unsigned lo8_enc(float y, unsigned hb  ) { return ((__float_as_uint(y) - (hb + 0xffff8000u)) >> 8) & 0xffu; }
__device__ __forceinline__ float lo8_dec(unsigned hb  , unsigned byte) { return __uint_as_float((hb | (byte << 8)) + 0xffff8080u); }
struct EpiRes {
    static constexpr bool PERM = true, AFTER_DRAIN = false;
    bf16_t* HI; unsigned char* LO; const float* gate; const float* dsc; const float* nsc; float* SSn; PG8_LAS float* cst; float gs; int nstride;
    __device__ __forceinline__ void operator()(const f32x4 (&acc)[2][2][4][2], const Unit& u, int wr, int wc, int fr, int fq) const {
        asm volatile("" : "+v"(fr), "+v"(fq));
        const int pm = u.pm; const int b = pm < 256 ? (pm >> 3) : 32;
        const int rl = pm * BM + wr * 64 + fr, col0 = u.pn * BM + wc * 64 + 16 * fq;
        f32x4 gv[2][2], mev[2][2], rdv[2][2];
#pragma unroll
        for (int bj = 0; bj < 2; ++bj)
#pragma unroll
            for (int n = 0; n < 2; ++n) { gv[bj][n] = *(const f32x4*)(gate + (size_t)b * MODW + col0 + bj * 8 + n * 4) * gs;
                mev[bj][n] = clamp_m(*(const f32x4*)(nsc + (size_t)b * nstride + col0 + bj * 8 + n * 4));
                const f32x4 md = clamp_m(*(const f32x4*)(dsc + (size_t)b * MODW + col0 + bj * 8 + n * 4));
#pragma unroll
                for (int e = 0; e < 4; ++e) rdv[bj][n][e] = __builtin_amdgcn_rcpf(md[e]); }
        constexpr int PF = 1, NB = PF + 1;
        u32x4 RH[NB][2]; u32x2 RL[NB][2];
        const int rloc0 = wr * 64 + fr; const size_t hib = ((size_t)(pm * 16 + u.pn * 4 + wc) * 256) * 64 + 16 * fq, lob = ((size_t)(pm * 4 + u.pn) * 256) * 256 + wc * 64 + 16 * fq;
#define HI_OFF(rloc_, bj_) (hib + (size_t)(rloc_) * 64 + (bj_) * 8)
#define LO_OFF(rloc_, bj_) (lob + (size_t)(rloc_) * 256 + (bj_) * 8)
#define RES_LOAD(slot, j_) do { const int rloc_ = rloc0 + ((j_) >> 2) * HALF + ((j_) & 3) * 16; \
            _Pragma("unroll") for (int bj = 0; bj < 2; ++bj) { RH[slot][bj] = *(const u32x4*)(HI + HI_OFF(rloc_, bj)); RL[slot][bj] = *(const u32x2*)(LO + LO_OFF(rloc_, bj)); } } while (0)
#pragma unroll
        for (int j = 0; j < PF; ++j) RES_LOAD(j % NB, j);
#pragma unroll
        for (int j = 0; j < 8; ++j) {
            if (j + PF < 8) RES_LOAD((j + PF) % NB, j + PF);
            asm volatile("" ::: "memory");
            const int ai = j >> 2, m = j & 3; const int r = rl + ai * HALF + m * 16; const int rloc = rloc0 + ai * HALF + m * 16;
            f32x2 ss2 = {0.f, 0.f};
#pragma unroll
            for (int bj = 0; bj < 2; ++bj) { u32x4 wh; u32x2 wl;
#pragma unroll
                for (int n = 0; n < 2; ++n) { const f32x4 me_ = mev[bj][n], rd_ = rdv[bj][n], gq = gv[bj][n], aq = acc[ai][bj][m][n];
                    const unsigned hw0 = RH[j % NB][bj][2 * n], hw1 = RH[j % NB][bj][2 * n + 1], lw = RL[j % NB][bj][n];
                    f32x2 y01, y23;
                    y01.x = __uint_as_float(__builtin_amdgcn_perm(hw0, lw, 0x0504000cu) + 0xffff8080u); y01.y = __uint_as_float(__builtin_amdgcn_perm(hw0, lw, 0x0706010cu) + 0xffff8080u);
                    y23.x = __uint_as_float(__builtin_amdgcn_perm(hw1, lw, 0x0504020cu) + 0xffff8080u); y23.y = __uint_as_float(__builtin_amdgcn_perm(hw1, lw, 0x0706030cu) + 0xffff8080u);
                    const f32x2 o01 = y01 * rd_.xy + gq.xy * aq.xy, o23 = y23 * rd_.zw + gq.zw * aq.zw;
                    ss2 += o01 * o01; ss2 += o23 * o23;
                    y01 = o01 * me_.xy; y23 = o23 * me_.zw;
                    const unsigned h0 = cvt_pk_bf16(y01.x, y01.y), h1 = cvt_pk_bf16(y23.x, y23.y);
                    const unsigned t0 = __float_as_uint(y01.x) - ((h0 << 16) + 0xffff8000u), t1 = __float_as_uint(y01.y) - ((h0 & 0xffff0000u) + 0xffff8000u);
                    const unsigned t2 = __float_as_uint(y23.x) - ((h1 << 16) + 0xffff8000u), t3 = __float_as_uint(y23.y) - ((h1 & 0xffff0000u) + 0xffff8000u);
                    wh[2 * n] = h0; wh[2 * n + 1] = h1;
                    wl[n] = __builtin_amdgcn_perm(__builtin_amdgcn_perm(t3, t2, 0x0c0c0501u), __builtin_amdgcn_perm(t1, t0, 0x0c0c0501u), 0x05040100u); }
                *(u32x4*)(HI + HI_OFF(rloc, bj)) = wh; *(u32x2*)(LO + LO_OFF(rloc, bj)) = wl; }
            float ss = ss2.x + ss2.y;
            { ss += __shfl_xor(ss, 16); ss += __shfl_xor(ss, 32); if (fq == 0) unsafeAtomicAdd(SSn + r, ss); }
            asm volatile("" ::: "memory");
        }
#undef RES_LOAD
#undef HI_OFF
#undef LO_OFF
    }
};
struct EpiSW {
    static constexpr bool PERM = true, AFTER_DRAIN = false;
    float* SWT;
    __device__ __forceinline__ void operator()(const f32x4 (&acc)[2][2][4][2], const Unit& u, int wr, int wc, int fr, int fq) const {
        asm volatile("" : "+v"(fr), "+v"(fq));
        if (wr != 0) return;
#pragma unroll
        for (int m = 0; m < 3; ++m) { const int row = m * 16 + fr;
            if (row < 33) { float* p = SWT + ((size_t)u.pn * 33 + row) * 256 + wc * 32 + 8 * fq;
#pragma unroll
                for (int bj = 0; bj < 2; ++bj)
#pragma unroll
                    for (int n = 0; n < 2; ++n) *(f32x4*)(p + bj * HALF + 4 * n) = acc[0][bj][m][n]; } }
    }
};
struct SwOrder {
    int G, c, L;
    __device__ bool next(int i, Unit& u) const { const int j = i * G + c; if (c < 0 || j >= 50) return false; const int pn = j < 44 ? L * 44 + j : 176 + L * 6 + (j - 44); u.pn = pn;
        if (pn < 176) { const int mi = pn / 22; u.pm = (mi >> 1) * 3 + 2 * (mi & 1); } else u.pm = ((pn - 176) / 6) * 3 + 1; return true; }
    __device__ __forceinline__ void a_ready(const Unit&) const {}
    __device__ __forceinline__ void done(const Unit&) const {}
};
struct EpiIN {
    static constexpr bool PERM = true, AFTER_DRAIN = false;
    bf16_t *Q, *Kb, *Vb, *UP, *VT, *VTC; const float *qg, *kg, *ropeC, *ropeS; const float* SS; const float* SWT;
    __device__ __forceinline__ void operator()(const f32x4 (&acc)[2][2][4][2], const Unit& u, int wr, int wc, int fr, int fq) const {
        asm volatile("" : "+v"(fr), "+v"(fq));
        const int pn = u.pn, pm = u.pm; const bool lat = pm < 256;
        const int rbase = pm * BM + wr * 64 + fr;
        f32x4 sw[2][2]; float rsv[2][4];
        { const int b = lat ? (pm >> 3) : 32; const float* swp = SWT + ((size_t)pn * 33 + b) * 256 + wc * 32 + 8 * fq;
#pragma unroll
          for (int bj = 0; bj < 2; ++bj)
#pragma unroll
            for (int n = 0; n < 2; ++n) sw[bj][n] = *(const f32x4*)(swp + bj * HALF + 4 * n);
#pragma unroll
          for (int ai = 0; ai < 2; ++ai)
#pragma unroll
            for (int m = 0; m < 4; ++m) rsv[ai][m] = __builtin_amdgcn_rsqf(SS[rbase + ai * HALF + m * 16] * (1.0f / 1024.0f) + 1e-6f); }
#define ZV(ai, bj, m, n) (acc[ai][bj][m][n] * rsv[ai][m] + sw[bj][n])
        if (pn <= 2) {
            if (pn == 2 && wc >= 2) {
#pragma unroll
                for (int ai = 0; ai < 2; ++ai)
#pragma unroll
                    for (int m = 0; m < 4; ++m) { const int row = rbase + ai * HALF + m * 16;
                        const int kvrow = lat ? (row >> 11) * KVROWS + (row & 2047) : ((row - NLAT) >> 8) * KVROWS + 2048 + (row & 255);
                        bf16_t* p = Vb + (size_t)kvrow * 128 + (wc - 2) * 64 + 8 * fq;
#pragma unroll
                        for (int bj = 0; bj < 2; ++bj) { const f32x4 a = ZV(ai, bj, m, 0), c = ZV(ai, bj, m, 1); u32x4 w; w.x = cvt_pk_bf16(a[0], a[1]); w.y = cvt_pk_bf16(a[2], a[3]); w.z = cvt_pk_bf16(c[0], c[1]); w.w = cvt_pk_bf16(c[2], c[3]); *(u32x4*)(p + 32 * bj) = w; } }
            } else {
                const bool isq = pn < 2; const float* gp = isq ? qg : kg; const float osc = isq ? QC2 : 1.0f;
                f32x4 gn[2][2];
#pragma unroll
                for (int bj = 0; bj < 2; ++bj)
#pragma unroll
                    for (int n = 0; n < 2; ++n) gn[bj][n] = *(const f32x4*)(gp + 32 * bj + 8 * fq + 4 * n);
#pragma unroll
                for (int ai = 0; ai < 2; ++ai)
#pragma unroll
                    for (int m = 0; m < 4; ++m) { const int row = rbase + ai * HALF + m * 16;
                        float ss = 0.f;
#pragma unroll
                        for (int bj = 0; bj < 2; ++bj)
#pragma unroll
                            for (int n = 0; n < 2; ++n) { const f32x4 x = ZV(ai, bj, m, n); ss += (x[0] * x[0] + x[1] * x[1]) + (x[2] * x[2] + x[3] * x[3]); }
                        ss += __shfl_xor(ss, 16); ss += __shfl_xor(ss, 32);
                        const float rstd = __builtin_amdgcn_rsqf(ss * (1.0f / 64.0f) + 1e-6f);
                        f32x4 o1[2], o2[2];
#pragma unroll
                        for (int n = 0; n < 2; ++n) { o1[n] = ZV(ai, 0, m, n) * rstd * gn[0][n]; o2[n] = ZV(ai, 1, m, n) * rstd * gn[1][n]; }
                        if (lat) { const int t = row & 2047;
#pragma unroll
                            for (int n = 0; n < 2; ++n) { const f32x4 c = *(const f32x4*)(ropeC + t * 32 + 8 * fq + 4 * n), s = *(const f32x4*)(ropeS + t * 32 + 8 * fq + 4 * n);
                                const f32x4 a = o1[n] * c - o2[n] * s, bq = o1[n] * s + o2[n] * c; o1[n] = a; o2[n] = bq; } }
                        bf16_t* p;
                        if (isq) p = Q + (size_t)row * 512 + (4 * pn + wc) * 64 + 8 * fq;
                        else { const int kvrow = lat ? (row >> 11) * KVROWS + (row & 2047) : ((row - NLAT) >> 8) * KVROWS + 2048 + (row & 255); p = Kb + (size_t)kvrow * 128 + wc * 64 + 8 * fq; }
                        u32x4 w;
                        w.x = cvt_pk_bf16(o1[0][0] * osc, o1[0][1] * osc); w.y = cvt_pk_bf16(o1[0][2] * osc, o1[0][3] * osc); w.z = cvt_pk_bf16(o1[1][0] * osc, o1[1][1] * osc); w.w = cvt_pk_bf16(o1[1][2] * osc, o1[1][3] * osc);
                        *(u32x4*)p = w;
                        w.x = cvt_pk_bf16(o2[0][0] * osc, o2[0][1] * osc); w.y = cvt_pk_bf16(o2[0][2] * osc, o2[0][3] * osc); w.z = cvt_pk_bf16(o2[1][0] * osc, o2[1][1] * osc); w.w = cvt_pk_bf16(o2[1][2] * osc, o2[1][3] * osc);
                        *(u32x4*)(p + 32) = w; }
            }
        } else if (pn == 3) {
#pragma unroll
            for (int ai = 0; ai < 2; ++ai)
#pragma unroll
                for (int m = 0; m < 4; ++m) { const int row = rbase + ai * HALF + m * 16; bf16_t* p = UP + (size_t)row * 256 + wc * 32 + 8 * fq;
#pragma unroll
                    for (int bj = 0; bj < 2; ++bj) { const f32x4 a = ZV(ai, bj, m, 0), c = ZV(ai, bj, m, 1); u32x4 w; w.x = cvt_pk_bf16(a[0], a[1]); w.y = cvt_pk_bf16(a[2], a[3]); w.z = cvt_pk_bf16(c[0], c[1]); w.w = cvt_pk_bf16(c[2], c[3]); *(u32x4*)(p + HALF * bj) = w; } }
        } else {
            const int half = pn - 4;
#pragma unroll
            for (int ai = 0; ai < 2; ++ai)
#pragma unroll
                for (int m = 0; m < 4; ++m) { const int row = rbase + ai * HALF + m * 16;
                    if (lat) { const int b = row >> 11, t = row & 2047; bf16_t* p = VT + ((size_t)b * 256 + 32 * wc + 8 * fq) * 4096 + half * 2048 + t; asm volatile("" : "+v"(p)); __attribute__((address_space(1))) bf16_t* gp = (__attribute__((address_space(1))) bf16_t*)p;
#pragma unroll
                        for (int bj = 0; bj < 2; ++bj)
#pragma unroll
                            for (int n = 0; n < 2; ++n)
#pragma unroll
                                for (int e = 0; e < 4; ++e) gp[(size_t)(128 * bj + 4 * n + e) * 4096] = (bf16_t)f2bf1(ZV(ai, bj, m, n)[e]); }
                    else { const int b = (row - NLAT) >> 8, t = row & 255; bf16_t* p = VTC + ((size_t)b * 256 + 32 * wc + 8 * fq) * 512 + half * 256 + t; asm volatile("" : "+v"(p)); __attribute__((address_space(1))) bf16_t* gp = (__attribute__((address_space(1))) bf16_t*)p;
#pragma unroll
                        for (int bj = 0; bj < 2; ++bj)
#pragma unroll
                            for (int n = 0; n < 2; ++n)
#pragma unroll
                                for (int e = 0; e < 4; ++e) gp[(size_t)(128 * bj + 4 * n + e) * 512] = (bf16_t)f2bf1(ZV(ai, bj, m, n)[e]); } }
        }
    }
#undef ZV
};
struct EpiDFT {
    static constexpr bool PERM = true, AFTER_DRAIN = false;
    bf16_t* AM; int rowbase, L; float sc;
    __device__ __forceinline__ void operator()(const f32x4 (&acc)[2][2][4][2], const Unit& u, int wr, int wc, int fr, int fq) const {
        asm volatile("" : "+v"(fr), "+v"(fq));
        const int r0 = rowbase + u.pn * L + u.pm * BM + wr * 64 + fr;
#pragma unroll
        for (int ai = 0; ai < 2; ++ai)
#pragma unroll
            for (int m = 0; m < 4; ++m) { bf16_t* p = AM + (size_t)(r0 + ai * HALF + m * 16) * DMODEL + 768 + wc * 32 + 8 * fq;
#pragma unroll
                for (int bj = 0; bj < 2; ++bj) { const f32x4 a = acc[ai][bj][m][0] * sc, c = acc[ai][bj][m][1] * sc; u32x4 w; w.x = cvt_pk_bf16(a[0], a[1]); w.y = cvt_pk_bf16(a[2], a[3]); w.z = cvt_pk_bf16(c[0], c[1]); w.w = cvt_pk_bf16(c[2], c[3]); *(u32x4*)(p + HALF * bj) = w; } }
    }
};
struct EpiDummy {
    static constexpr bool PERM = true, AFTER_DRAIN = false;
    float* X;
    __device__ __forceinline__ void operator()(const f32x4 (&acc)[2][2][4][2], const Unit& u, int wr, int wc, int fr, int fq) const {
        f32x4 t = {0.f, 0.f, 0.f, 0.f};
#pragma unroll
        for (int ai = 0; ai < 2; ++ai)
#pragma unroll
            for (int bj = 0; bj < 2; ++bj)
#pragma unroll
                for (int m = 0; m < 4; ++m)
#pragma unroll
                    for (int n = 0; n < 2; ++n) t += acc[ai][bj][m][n];
        if (t[0] + t[1] + t[2] + t[3] == 12345.6789f) X[0] = 1.0f;
    }
};
template <class Epi, class Sched, bool ALIGN_EPI = false, bool SP2 = false>
__device__ __forceinline__ void gemm_phase(PG8_LAS unsigned char* lds, const Gemm g, const Sched& S, const Epi& E) {
    const int tid = fresh_tid(), wid = __builtin_amdgcn_readfirstlane(tid >> 6), lane = tid & 63, wr = wid >> 2, wc = wid & 3, fr = lane & 15, fq = lane >> 4;
    const int K = g.K, nt = K / BK;
    const int pitchA = g.ablk ? BK : K;
    unsigned voffA[2], voffB[2];
#pragma unroll
    for (int i = 0; i < 2; ++i) { int R, C; stage_rc(tid * 16 + i * 8192, R, C); const int Rb = Epi::PERM ? ((R & ~31) + perm32(R & 31)) : R;
        voffA[i] = (unsigned)(R * pitchA + C) * 2u; voffB[i] = (unsigned)(Rb * K + C) * 2u; }
    const size_t kstep = (size_t)(BK * 2);
    const size_t hstep = (size_t)HALF * K * 2;
    const size_t kstepA = g.ablk ? (size_t)BM * BK * 2 : kstep, hstepA = (size_t)HALF * pitchA * 2;
    const size_t tstep = 2 * hstep;
    const unsigned ldsw = (unsigned)wid * 1024u;
    const int aoff = lds_byte(wr * 64 + fr, fq * 8), boff = lds_byte(wc * 32 + fr, fq * 8);
#define PG8_SA(b, h) (((b) * 2 + (h)) * HTB)
#define PG8_SB(b, h) ((4 + (b) * 2 + (h)) * HTB)
#define PG8_STAGE(bufoff, gbase, voff) do { _Pragma("unroll") for (int _i = 0; _i < 2; ++_i) \
        __builtin_amdgcn_global_load_lds((const unsigned*)((const char*)(gbase) + (voff)[_i]), (PG8_LAS unsigned*)(lds + (bufoff) + ldsw + _i * 8192), 16, 0, 0); } while (0)
#define PG8_LDA(dst, b, h) do { _Pragma("unroll") for (int m = 0; m < 4; ++m) _Pragma("unroll") for (int k = 0; k < 2; ++k) dst[m][k] = *(const PG8_LAS bf16x8*)(lds + PG8_SA(b, h) + aoff + m * 2048 + k * 1024); } while (0)
#define PG8_LDB(dst, b, h) do { _Pragma("unroll") for (int n = 0; n < 2; ++n) _Pragma("unroll") for (int k = 0; k < 2; ++k) dst[n][k] = *(const PG8_LAS bf16x8*)(lds + PG8_SB(b, h) + boff + n * 2048 + k * 1024); } while (0)
#define PG8_MMA(ai, bj, At, Bt) do { __builtin_amdgcn_s_setprio(1); _Pragma("unroll") for (int m = 0; m < 4; ++m) _Pragma("unroll") for (int n = 0; n < 2; ++n) _Pragma("unroll") for (int k = 0; k < 2; ++k) \
        acc[ai][bj][m][n] = __builtin_amdgcn_mfma_f32_16x16x32_bf16(Bt[n][k], At[m][k], acc[ai][bj][m][n], 0, 0, 0); __builtin_amdgcn_s_setprio(0); } while (0)
#define PG8_WAIT_V(n) asm volatile("s_waitcnt vmcnt(" #n ")" ::: "memory")
#define PG8_WAIT_L(n) asm volatile("s_waitcnt lgkmcnt(" #n ")" ::: "memory")
#define PG8_BAR __builtin_amdgcn_s_barrier()
#define PG8_SCHED __builtin_amdgcn_sched_barrier(0)
    Unit cur, nxt; int ui = 0;
    if (!S.next(0, cur)) return;
    f32x4 acc[2][2][4][2];
#pragma unroll
    for (int a = 0; a < 2; ++a)
#pragma unroll
        for (int b = 0; b < 2; ++b)
#pragma unroll
            for (int m = 0; m < 4; ++m)
#pragma unroll
                for (int n = 0; n < 2; ++n) acc[a][b][m][n] = (f32x4){0.f, 0.f, 0.f, 0.f};
    bf16x8 At[4][2], B0[2][2], B1[2][2];
    const char* cA = (const char*)g.A + (size_t)cur.pm * tstep; const char* cB = (const char*)g.Bt + (size_t)cur.pn * tstep;
    S.a_ready(cur);
    if constexpr (SP2) {
        PG8_STAGE(PG8_SB(0, 0), cB, voffB); PG8_STAGE(PG8_SB(0, 1), cB + hstep, voffB); PG8_STAGE(PG8_SA(0, 0), cA, voffA); PG8_STAGE(PG8_SA(0, 1), cA + hstepA, voffA);
        if (wr == 1) PG8_BAR;
        PG8_WAIT_V(2); PG8_BAR;
        PG8_STAGE(PG8_SB(1, 0), cB + kstep, voffB); PG8_STAGE(PG8_SA(1, 0), cA + kstepA, voffA); PG8_STAGE(PG8_SB(1, 1), cB + hstep + kstep, voffB);
        PG8_WAIT_V(6); PG8_BAR;
    } else {
        PG8_STAGE(PG8_SB(0, 0), cB, voffB); PG8_STAGE(PG8_SA(0, 0), cA, voffA); PG8_STAGE(PG8_SB(0, 1), cB + hstep, voffB); PG8_STAGE(PG8_SA(0, 1), cA + hstepA, voffA);
        if (wr == 1) PG8_BAR;
        PG8_WAIT_V(4); PG8_BAR;
        PG8_STAGE(PG8_SB(1, 0), cB + kstep, voffB); PG8_STAGE(PG8_SA(1, 0), cA + kstepA, voffA); PG8_STAGE(PG8_SB(1, 1), cB + hstep + kstep, voffB);
        PG8_WAIT_V(6); PG8_BAR;
    }
    for (;;) {
        const bool has_next = S.next(ui + 1, nxt);
        const char* nA = has_next ? (const char*)g.A + (size_t)nxt.pm * tstep : cA; const char* nB = has_next ? (const char*)g.Bt + (size_t)nxt.pn * tstep : cB;
        for (int t = 0; t < nt; t += 2) {
            const bool last = (t == nt - 2);
            const char* a1 = cA + (size_t)(t + 1) * kstepA;
            const char* a2 = last ? nA : cA + (size_t)(t + 2) * kstepA; const char* b2 = last ? nB : cB + (size_t)(t + 2) * kstep;
            const char* a3 = a2 + kstepA; const char* b3 = b2 + kstep;
            if (last && has_next) S.a_ready(nxt);
            if constexpr (SP2) {
            PG8_LDB(B0, 0, 0); PG8_LDB(B1, 0, 1); PG8_SCHED; PG8_LDA(At, 0, 0); PG8_STAGE(PG8_SA(1, 1), a1 + hstepA, voffA);
            PG8_WAIT_V(8); PG8_WAIT_L(0); PG8_BAR; PG8_MMA(0, 0, At, B0); PG8_MMA(0, 1, At, B1); PG8_BAR; PG8_SCHED;
            PG8_LDA(At, 0, 1); PG8_STAGE(PG8_SB(0, 0), b2, voffB); PG8_STAGE(PG8_SB(0, 1), b2 + hstep, voffB); PG8_STAGE(PG8_SA(0, 0), a2, voffA);
            PG8_WAIT_V(8); PG8_WAIT_L(0); PG8_BAR; PG8_MMA(1, 0, At, B0); PG8_MMA(1, 1, At, B1); PG8_BAR; PG8_SCHED;
            PG8_LDB(B0, 1, 0); PG8_LDB(B1, 1, 1); PG8_SCHED; PG8_LDA(At, 1, 0); PG8_STAGE(PG8_SA(0, 1), a2 + hstepA, voffA);
            PG8_WAIT_V(8); PG8_WAIT_L(0); PG8_BAR; PG8_MMA(0, 0, At, B0); PG8_MMA(0, 1, At, B1); PG8_BAR; PG8_SCHED;
            PG8_LDA(At, 1, 1); PG8_STAGE(PG8_SB(1, 0), b3, voffB); PG8_STAGE(PG8_SB(1, 1), b3 + hstep, voffB); PG8_STAGE(PG8_SA(1, 0), a3, voffA);
            PG8_WAIT_V(8); PG8_WAIT_L(0); PG8_BAR; PG8_MMA(1, 0, At, B0); PG8_MMA(1, 1, At, B1); PG8_BAR; PG8_SCHED;
            } else {
            PG8_LDB(B0, 0, 0); PG8_SCHED; PG8_LDA(At, 0, 0); PG8_STAGE(PG8_SA(1, 1), a1 + hstepA, voffA);
            PG8_WAIT_L(8); PG8_BAR; PG8_WAIT_L(0); PG8_MMA(0, 0, At, B0); PG8_BAR; PG8_SCHED;
            PG8_LDB(B1, 0, 1); PG8_STAGE(PG8_SB(0, 0), b2, voffB);
            PG8_BAR; PG8_WAIT_L(0); PG8_MMA(0, 1, At, B1); PG8_BAR;
            PG8_LDA(At, 0, 1); PG8_STAGE(PG8_SA(0, 0), a2, voffA);
            PG8_BAR; PG8_WAIT_L(0); PG8_MMA(1, 0, At, B0); PG8_BAR; PG8_SCHED;
            PG8_STAGE(PG8_SB(0, 1), b2 + hstep, voffB);
            PG8_WAIT_V(6); PG8_BAR; PG8_MMA(1, 1, At, B1); PG8_BAR;
            PG8_LDB(B0, 1, 0); PG8_SCHED; PG8_LDA(At, 1, 0); PG8_STAGE(PG8_SA(0, 1), a2 + hstepA, voffA);
            PG8_WAIT_L(8); PG8_BAR; PG8_WAIT_L(0); PG8_MMA(0, 0, At, B0); PG8_BAR; PG8_SCHED;
            PG8_LDB(B1, 1, 1); PG8_STAGE(PG8_SB(1, 0), b3, voffB);
            PG8_BAR; PG8_WAIT_L(0); PG8_MMA(0, 1, At, B1); PG8_BAR;
            PG8_LDA(At, 1, 1); PG8_STAGE(PG8_SA(1, 0), a3, voffA);
            PG8_BAR; PG8_WAIT_L(0); PG8_MMA(1, 0, At, B0); PG8_BAR; PG8_SCHED;
            PG8_STAGE(PG8_SB(1, 1), b3 + hstep, voffB);
            PG8_WAIT_V(6); PG8_BAR; PG8_MMA(1, 1, At, B1); PG8_BAR;
            }
        }
        if constexpr (ALIGN_EPI) { if (wr == 0) PG8_BAR; }
        if constexpr (!Epi::AFTER_DRAIN) { E(acc, cur, wr, wc, fr, fq); S.done(cur); }
        if (!has_next) break;
#pragma unroll
        for (int a = 0; a < 2; ++a)
#pragma unroll
            for (int b = 0; b < 2; ++b)
#pragma unroll
                for (int m = 0; m < 4; ++m)
#pragma unroll
                    for (int n = 0; n < 2; ++n) acc[a][b][m][n] = (f32x4){0.f, 0.f, 0.f, 0.f};
        cur = nxt; cA = nA; cB = nB; ++ui;
        if constexpr (ALIGN_EPI) { if (wr == 1) PG8_BAR; }
    }
    PG8_WAIT_V(0);
    if constexpr (!ALIGN_EPI) { if (wr == 0) PG8_BAR; }
    PG8_BAR;
    if constexpr (Epi::AFTER_DRAIN) { E.fused(acc, cur, wr, wc, fr, fq, lds, wid, lane); S.done(cur); }
#undef PG8_SA
#undef PG8_SB
#undef PG8_STAGE
#undef PG8_LDA
#undef PG8_LDB
#undef PG8_MMA
#undef PG8_WAIT_V
#undef PG8_WAIT_L
#undef PG8_BAR
#undef PG8_SCHED
}
}
#include <hip/hip_bf16.h>
#include <cmath>
namespace attn_body {
using bf16=__hip_bfloat16;
using bf16x8=__attribute__((ext_vector_type(8)))short;
using s16x4=__attribute__((ext_vector_type(4)))short;
using f32x16=__attribute__((ext_vector_type(16)))float;
using u32x4=__attribute__((ext_vector_type(4)))unsigned;
constexpr int D=64,QP=512,KVP=128,OP=1024;
constexpr int NW=8,QBLK=32,QB=QBLK*NW,KVBLK=64;
__device__ __forceinline__ int crow(int r,int hi){return (r&3)+8*(r>>2)+4*hi;}
#define SBAR() __builtin_amdgcn_sched_barrier(0)
constexpr int NSLOT=3, SLOTB=8192;
constexpr int LDS_K=0, LDS_V=NSLOT*SLOTB, LDS_WS=2*NSLOT*SLOTB, LDS_OST=LDS_WS+NW*64*4, LDS_BYTES=LDS_OST+NW*4096;
constexpr float C2=0.125f*1.4426950408889634f;
__device__ __forceinline__ void glds16(const void*gsrc,unsigned lds_dst){unsigned keep;
  asm volatile("s_mov_b32 %0, m0\n\ts_mov_b32 m0, %2\n\ts_nop 0\n\tglobal_load_lds_dwordx4 %1, off\n\ts_mov_b32 m0, %0":"=&s"(keep):"v"(gsrc),"s"(lds_dst):"memory");}
__device__ __forceinline__ float max3f(float a,float b,float c){float r;asm("v_max3_f32 %0, %1, %2, %3":"=v"(r):"v"(a),"v"(b),"v"(c));return r;}
__device__ __forceinline__ float max2f(float a,float b){float r;asm("v_max_f32_e32 %0, %1, %2":"=v"(r):"v"(a),"v"(b));return r;}
__device__ __forceinline__ float fadd_s(float a,float b){float r;asm("v_add_f32_e32 %0, %1, %2":"=v"(r):"v"(a),"v"(b));return r;}
__device__ __forceinline__ float fsub_s(float a,float b){float r;asm("v_sub_f32_e32 %0, %1, %2":"=v"(r):"v"(a),"v"(b));return r;}
typedef float f32x2_t __attribute__((ext_vector_type(2))); typedef __bf16 bf16x2_t __attribute__((ext_vector_type(2)));
__device__ __forceinline__ unsigned cvtpk_s(float lo,float hi){f32x2_t v={lo,hi};bf16x2_t b=__builtin_convertvector(v,bf16x2_t);return __builtin_bit_cast(unsigned,b);}
#define WAIT_BAR(N) asm volatile("s_waitcnt vmcnt(" #N ") lgkmcnt(0)\n\ts_barrier":::"memory")

__device__ __forceinline__ void qkt(f32x16&p0,f32x16&p1,const char*Kslot,const bf16x8*qr,const f32x16&negm,int r32,int hi){
  const char*kb=Kslot+hi*1024+r32*16;
  #pragma unroll
  for(int d0=0;d0<4;++d0){
    const bf16x8 b0=*reinterpret_cast<const bf16x8*>(kb+d0*2048);
    const bf16x8 b1=*reinterpret_cast<const bf16x8*>(kb+d0*2048+512);
    if(d0==0){p0=__builtin_amdgcn_mfma_f32_32x32x16_bf16(b0,qr[0],negm,0,0,0);p1=__builtin_amdgcn_mfma_f32_32x32x16_bf16(b1,qr[0],negm,0,0,0);}
    else{p0=__builtin_amdgcn_mfma_f32_32x32x16_bf16(b0,qr[d0],p0,0,0,0);p1=__builtin_amdgcn_mfma_f32_32x32x16_bf16(b1,qr[d0],p1,0,0,0);}}
}
typedef __attribute__((address_space(3))) const char* lds_cptr;
typedef short v4i16_t __attribute__((ext_vector_type(4)));
__device__ __forceinline__ void kload8(bf16x8*kf,lds_cptr kp){
  kf[0]=*(const __attribute__((address_space(3))) bf16x8*)(kp);      kf[1]=*(const __attribute__((address_space(3))) bf16x8*)(kp+512);
  kf[2]=*(const __attribute__((address_space(3))) bf16x8*)(kp+2048); kf[3]=*(const __attribute__((address_space(3))) bf16x8*)(kp+2560);
  kf[4]=*(const __attribute__((address_space(3))) bf16x8*)(kp+4096); kf[5]=*(const __attribute__((address_space(3))) bf16x8*)(kp+4608);
  kf[6]=*(const __attribute__((address_space(3))) bf16x8*)(kp+6144); kf[7]=*(const __attribute__((address_space(3))) bf16x8*)(kp+6656);
}
__device__ __forceinline__ void kload2(bf16x8*kf,lds_cptr kp,int j){ kf[2*j]=*(const __attribute__((address_space(3))) bf16x8*)(kp+j*2048); kf[2*j+1]=*(const __attribute__((address_space(3))) bf16x8*)(kp+j*2048+512); }
__device__ __forceinline__ s16x4 vtr(lds_cptr p){ return __builtin_bit_cast(s16x4,__builtin_amdgcn_ds_read_tr16_b64_v4i16((__attribute__((address_space(3))) v4i16_t*)p)); }
__device__ __forceinline__ float rowmax(const f32x16&p0,const f32x16&p1){
  float a=max3f(p0[0],p0[1],p1[0]),b=max3f(p0[2],p0[3],p1[1]);a=max3f(a,p1[2],p1[3]);
  #pragma unroll
  for(int r=4;r<16;r+=4){a=max3f(a,p0[r],p0[r+1]);b=max3f(b,p0[r+2],p0[r+3]);a=max3f(a,p1[r],p1[r+1]);b=max3f(b,p1[r+2],p1[r+3]);}
  const float m=max2f(a,b);
  auto rr=__builtin_amdgcn_permlane32_swap(__float_as_uint(m),__float_as_uint(m),false,false);
  return max2f(__uint_as_float(rr[0]),__uint_as_float(rr[1]));
}
__device__ __forceinline__ void pv(f32x16*o,int vb,bf16x8 pa0,bf16x8 pa1,bf16x8 pa2,bf16x8 pa3){
  #pragma unroll
  for(int d0=0;d0<2;++d0){s16x4 lo[4],hi[4];
    #pragma unroll
    for(int ks=0;ks<4;++ks){
      asm volatile("ds_read_b64_tr_b16 %0,%1 offset:%c2":"=&v"(lo[ks]):"v"(vb),"i"(d0*4096+ks*1024):"memory");
      asm volatile("ds_read_b64_tr_b16 %0,%1 offset:%c2":"=&v"(hi[ks]):"v"(vb),"i"(d0*4096+ks*1024+512):"memory");}
    asm volatile("s_waitcnt lgkmcnt(0)":::"memory");SBAR();
    #define PK(k) (bf16x8){lo[k][0],lo[k][1],lo[k][2],lo[k][3],hi[k][0],hi[k][1],hi[k][2],hi[k][3]}
    o[d0]=__builtin_amdgcn_mfma_f32_32x32x16_bf16(pa0,PK(0),o[d0],0,0,0);
    o[d0]=__builtin_amdgcn_mfma_f32_32x32x16_bf16(pa1,PK(1),o[d0],0,0,0);
    o[d0]=__builtin_amdgcn_mfma_f32_32x32x16_bf16(pa2,PK(2),o[d0],0,0,0);
    o[d0]=__builtin_amdgcn_mfma_f32_32x32x16_bf16(pa3,PK(3),o[d0],0,0,0);
    #undef PK
  }
}

#ifndef ATTN_STORE16
#define ATTN_STORE16(p,v) (*(u32x4*)(p)=(v))
#endif
template<int THRL> __device__ __forceinline__ void attn_unit(const bf16*Qb,const bf16*Kh,const bf16*Vh,bf16*Ob,const int NT,char*shm){
  const int tid=fresh_tid(),lane=tid&63,r32=lane&31,hi=lane>>5; const int wid=__builtin_amdgcn_readfirstlane(tid>>6);
  const bf16*Qw=Qb+(long)(wid*QBLK)*QP;
  const unsigned lds0=(unsigned)(uintptr_t)shm;
  float*wsf=(float*)(shm+LDS_WS)+wid*64;
  const bf16*ksrc=Kh+(long)lane*KVP+wid*8;
  const bf16*vsrc=Vh+(long)(16*(wid&3)+(lane>>2))*KVP+(wid>>2)*32+(lane&3)*8;
  const unsigned kdst=lds0+LDS_K+wid*1024, vdst=lds0+LDS_V+wid*1024;
  #define DMA_K(t,slot) glds16(ksrc+(long)(t)*KVBLK*KVP,(unsigned)__builtin_amdgcn_readfirstlane(kdst+(slot)))
  #define DMA_V(t,slot) glds16(vsrc+(long)(t)*KVBLK*KVP,(unsigned)__builtin_amdgcn_readfirstlane(vdst+(slot)))
  const int vb0=(int)(lds0+LDS_V)+((lane>>4)&1)*32+(lane&3)*8+(4*hi+((lane&15)>>2))*64;
  const char*Kbase=shm+LDS_K; bf16x8 kf[8];
  const lds_cptr shm3=(lds_cptr)shm; const lds_cptr kp0=shm3+LDS_K+hi*1024+r32*16; const lds_cptr vp0=shm3+LDS_V+((lane>>4)&1)*32+(lane&3)*8+(4*hi+((lane&15)>>2))*64;
  DMA_K(0,0);DMA_V(0,0);DMA_K(1,SLOTB);
  bf16x8 qr[4];
  #pragma unroll
  for(int d0=0;d0<4;++d0)qr[d0]=*reinterpret_cast<const bf16x8*>(&Qw[(long)r32*QP+d0*16+hi*8]);
  float mhat=0.f,l_reg=0.f;f32x16 o[2];o[0]=f32x16{};o[1]=f32x16{};f32x16 negm=f32x16{};asm volatile("":"+v"(negm));
  const int qrel=wid*QBLK+r32;
  #define CMASK(P0,P1,t) do{}while(0)
  bool resc=false;
  #define START(P0,P1) do{ const float rm=rowmax(P0,P1); resc=false; \
    { const float dl=rm; mhat=fadd_s(mhat,dl); \
      _Pragma("unroll") for(int r=0;r<16;++r){P0[r]=fsub_s(P0[r],dl);P1[r]=fsub_s(P1[r],dl);} \
      _Pragma("unroll") for(int r=0;r<16;++r)negm[r]=-mhat; asm volatile("":"+v"(negm)); } \
    _Pragma("unroll") for(int r=0;r<16;++r)P0[r]=__builtin_amdgcn_exp2f(P0[r]); }while(0)
  #define RESC() do{ if(resc){ asm volatile("s_waitcnt lgkmcnt(0)":::"memory"); \
      _Pragma("unroll") for(int d_=0;d_<2;++d_) _Pragma("unroll") for(int r=0;r<16;++r)o[d_][r]*=wsf[crow(r,hi)]; } }while(0)
  f32x16 pA0,pA1,pB0,pB1;
  int sl_prev=0,sl_cur=0,sl_next=SLOTB;
  #define ROT() do{sl_prev=sl_cur;sl_cur=sl_next;sl_next=(sl_next==(NSLOT-1)*SLOTB)?0:sl_next+SLOTB;}while(0)
  DMA_K(2,2*SLOTB);
  WAIT_BAR(3);
  qkt(pA0,pA1,Kbase,qr,negm,r32,hi);asm volatile("s_nop 15\n\ts_nop 7":"+v"(pA0),"+v"(pA1));CMASK(pA0,pA1,0);
  START(pA0,pA1);
  _Pragma("unroll") for(int r=0;r<16;++r)pA1[r]=__builtin_amdgcn_exp2f(pA1[r]);
  WAIT_BAR(0);
  DMA_K(3,0);DMA_V(1,SLOTB);
  ROT();
  kload8(kf,kp0+sl_cur);
  WAIT_BAR(2);
  s16x4 vlo[8],vhi[8]; u32x4 pw0,pw1,pw2,pw3;
  #define PKW(P,B) cvtpk_s(P[B],P[B+1])
  #define PAF(k) __builtin_bit_cast(bf16x8,pw##k)
  #define VFR(i) (bf16x8){vlo[i][0],vlo[i][1],vlo[i][2],vlo[i][3],vhi[i][0],vhi[i][1],vhi[i][2],vhi[i][3]}
  #define PIN(x) asm volatile("":"+v"(x))
  #define MX3(a,b,c) __builtin_fmaxf(__builtin_fmaxf((a),(b)),(c))
  #define GAPA(MF,A0,A1,A2,A3,W0,W1,PW) do{ MF; sacc+=A0; sacc+=A1; sacc+=A2; sacc+=A3; PIN(sacc); W0; W1; PIN(PW); SBAR(); }while(0)
  #define EX(v) __builtin_amdgcn_exp2f(v)
  #define GAPB(MF,X,B) do{ MF; X[B]=EX(X[B]); X[B+1]=EX(X[B+1]); X[B+2]=EX(X[B+2]); X[B+3]=EX(X[B+3]); PIN(X); SBAR(); }while(0)
  #define VRD(i) do{ vlo[i]=vtr(vp_+(((i)>>2)*4096+((i)&3)*1024)); vhi[i]=vtr(vp_+(((i)>>2)*4096+((i)&3)*1024+512)); }while(0)
  #define KRD(G,j) do{ if(G){ kload2(kf,kp0+sl_next,j); SBAR(); } }while(0)
  #define STEP(C0,C1,P0,P1,t,GK,GV,GL) do{ SBAR(); \
    const lds_cptr vp_=vp0+sl_prev; \
    VRD(0); SBAR(); float sacc=(P0[0]+P0[1]); \
    GAPA(C0=__builtin_amdgcn_mfma_f32_32x32x16_bf16(kf[0],qr[0],negm,0,0,0), P0[2],P0[3],P0[4],P0[5],     pw0[0]=PKW(P0,0), pw0[1]=PKW(P0,2), pw0); \
    VRD(4); SBAR(); GAPA(C1=__builtin_amdgcn_mfma_f32_32x32x16_bf16(kf[1],qr[0],negm,0,0,0), P0[6],P0[7],P0[8],P0[9],     pw0[2]=PKW(P0,4), pw0[3]=PKW(P0,6), pw0); \
    VRD(1); SBAR(); GAPA(C0=__builtin_amdgcn_mfma_f32_32x32x16_bf16(kf[2],qr[1],C0,0,0,0),   P0[10],P0[11],P0[12],P0[13], pw1[0]=PKW(P0,8), pw1[1]=PKW(P0,10), pw1); \
    VRD(5); SBAR(); GAPA(C1=__builtin_amdgcn_mfma_f32_32x32x16_bf16(kf[3],qr[1],C1,0,0,0),   P0[14],P0[15],P1[0],P1[1],   pw1[2]=PKW(P0,12),pw1[3]=PKW(P0,14), pw1); \
    VRD(2); SBAR(); GAPA(C0=__builtin_amdgcn_mfma_f32_32x32x16_bf16(kf[4],qr[2],C0,0,0,0),   P1[2],P1[3],P1[4],P1[5],     pw2[0]=PKW(P1,0), pw2[1]=PKW(P1,2), pw2); \
    VRD(6); SBAR(); GAPA(C1=__builtin_amdgcn_mfma_f32_32x32x16_bf16(kf[5],qr[2],C1,0,0,0),   P1[6],P1[7],P1[8],P1[9],     pw2[2]=PKW(P1,4), pw2[3]=PKW(P1,6), pw2); \
    VRD(3); SBAR(); GAPA(C0=__builtin_amdgcn_mfma_f32_32x32x16_bf16(kf[6],qr[3],C0,0,0,0),   P1[10],P1[11],P1[12],P1[13], pw3[0]=PKW(P1,8), pw3[1]=PKW(P1,10), pw3); \
    VRD(7); SBAR(); GAPA(C1=__builtin_amdgcn_mfma_f32_32x32x16_bf16(kf[7],qr[3],C1,0,0,0),   P1[14],P1[15],0.f,0.f,       pw3[2]=PKW(P1,12),pw3[3]=PKW(P1,14), pw3); \
    l_reg+=sacc; \
    if(GK){DMA_K((t)+3,sl_cur);} if(GV){DMA_V((t)+1,sl_next);} \
    CMASK(C0,C1,t); \
    { float a=MX3(C0[0],C0[1],C1[0]),b=MX3(C0[2],C0[3],C1[1]); a=MX3(a,C1[2],C1[3]); \
      _Pragma("unroll") for(int r=4;r<16;r+=4){a=MX3(a,C0[r],C0[r+1]);b=MX3(b,C0[r+2],C0[r+3]);a=MX3(a,C1[r],C1[r+1]);b=MX3(b,C1[r+2],C1[r+3]);} \
      float rm=__builtin_fmaxf(a,b); { auto rr=__builtin_amdgcn_permlane32_swap(__float_as_uint(rm),__float_as_uint(rm),false,false); rm=__builtin_fmaxf(__uint_as_float(rr[0]),__uint_as_float(rr[1])); } \
      resc=false; \
      if(__builtin_expect(__any(rm>(float)THRL),0)){ const float dl=__builtin_fmaxf(rm,0.f); mhat+=dl; \
        _Pragma("unroll") for(int r=0;r<16;++r){C0[r]-=dl;C1[r]-=dl;} \
        _Pragma("unroll") for(int r=0;r<16;++r)negm[r]=-mhat; asm volatile("":"+v"(negm)); \
        const float f=__builtin_amdgcn_exp2f(-dl); l_reg*=f; if(hi==0)wsf[r32]=f; resc=true; } } \
    SBAR(); \
    GAPB(o[0]=__builtin_amdgcn_mfma_f32_32x32x16_bf16(PAF(0),VFR(0),o[0],0,0,0), C0,0); \
    GAPB(o[1]=__builtin_amdgcn_mfma_f32_32x32x16_bf16(PAF(0),VFR(4),o[1],0,0,0), C0,4); \
    KRD(GL,0); GAPB(o[0]=__builtin_amdgcn_mfma_f32_32x32x16_bf16(PAF(1),VFR(1),o[0],0,0,0), C0,8); \
    KRD(GL,1); GAPB(o[1]=__builtin_amdgcn_mfma_f32_32x32x16_bf16(PAF(1),VFR(5),o[1],0,0,0), C0,12); \
    KRD(GL,2); GAPB(o[0]=__builtin_amdgcn_mfma_f32_32x32x16_bf16(PAF(2),VFR(2),o[0],0,0,0), C1,0); \
    KRD(GL,3); GAPB(o[1]=__builtin_amdgcn_mfma_f32_32x32x16_bf16(PAF(2),VFR(6),o[1],0,0,0), C1,4); \
    GAPB(o[0]=__builtin_amdgcn_mfma_f32_32x32x16_bf16(PAF(3),VFR(3),o[0],0,0,0), C1,8); \
    GAPB(o[1]=__builtin_amdgcn_mfma_f32_32x32x16_bf16(PAF(3),VFR(7),o[1],0,0,0), C1,12); \
    }while(0)
  int t=1;
  #undef CMASK
  #define CMASK(P0,P1,t) do{}while(0)
  for(;t+5<NT;t+=2){
    STEP(pB0,pB1,pA0,pA1,t,true,true,true);     WAIT_BAR(2); RESC(); ROT();
    STEP(pA0,pA1,pB0,pB1,t+1,true,true,true);   WAIT_BAR(2); RESC(); ROT();
  }
  #undef CMASK
  #define CMASK(P0,P1,t) do{}while(0)
  #define ENDW(tt) do{ if((tt)+3<NT){WAIT_BAR(2);} else if((tt)+2<NT){WAIT_BAR(1);} else {WAIT_BAR(0);} }while(0)
  for(;t+1<NT;t+=2){
    STEP(pB0,pB1,pA0,pA1,t,(t+3<NT),(t+1<NT),(t+1<NT));       ENDW(t);   RESC(); ROT();
    STEP(pA0,pA1,pB0,pB1,t+1,(t+4<NT),(t+2<NT),(t+2<NT));     ENDW(t+1); RESC(); ROT();
  }
  STEP(pB0,pB1,pA0,pA1,NT-1,false,false,false); RESC();
  { float sacc=pB0[0]+pB0[1]; _Pragma("unroll") for(int r=2;r<16;++r)sacc+=pB0[r]; _Pragma("unroll") for(int r=0;r<16;++r)sacc+=pB1[r]; l_reg+=sacc;
    pw0=(u32x4){PKW(pB0,0),PKW(pB0,2),PKW(pB0,4),PKW(pB0,6)};pw1=(u32x4){PKW(pB0,8),PKW(pB0,10),PKW(pB0,12),PKW(pB0,14)};pw2=(u32x4){PKW(pB1,0),PKW(pB1,2),PKW(pB1,4),PKW(pB1,6)};pw3=(u32x4){PKW(pB1,8),PKW(pB1,10),PKW(pB1,12),PKW(pB1,14)};
    SBAR(); pv(o,vb0+sl_cur,PAF(0),PAF(1),PAF(2),PAF(3)); }
  #undef PKW
  #undef PAF
  #undef VFR
  #undef PIN
  #undef MX3
  #undef GAPA
  #undef GAPB
  #undef EX
  #undef VRD
  #undef KRD
  #undef STEP
  #undef ENDW
  {auto rr=__builtin_amdgcn_permlane32_swap(__float_as_uint(l_reg),__float_as_uint(l_reg),false,false);l_reg=__uint_as_float(rr[0])+__uint_as_float(rr[1]);}
  if(hi==0)wsf[32+r32]=l_reg;asm volatile("s_waitcnt lgkmcnt(0)":::"memory");
  float rli[16];
  #pragma unroll
  for(int r=0;r<16;++r)rli[r]=__builtin_amdgcn_rcpf(wsf[32+crow(r,hi)]);
  bf16*Ow=Ob+(long)(wid*QBLK)*OP;
  { bf16*stg=(bf16*)(shm+LDS_OST)+wid*2048;
    #pragma unroll
    for(int r=0;r<16;++r){const int orow=crow(r,hi);
      #pragma unroll
      for(int d0=0;d0<2;++d0)stg[orow*64+d0*32+r32]=__float2bfloat16(o[d0][r]*rli[r]);}
    asm volatile("s_waitcnt lgkmcnt(0)":::"memory");
    #pragma unroll
    for(int i=0;i<4;++i){const int row=i*8+(lane>>3),ch=lane&7; const u32x4 v=*(const u32x4*)(stg+row*64+ch*8); ATTN_STORE16(Ow+(long)row*OP+ch*8,v);} }
  asm volatile("s_waitcnt lgkmcnt(0)\n\ts_barrier":::"memory");
  #undef DMA_K
  #undef DMA_V
  #undef CMASK
  #undef START
  #undef RESC
  #undef ROT
}
constexpr int ATTN_LDS_BYTES=LDS_BYTES;
#undef SBAR
#undef WAIT_BAR
}
#define LAS __attribute__((address_space(3)))
typedef unsigned short bf16;
typedef float f32x4 __attribute__((ext_vector_type(4)));
typedef unsigned v4u __attribute__((ext_vector_type(4)));
typedef unsigned v2u __attribute__((ext_vector_type(2)));
constexpr size_t MiB = 1u << 20;
constexpr size_t WS_MOD = 1 * MiB;
constexpr size_t WS_ROPE = 6 * MiB;
constexpr size_t WS_ACAT = 7 * MiB;
constexpr size_t WS_ACATC = 23 * MiB;
constexpr size_t WS_WGU = 24 * MiB;
constexpr size_t WS_WIN = 112 * MiB;
constexpr size_t WS_WDN = 124 * MiB;
constexpr size_t WS_WOUT = 168 * MiB;
constexpr size_t WS_ZERO = 0;
constexpr size_t WS_A = 176 * MiB;
constexpr size_t WS_HID = 320 * MiB;
constexpr size_t WS_Q = WS_HID;
constexpr size_t WS_K = WS_HID + 72 * MiB;
constexpr size_t WS_V = WS_HID + 90 * MiB;
constexpr size_t WS_UP = WS_HID + 108 * MiB;
constexpr size_t WS_VT = WS_HID + 144 * MiB;
constexpr size_t WS_VTC = WS_HID + 208 * MiB;
constexpr size_t WS_MODP = WS_HID;
constexpr size_t WS_A2 = 716 * MiB;
constexpr size_t WS_SS = 860 * MiB;
constexpr size_t WS_SH = 864 * MiB;
constexpr size_t WS_SWT = 870 * MiB;
constexpr size_t WS_LO = 878 * MiB;
constexpr size_t WS_END = 950 * MiB;
constexpr int LDS_BYTES = 147456, TAB_OFF = 131072;

#define XB_TMO      128
#define XB_XCNT(j)  (256  + 64 * (j))
#define XB_XSUB(j)  (1280 + 64 * (j))
#define XB_XGEN(j)  (2304 + 64 * (j))
#define XB_TOP      3328
#define XB_TOPGEN   3392
#define XCD_BAR_WORDS 3456
#define XB_SPIN_CAP (1u << 18)

__device__ __forceinline__ unsigned xb_ld(unsigned* p)              { return __hip_atomic_load(p, __ATOMIC_RELAXED, __HIP_MEMORY_SCOPE_AGENT); }
__device__ __forceinline__ unsigned xb_add(unsigned* p, unsigned v) { return __hip_atomic_fetch_add(p, v, __ATOMIC_RELAXED, __HIP_MEMORY_SCOPE_AGENT); }
__device__ __forceinline__ unsigned xb_xcc_id() { return (unsigned)__builtin_amdgcn_s_getreg((3 << 11) | 20) & 0xFu; }
#define XB_SPIN(cond, bar) do { unsigned _sp = 0; while (cond) { __builtin_amdgcn_s_sleep(1); \
    if ((++_sp & 255u) == 0u) { if (xb_ld(&(bar)[XB_TMO])) break; if (_sp > XB_SPIN_CAP) { atomicAdd(&(bar)[XB_TMO], 1u); break; } } } } while (0)

struct XcdBarrier {
    unsigned* bar; unsigned x;
    volatile LAS unsigned* st;
};

__device__ __forceinline__ XcdBarrier xcd_barrier_post(unsigned* bar, volatile LAS unsigned* st) {
    XcdBarrier b; b.bar = bar; b.x = xb_xcc_id(); b.st = st;
    if (threadIdx.x == 0) (void)xb_add(&bar[XB_XCNT(b.x)], 1u);
    return b;
}
__device__ __forceinline__ void xcd_barrier_complete(unsigned* bar, unsigned x, unsigned& nloc, unsigned& nx) {
    const unsigned G = gridDim.x * gridDim.y * gridDim.z;
    unsigned sum, cnt, mine, sp = 0u;
    for (;;) {
        sum = 0u; cnt = 0u; mine = 0u;
#pragma unroll
        for (unsigned j = 0; j < 16; ++j) { const unsigned c = xb_ld(&bar[XB_XCNT(j)]); sum += c; cnt += (c > 0u) ? 1u : 0u; mine = (j == x) ? c : mine; }
        if (sum == G) break;
        __builtin_amdgcn_s_sleep(1);
        if ((++sp & 255u) == 0u) { if (xb_ld(&bar[XB_TMO])) break; if (sp > XB_SPIN_CAP) { atomicAdd(&bar[XB_TMO], 1u); break; } }
    }
    nloc = mine > 0u ? mine : 1u; nx = cnt > 0u ? cnt : 1u;
}

__device__ __forceinline__ void xcd_barrier(const XcdBarrier& b) {
    asm volatile("s_waitcnt vmcnt(0)" ::: "memory");
    __syncthreads();
    if (threadIdx.x == 0) {
        unsigned* bar = b.bar;
        __builtin_amdgcn_s_waitcnt(0);
        unsigned nloc = b.st[0], nx = b.st[1];
        if (nloc == 0u) { xcd_barrier_complete(bar, b.x, nloc, nx); b.st[0] = nloc; b.st[1] = nx; }
        const unsigned old = xb_add(&bar[XB_XSUB(b.x)], 1u);
        const unsigned gen = old / nloc;
        if (old + 1u == (gen + 1u) * nloc) {
            __builtin_amdgcn_fence(__ATOMIC_RELEASE, "agent");
            asm volatile("s_waitcnt vmcnt(0)" ::: "memory");
            const unsigned og = xb_add(&bar[XB_TOP], 1u);
            const unsigned tg = og / nx;
            if (og + 1u == (tg + 1u) * nx) xb_add(&bar[XB_TOPGEN], 1u);
            else XB_SPIN(xb_ld(&bar[XB_TOPGEN]) == tg, bar);
            __builtin_amdgcn_fence(__ATOMIC_ACQUIRE, "agent");
            xb_add(&bar[XB_XGEN(b.x)], 1u);
            asm volatile("s_waitcnt vmcnt(0)" ::: "memory");
        } else {
            XB_SPIN(xb_ld(&bar[XB_XGEN(b.x)]) == gen, bar);
            __builtin_amdgcn_fence(__ATOMIC_ACQUIRE, "agent");
            asm volatile("s_waitcnt vmcnt(0)" ::: "memory");
        }
    }
    __syncthreads();
}

#ifndef PROBE
#define PROBE 0
#endif
#if PROBE == 6
#define GSYNC() do { xcd_barrier(mk_xbar(args.ws, L)); xcd_barrier(mk_xbar(args.ws, L)); } while (0)
#else
#define GSYNC() xcd_barrier(mk_xbar(args.ws, L))
#endif
constexpr size_t WS_BAR = 65536;
constexpr int XB_LDS_OFF = TAB_OFF + 12288;
__device__ __forceinline__ XcdBarrier mk_xbar(unsigned char* ws, LAS unsigned char* L) { asm volatile("" : "+s"(ws)); XcdBarrier b; b.bar = (unsigned*)(ws + WS_BAR); b.x = xb_xcc_id(); b.st = (volatile LAS unsigned*)(L + XB_LDS_OFF); return b; }
struct Args { const float* in[18]; float* out; unsigned char* ws; };
constexpr int I_GU = 16 * 176, I_DN = 44 * 32, I_IN = 16 * 32, I_OUT = 8 * 32;

__device__ __forceinline__ void stagger(int ticks) {
    if (ticks > 0) { const unsigned long long t0 = __builtin_amdgcn_s_memrealtime(); while ((long long)(__builtin_amdgcn_s_memrealtime() - t0) < (long long)ticks) __builtin_amdgcn_s_sleep(8); }
}
#ifndef STG_GU
#define STG_GU 0
#endif
#ifndef STG_DN
#define STG_DN 0
#endif
#ifndef STG_OUT
#define STG_OUT 0
#endif
__device__ __forceinline__ float wave_sum(float v) {
#pragma unroll
    for (int o = 1; o < 64; o <<= 1) v += __shfl_xor(v, o);
    return v;
}
__device__ __forceinline__ unsigned pk2(float lo, float hi) { return pg8::cvt_pk_bf16(lo, hi); }
__device__ __forceinline__ int map_row(int mode, int n) {
    if (mode == 0) return n;
    if (mode == 3) return 256 * (n >> 8) + 128 * ((n >> 3) & 1) + 32 * ((n >> 6) & 3) + 8 * ((n >> 4) & 3) + (n & 7);
    if (mode == 1) { const int isu = n >= DFF ? 1 : 0; const int j = n - isu * DFF; return 256 * (j >> 7) + 128 * isu + (j & 127); }
    if (n < 512) { const int h = n >> 6, d = n & 63; return 256 * (h >> 2) + 128 * (d >> 5) + 32 * (h & 3) + (d & 31); }
    if (n < 768) { const int wc = (n - 512) >> 6, d = n & 63; return 512 + 128 * (d >> 5) + 32 * wc + (d & 31); }
    return n;
}
__device__ __forceinline__ void transpose_item(const float* W, int ldw, bf16* WT, int ldt, int mode, LAS float* scr, int kb, int nb, int lane) {
    const int k0 = 64 * kb, n0 = 32 * nb;
#pragma unroll 8
    for (int i = 0; i < 32; ++i) { const int kk = 2 * i + (lane >> 5); scr[kk * 33 + (lane & 31)] = W[(size_t)(k0 + kk) * ldw + n0 + (lane & 31)]; }
    asm volatile("s_waitcnt lgkmcnt(0)" ::: "memory");
    const int c = lane & 7;
#pragma unroll
    for (int j = 0; j < 4; ++j) { const int n = (lane >> 3) + 8 * j; const LAS float* s = scr + (8 * c) * 33 + n;
        v4u o; o.x = pk2(s[0 * 33], s[1 * 33]); o.y = pk2(s[2 * 33], s[3 * 33]); o.z = pk2(s[4 * 33], s[5 * 33]); o.w = pk2(s[6 * 33], s[7 * 33]);
        *(v4u*)(WT + (size_t)map_row(mode, n0 + n) * ldt + k0 + 8 * c) = o; }
    asm volatile("s_waitcnt lgkmcnt(0)" ::: "memory");
}
__device__ __forceinline__ void norm_rows(const float* srcL, const float* srcC, bf16* A, const float* modl, int sidx, int nrows, int gw_, int NGW) {
    const int ft = fresh_tid(); const int lane = ft & 63; const int gw = gw_ + __builtin_amdgcn_readfirstlane(ft >> 6);
    for (int row = gw; row < nrows; row += NGW) {
        const float* xr = row < NLAT ? srcL + (size_t)row * DMODEL : srcC + (size_t)(row - NLAT) * DMODEL;
        const int b = row < NLAT ? (row >> 11) : 32;
        const float* sh = modl + (size_t)b * MODW + sidx * 1024; const float* sc = sh + 1024;
        f32x4 v[4]; float s = 0.f;
#pragma unroll
        for (int j = 0; j < 4; ++j) { v[j] = ((const f32x4*)xr)[lane + 64 * j]; s += (v[j].x * v[j].x + v[j].y * v[j].y) + (v[j].z * v[j].z + v[j].w * v[j].w); }
        const float rstd = 1.0f / sqrtf(wave_sum(s) * (1.0f / DMODEL) + 1e-6f);
        v2u* o8 = (v2u*)(A + (size_t)row * DMODEL) + lane;
#pragma unroll
        for (int j = 0; j < 4; ++j) { const f32x4 shv = ((const f32x4*)sh)[lane + 64 * j], scv = ((const f32x4*)sc)[lane + 64 * j];
            const f32x4 o = v[j] * rstd * (scv + 1.0f) + shv; v2u w; w.x = pk2(o.x, o.y); w.y = pk2(o.z, o.w); o8[64 * j] = w; }
    }
}

__global__ void __launch_bounds__(512, 2) fwd_mega(Args args) {
    extern __shared__ __attribute__((aligned(16))) unsigned char lds[];
    cg::grid_group grid = cg::this_grid();
    LAS unsigned char* L = (LAS unsigned char*)lds;
    const int tid = threadIdx.x, lane = tid & 63, wave = __builtin_amdgcn_readfirstlane(tid >> 6);
    const int G = gridDim.x, bx = blockIdx.x; const int vcu = (G % 8 == 0) ? (bx % 8) * (G / 8) + bx / 8 : bx;
    const int gw = vcu * 8 + wave, NGW = G * 8; const int gtid = bx * 512 + tid, NTHR = G * 512;
    unsigned char* ws = args.ws;
    if (tid < 2) ((volatile LAS unsigned*)(L + XB_LDS_OFF))[tid] = 0u;
    __syncthreads();
    (void)xcd_barrier_post((unsigned*)(ws + WS_BAR), (volatile LAS unsigned*)(L + XB_LDS_OFF));
    const float* x_in = args.in[0]; const float* c_in = args.in[1]; const float* ctx_in = args.in[2]; const float* cctx_in = args.in[3];
    const float* ada_w = args.in[4]; const float* ada_b = args.in[5];
    const float* w_in = args.in[8]; const float* q_gain = args.in[9]; const float* k_gain = args.in[10];
    const float* pool_w = args.in[11]; const float* pool_scale = args.in[12]; const float* fft_w = args.in[13]; const float* w_out = args.in[14];
    const float* final_gain = args.in[17];
    float* ZERO = (float*)(ws + WS_ZERO); unsigned char* LOP = ws + WS_LO;
    float* MOD = (float*)(ws + WS_MOD); float* MODP = (float*)(ws + WS_MODP);
    float* ROPEC = (float*)(ws + WS_ROPE); float* ROPES = ROPEC + 2048 * 32;
    bf16* ACAT = (bf16*)(ws + WS_ACAT); bf16* ACATC = (bf16*)(ws + WS_ACATC);
    bf16* WGU = (bf16*)(ws + WS_WGU); bf16* WDN = (bf16*)(ws + WS_WDN); bf16* WIN = (bf16*)(ws + WS_WIN); bf16* WOUT = (bf16*)(ws + WS_WOUT);
    bf16* AB = (bf16*)(ws + WS_A); bf16* AB2 = (bf16*)(ws + WS_A2); bf16* HID = (bf16*)(ws + WS_HID);
    float* SSB = (float*)(ws + WS_SS); bf16* SH = (bf16*)(ws + WS_SH); float* SWT = (float*)(ws + WS_SWT);
    bf16* QB_ = (bf16*)(ws + WS_Q); bf16* KB_ = (bf16*)(ws + WS_K); bf16* VB_ = (bf16*)(ws + WS_V); bf16* UP = (bf16*)(ws + WS_UP); bf16* VT = (bf16*)(ws + WS_VT); bf16* VTC = (bf16*)(ws + WS_VTC);

#if PROBE == 4
    for (int prep_ = 0; prep_ < 2; ++prep_) {
#else
    {
#endif
#define TRANSPOSE_ITEM(it_) do { int r = (it_); \
        if (r < 8 * I_GU) { const int mi = r / I_GU; r %= I_GU; const int l_ = mi >> 1, f_ = mi & 1; \
            transpose_item(args.in[f_ ? 15 : 6] + (size_t)l_ * 1024 * 5632, 5632, WGU + (size_t)mi * 5632 * 1024, 1024, 1, scr, r / 176, r % 176, lane_); } \
        else if (r < 8 * I_GU + 8 * I_DN) { r -= 8 * I_GU; const int mi = r / I_DN; r %= I_DN; const int l_ = mi >> 1, f_ = mi & 1; \
            transpose_item(args.in[f_ ? 16 : 7] + (size_t)l_ * 2816 * 1024, 1024, WDN + (size_t)mi * 1024 * 2816, 2816, 3, scr, r / 32, r % 32, lane_); } \
        else if (r < 8 * I_GU + 8 * I_DN + 4 * I_IN) { r -= 8 * I_GU + 8 * I_DN; const int l_ = r / I_IN; r %= I_IN; \
            transpose_item(w_in + (size_t)l_ * 1024 * 1280, 1280, WIN + (size_t)l_ * 1536 * 1024, 1024, 2, scr, r / 32, r % 32, lane_); } \
        else { r -= 8 * I_GU + 8 * I_DN + 4 * I_IN; const int l_ = r / I_OUT; r %= I_OUT; \
            transpose_item(w_out + (size_t)l_ * 1024 * 1024, 1024, WOUT + (size_t)l_ * 1024 * 1024, 1024, 3, scr, r / 32, r % 32, lane_); } } while (0)
    {   LAS float* scr = (LAS float*)(L + wave * 16384); const int lane_ = lane;
        for (int k = gw; k < 2 * I_GU + 2 * I_DN + I_IN + I_OUT; k += NGW) {
            const int it = k < 2 * I_GU ? k : k < 2 * I_GU + 2 * I_DN ? 8 * I_GU + (k - 2 * I_GU) : k < 2 * I_GU + 2 * I_DN + I_IN ? 8 * I_GU + 8 * I_DN + (k - 2 * I_GU - 2 * I_DN) : 8 * I_GU + 8 * I_DN + 4 * I_IN + (k - 2 * I_GU - 2 * I_DN - I_IN);
            TRANSPOSE_ITEM(it); }
    }
    __syncthreads();
    LAS float* T2048 = (LAS float*)(L + TAB_OFF); LAS float* T64 = T2048 + 2048;
    for (int i = tid; i < 2048; i += 512) T2048[i] = cospif((float)i * (1.0f / 1024.0f));
    if (tid < 64) T64[tid] = cospif((float)tid * (1.0f / 32.0f));
    __syncthreads();
#define FOLD_CH(idx) do { \
        const int k = idx & 1023; const int hi_ = __builtin_amdgcn_readfirstlane(idx >> 10); const int l = hi_ >> 8, cc = hi_ & 255, g = cc >> 6, cp = cc & 63; \
        const float* src = w_in + ((size_t)l * 1024 + k) * 1280 + 1024 + 64 * g; \
        float ac = 0.f, as = 0.f; \
        _Pragma("unroll 4") \
        for (int c4 = 0; c4 < 16; ++c4) { const f32x4 w = *(const f32x4*)(src + 4 * c4); \
        _Pragma("unroll") \
            for (int e = 0; e < 4; ++e) { const int m = (4 * c4 + e) * cp; ac += w[e] * T64[m & 63]; as += w[e] * T64[(m - 16) & 63]; } } \
        bf16* d = WIN + (size_t)l * 1536 * 1024 + k; \
        d[(size_t)(1024 + cc) * 1024] = (bf16)pg8::f2bf1(ac * 0.125f); d[(size_t)(1280 + cc) * 1024] = (bf16)pg8::f2bf1(as * 0.125f); \
    } while (0)
#define FOLD_POOL(idx) do { \
        const int n = idx & 1023; const int hi_ = __builtin_amdgcn_readfirstlane(idx >> 10); \
        const int l = hi_ >> 5, gc = hi_ & 31, g = gc >> 3, c0 = (gc & 7) * 8; \
        const float* wo = w_out + (size_t)l * 1024 * 1024 + (size_t)(512 + 64 * g) * 1024 + n; \
        const float* ps = pool_scale + l * 256 + 64 * g; const float* pw = pool_w + ((size_t)(l * 4 + g) * 64 + c0) * 64; \
        float a[8]; \
        _Pragma("unroll") \
        for (int i = 0; i < 8; ++i) a[i] = 0.f; \
        for (int d0 = 0; d0 < 64; d0 += 8) { float w[8]; \
        _Pragma("unroll") \
            for (int dd = 0; dd < 8; ++dd) w[dd] = wo[(size_t)(d0 + dd) * 1024]; \
        _Pragma("unroll") \
            for (int dd = 0; dd < 8; ++dd) { const float ww = ps[d0 + dd] * w[dd]; \
        _Pragma("unroll") \
                for (int i = 0; i < 8; ++i) a[i] += pw[i * 64 + d0 + dd] * ww; } } \
        v4u o; o.x = pk2(a[0], a[1]); o.y = pk2(a[2], a[3]); o.z = pk2(a[4], a[5]); o.w = pk2(a[6], a[7]); \
        *(v4u*)(WOUT + (size_t)l * 1024 * 1024 + (size_t)map_row(3, n) * 1024 + 512 + 64 * g + c0) = o; \
    } while (0)
#define FOLD_FFT(idx) do { \
        const int n = idx & 1023; const int hi_ = __builtin_amdgcn_readfirstlane(idx >> 10); \
        const int l = hi_ >> 5, i0 = (hi_ & 31) * 8; \
        const float* wo = w_out + (size_t)l * 1024 * 1024 + (size_t)768 * 1024 + n; \
        const float* fw = fft_w + (size_t)l * 65536 + (size_t)i0 * 256; \
        float a[8]; \
        _Pragma("unroll") \
        for (int i = 0; i < 8; ++i) a[i] = 0.f; \
        for (int j0 = 0; j0 < 256; j0 += 8) { float w[8]; \
        _Pragma("unroll") \
            for (int jj = 0; jj < 8; ++jj) w[jj] = wo[(size_t)(j0 + jj) * 1024]; \
        _Pragma("unroll") \
            for (int i = 0; i < 8; ++i) \
        _Pragma("unroll") \
                for (int jj = 0; jj < 8; ++jj) a[i] += fw[i * 256 + j0 + jj] * w[jj]; } \
        v4u o; o.x = pk2(a[0], a[1]); o.y = pk2(a[2], a[3]); o.z = pk2(a[4], a[5]); o.w = pk2(a[6], a[7]); \
        *(v4u*)(WOUT + (size_t)l * 1024 * 1024 + (size_t)map_row(3, n) * 1024 + 768 + i0) = o; \
    } while (0)
    for (int idx = bx * 512 + fresh_tid(); idx < 262144; idx += NTHR) FOLD_CH(idx);
    for (int idx = bx * 512 + fresh_tid(); idx < 32768; idx += NTHR) FOLD_POOL(idx);
    for (int idx = bx * 512 + fresh_tid(); idx < 32768; idx += NTHR) FOLD_FFT(idx);
    for (int idx = bx * 512 + fresh_tid(); idx < 13 * NROW / 4; idx += NTHR) { ((f32x4*)SSB)[idx] = (f32x4){0.f, 0.f, 0.f, 0.f}; if (idx < 256) ((f32x4*)ZERO)[idx] = (f32x4){0.f, 0.f, 0.f, 0.f}; }
    for (int idx = bx * 512 + fresh_tid(); idx < 65536; idx += NTHR) {
        const int t = idx >> 5, i = idx & 31; const int pos = i < 16 ? (t >> 6) : (t & 63);
        const float inv = powf(10000.0f, -(float)(i & 15) * (1.0f / 16.0f)); const float ang = (float)pos * inv;
        ROPEC[idx] = cosf(ang); ROPES[idx] = sinf(ang);
    }
    for (int idx = bx * 512 + fresh_tid(); idx < 2048 * 512; idx += NTHR) {
        const int kp = idx >> 9, ch = idx & 511; unsigned w[4];
#pragma unroll
        for (int e2 = 0; e2 < 4; ++e2) { unsigned pr[2];
#pragma unroll
            for (int q = 0; q < 2; ++q) { const int np = ch * 8 + e2 * 2 + q; const int m = np < 2048 ? (kp * np) & 2047 : (kp * (np - 2048) + 512) & 2047; pr[q] = pg8::f2bf1(T2048[m]); }
            w[e2] = pr[0] | (pr[1] << 16); }
        v4u o; o.x = w[0]; o.y = w[1]; o.z = w[2]; o.w = w[3];
        *(v4u*)(ACAT + (size_t)kp * 4096 + ch * 8) = o;
    }
    for (int idx = bx * 512 + fresh_tid(); idx < 256 * 64; idx += NTHR) {
        const int kp = idx >> 6, ch = idx & 63; unsigned w[4];
#pragma unroll
        for (int e2 = 0; e2 < 4; ++e2) { unsigned pr[2];
#pragma unroll
            for (int q = 0; q < 2; ++q) { const int np = ch * 8 + e2 * 2 + q; const int m = np < 256 ? (8 * kp * np) & 2047 : (8 * kp * (np - 256) + 512) & 2047; pr[q] = pg8::f2bf1(T2048[m]); }
            w[e2] = pr[0] | (pr[1] << 16); }
        v4u o; o.x = w[0]; o.y = w[1]; o.z = w[2]; o.w = w[3];
        *(v4u*)(ACATC + (size_t)kp * 512 + ch * 8) = o;
    }
    {
        LAS float* sc = (LAS float*)L;
        for (int task = bx; task < 576; task += G) {
            const int ks = task / 72, cb = task % 72;
            __syncthreads();
            for (int e = tid; e < 128 * 33; e += 512) { const int kk = e / 33, b = e % 33; const int k = ks * 128 + kk;
                const float cv = b < 32 ? c_in[b * 1024 + k] : cctx_in[k]; sc[kk * 36 + b] = cv / (1.0f + expf(-cv)); }
            __syncthreads();
            const int j = cb * 512 + tid; const int l = j / MODW, jj = j % MODW;
            const float* wp = ada_w + ((size_t)l * 1024 + ks * 128) * MODW + jj;
            typedef float f32x2v __attribute__((ext_vector_type(2)));
            f32x2v a2[16]; float a32 = 0.f;
#pragma unroll
            for (int b = 0; b < 16; ++b) a2[b] = (f32x2v){0.f, 0.f};
            for (int k0 = 0; k0 < 128; k0 += 8) { float wv[8];
#pragma unroll
                for (int kq = 0; kq < 8; ++kq) wv[kq] = wp[(size_t)(k0 + kq) * MODW];
#pragma unroll
                for (int kq = 0; kq < 8; ++kq) { const f32x2v w2 = {wv[kq], wv[kq]}; const int kk = k0 + kq;
#pragma unroll
                    for (int q = 0; q < 8; ++q) { const f32x4 s = *(const LAS f32x4*)(sc + kk * 36 + 4 * q); a2[2 * q] += w2 * s.xy; a2[2 * q + 1] += w2 * s.zw; }
                    a32 += wv[kq] * sc[kk * 36 + 32]; } }
            float a[33];
#pragma unroll
            for (int b = 0; b < 16; ++b) { a[2 * b] = a2[b].x; a[2 * b + 1] = a2[b].y; }
            a[32] = a32;
#pragma unroll
            for (int b = 0; b < 33; ++b) MODP[((size_t)ks * 33 + b) * 36864 + j] = a[b];
        }
    }
    grid.sync();

    for (int idx = bx * 512 + fresh_tid(); idx < 33 * 36864; idx += NTHR) {
        const int b = idx / 36864, j = idx % 36864, l = j / MODW, jj = j % MODW;
        float s = ada_b[j];
#pragma unroll
        for (int ks = 0; ks < 8; ++ks) s += MODP[((size_t)ks * 33 + b) * 36864 + j];
        MOD[((size_t)l * 33 + b) * MODW + jj] = s;
        const int which = jj >> 10;
        if (which == 0 || which == 3 || which == 6) SH[((size_t)(l * 3 + which / 3) * 256 + b) * 1024 + (jj & 1023)] = (bf16)pg8::f2bf1(s);
    }
    GSYNC();
    {   pg8::Gemm g{SH, WGU, 12 * 256, 51200, 1024}; pg8::SwOrder S{G, bx, 0}; pg8::EpiSW E{SWT};
        pg8::gemm_phase<pg8::EpiSW, pg8::SwOrder, true, true>(L, g, S, E); }
    {   const int ft = fresh_tid(); const int ln = ft & 63;
        for (int row = vcu * 8 + __builtin_amdgcn_readfirstlane(ft >> 6); row < NROW; row += NGW) {
            const float* xr = row < NLAT ? x_in + (size_t)row * DMODEL : ctx_in + (size_t)(row - NLAT) * DMODEL;
            const int b = row < NLAT ? (row >> 11) : 32; const float* sc = MOD + (size_t)b * MODW + 1024;
            float s = 0.f; const int pmr = row >> 8, rlc = row & 255;
            v2u* o8 = (v2u*)(AB + ((size_t)(pmr * 16 + (ln >> 4)) * 256 + rlc) * 64 + 4 * (ln & 15)); unsigned* l8 = (unsigned*)(LOP + ((size_t)(pmr * 4) * 256 + rlc) * 256 + 4 * ln);
#pragma unroll
            for (int j = 0; j < 4; ++j) { const f32x4 v = ((const f32x4*)xr)[ln + 64 * j]; s += (v.x * v.x + v.y * v.y) + (v.z * v.z + v.w * v.w);
                const f32x4 o = v * pg8::clamp_m(((const f32x4*)sc)[ln + 64 * j]); v2u w; w.x = pk2(o.x, o.y); w.y = pk2(o.z, o.w); o8[(size_t)j * 4 * 256 * 64 / 4] = w;
                const unsigned b0 = w.x << 16, b1 = w.x & 0xffff0000u, b2 = w.y << 16, b3 = w.y & 0xffff0000u;
                const unsigned w8 = pg8::lo8_enc(o.x, b0) | (pg8::lo8_enc(o.y, b1) << 8) | (pg8::lo8_enc(o.z, b2) << 16) | (pg8::lo8_enc(o.w, b3) << 24);
                l8[(size_t)j * 256 * 256 / 4] = w8; }
            s = wave_sum(s); if (ln == 0) SSB[row] = s;
        }
    }
    GSYNC();

    }
    for (int l = 0; l < 4; ++l) {
        const bool last = (l == 3);
        const float* modl = MOD + (size_t)l * 33 * MODW;
        for (int f = 0; f < 2; ++f) {
            const bool first = (l == 0 && f == 0);
            const int nrows = (last && f == 1) ? NLAT : NROW;
            {   pg8::Gemm g{AB, WGU + (size_t)(l * 2 + f) * 5632 * 1024, nrows, 5632, 1024, 1}; pg8::StaticOrder S; S.init(nrows, 5632, G, bx);
                pg8::EpiGU E{HID, SSB + (size_t)(l * 3 + 2 * f) * NROW, SWT + (size_t)((l * 2 + f) * 22) * 33 * 256};
                { int b2 = blockIdx.x; asm volatile("" : "+s"(b2)); stagger(nrows == NROW ? (b2 < 96 ? 0 : b2 < 192 ? STG_GU : b2 < 224 ? STG_GU / 2 : STG_GU * 3 / 2) : (b2 < 128 ? 0 : STG_GU)); }
                pg8::gemm_phase<pg8::EpiGU, pg8::StaticOrder, true, true>(L, g, S, E);
#if PROBE == 1
                pg8::gemm_phase<pg8::EpiGU, pg8::StaticOrder, true, true>(L, g, S, E);
#endif
            }
            GSYNC();
            {   pg8::Gemm g{HID, WDN + (size_t)(l * 2 + f) * 1024 * 2816, nrows, 1024, 2816, 1}; pg8::StaticOrder S; S.init(nrows, 1024, G, bx);
                const float* dsc = modl + (f == 0 ? 1 : 7) * 1024;
                const float* nsc = f == 0 ? modl + 4 * 1024 : (last ? ZERO : modl + (size_t)33 * MODW + 1 * 1024);
                float* ssn = f == 0 ? SSB + (size_t)(l * 3 + 1) * NROW : SSB + (size_t)((l + 1) * 3) * NROW;
                pg8::EpiRes E{AB, LOP, modl + (f == 0 ? 2 : 8) * 1024, dsc, nsc, ssn, (LAS float*)(L + TAB_OFF), 0.5f, (f == 1 && last) ? 0 : MODW};
                { int b2 = blockIdx.x; asm volatile("" : "+s"(b2)); stagger(b2 < 128 ? 0 : STG_DN); }
                pg8::gemm_phase<pg8::EpiRes, pg8::StaticOrder, true, true>(L, g, S, E);
#if PROBE == 5
                pg8::EpiDummy ED{(float*)(ws + WS_SWT)};
                pg8::gemm_phase<pg8::EpiDummy, pg8::StaticOrder, true, true>(L, g, S, ED);
#endif
            }
            if (!last && bx >= (G >> 1)) {
                const int hb = G >> 1, nW = G - hb;
                const int ftt = fresh_tid(); const int lane_ = ftt & 63; const int wv = __builtin_amdgcn_readfirstlane(ftt >> 6);
                LAS float* scr = (LAS float*)(L + wv * 16384); const int Ln = l + 1;
                if (f == 0) { for (int k = (bx - hb) * 8 + wv; k < 2 * I_GU + I_IN; k += nW * 8) { const int it = k < 2 * I_GU ? Ln * 2 * I_GU + k : 8 * I_GU + 8 * I_DN + Ln * I_IN + (k - 2 * I_GU); TRANSPOSE_ITEM(it); }
                    LAS float* T64 = (LAS float*)(L + TAB_OFF) + 2048; __syncthreads(); if (ftt < 64) T64[ftt] = cospif((float)ftt * (1.0f / 32.0f)); __syncthreads();
                    for (int idx = Ln * 262144 + (bx - hb) * 512 + ftt; idx < (Ln + 1) * 262144; idx += nW * 512) FOLD_CH(idx); }
                else { for (int idx = Ln * 32768 + (bx - hb) * 512 + ftt; idx < (Ln + 1) * 32768; idx += nW * 512) { FOLD_POOL(idx); FOLD_FFT(idx); }
                    for (int k = (bx - hb) * 8 + wv; k < 2 * I_DN + I_OUT; k += nW * 8) { const int it = k < 2 * I_DN ? 8 * I_GU + Ln * 2 * I_DN + k : 8 * I_GU + 8 * I_DN + 4 * I_IN + Ln * I_OUT + (k - 2 * I_DN); TRANSPOSE_ITEM(it); }
                    __syncthreads();
                    pg8::Gemm g2{SH, WGU, 12 * 256, 51200, 1024}; pg8::SwOrder S2{nW, bx - hb, Ln}; pg8::EpiSW E2{SWT};
                    pg8::gemm_phase<pg8::EpiSW, pg8::SwOrder, true, true>(L, g2, S2, E2); }
            }
            GSYNC();
            if (f == 0) {
                {   pg8::Gemm g{AB, WIN + (size_t)l * 1536 * 1024, NROW, 1536, 1024, 1}; pg8::StaticOrder S; S.init(NROW, 1536, G, bx);
                    pg8::EpiIN E{QB_, KB_, VB_, UP, VT, VTC, q_gain + l * 64, k_gain + l * 64, ROPEC, ROPES, SSB + (size_t)(l * 3 + 1) * NROW, SWT + (size_t)(176 + l * 6) * 33 * 256};
                    pg8::gemm_phase<pg8::EpiIN, pg8::StaticOrder, true, true>(L, g, S, E);
#if PROBE == 3
                    pg8::gemm_phase<pg8::EpiIN, pg8::StaticOrder, true, true>(L, g, S, E);
#endif
                }
                GSYNC();
#if PROBE == 2
                for (int rep_ = 0; rep_ < 2; ++rep_) {
#else
                {
#endif
                for (int v = vcu; v < 256; v += G) {
                    const int p = v >> 2, s = v & 3, b = p >> 1, kvh = p & 1, h = 4 * kvh + s;
                    const attn_body::bf16* Kh = (const attn_body::bf16*)KB_ + (size_t)b * KVROWS * 128 + kvh * 64;
                    const attn_body::bf16* Vh = (const attn_body::bf16*)VB_ + (size_t)b * KVROWS * 128 + kvh * 64;
                    for (int qb = 0; qb < 8; ++qb) { const size_t r0 = (size_t)b * 2048 + qb * 256;
                        attn_body::attn_unit<8>((const attn_body::bf16*)QB_ + r0 * 512 + h * 64, Kh, Vh, (attn_body::bf16*)AB2 + r0 * 1024 + h * 64, 36, (char*)lds); }
                    if (!last) { const int cb = v >> 3, ch = v & 7; const size_t r0 = (size_t)NLAT + cb * 256;
                        const attn_body::bf16* Kc = (const attn_body::bf16*)KB_ + ((size_t)cb * KVROWS + 2048) * 128 + (ch >> 2) * 64;
                        const attn_body::bf16* Vc = (const attn_body::bf16*)VB_ + ((size_t)cb * KVROWS + 2048) * 128 + (ch >> 2) * 64;
                        attn_body::attn_unit<8>((const attn_body::bf16*)QB_ + r0 * 512 + ch * 64, Kc, Vc, (attn_body::bf16*)AB2 + r0 * 1024 + ch * 64, 4, (char*)lds); }
                }
                {   const int prow = last ? NLAT : NROW;
                    const int pskip = (!last && G > 64) ? 32 : 0;
                    for (int idx = (bx < pskip ? prow * 32 : (bx - pskip) * 512 + fresh_tid()); idx < prow * 32; idx += (G - pskip) * 512) {
                        const int p8 = prow * 8; const int g = __builtin_amdgcn_readfirstlane((idx >= p8) + (idx >= 2 * p8) + (idx >= 3 * p8)); const int rem = idx - g * p8; const int row = rem >> 3, c0 = g * 64 + (rem & 7) * 8, w2 = 1 << g, w = 2 << g;
                        int Ls, t; if (row < NLAT) { Ls = 2048; t = row & 2047; } else { Ls = 256; t = row & 255; }
                        const int base = row - t; const int lo = max(t - w2, 0), hi = min(t + w - w2, Ls);
                        float s[8];
#pragma unroll
                        for (int i = 0; i < 8; ++i) s[i] = 0.f;
                        v4u wq[16]; float wt[16];
#pragma unroll
                        for (int j = 0; j < 16; ++j) { wt[j] = 0.f; wq[j] = (v4u){0u, 0u, 0u, 0u}; if (j < w) { const int pos = t - w2 + j; const bool ok = pos >= 0 && pos < Ls; wt[j] = ok ? 1.0f : 0.0f; wq[j] = *(const v4u*)(UP + (size_t)(base + (ok ? pos : t)) * 256 + c0); } }
#pragma unroll
                        for (int j = 0; j < 16; ++j) if (j < w) { const v4u q = wq[j]; const float wj = wt[j];
                            s[0] += wj * __uint_as_float(q.x << 16); s[1] += wj * __uint_as_float(q.x & 0xffff0000u); s[2] += wj * __uint_as_float(q.y << 16); s[3] += wj * __uint_as_float(q.y & 0xffff0000u);
                            s[4] += wj * __uint_as_float(q.z << 16); s[5] += wj * __uint_as_float(q.z & 0xffff0000u); s[6] += wj * __uint_as_float(q.w << 16); s[7] += wj * __uint_as_float(q.w & 0xffff0000u); }
                        const v4u q = *(const v4u*)(UP + (size_t)row * 256 + c0); const float ic = 1.0f / (float)(hi - lo);
                        v4u o;
                        o.x = pk2(s[0] * ic - __uint_as_float(q.x << 16), s[1] * ic - __uint_as_float(q.x & 0xffff0000u));
                        o.y = pk2(s[2] * ic - __uint_as_float(q.y << 16), s[3] * ic - __uint_as_float(q.y & 0xffff0000u));
                        o.z = pk2(s[4] * ic - __uint_as_float(q.z << 16), s[5] * ic - __uint_as_float(q.z & 0xffff0000u));
                        o.w = pk2(s[6] * ic - __uint_as_float(q.w << 16), s[7] * ic - __uint_as_float(q.w & 0xffff0000u));
                        *(v4u*)(AB2 + (size_t)row * 1024 + 512 + c0) = o;
                    }
                }
                {   pg8::Gemm g{ACAT, VT, 2048, 8192, 4096}; pg8::StaticOrder S; S.init(2048, 8192, G, bx);
                    pg8::EpiDFT E{AB2, 0, 2048, 0.022097086912079608f};
                    pg8::gemm_phase<pg8::EpiDFT, pg8::StaticOrder, true, true>(L, g, S, E); }
                if (!last) { pg8::Gemm g{ACATC, VTC, 256, 8192, 512}; pg8::StaticOrder S; S.init(256, 8192, G, bx);
                    pg8::EpiDFT E{AB2, NLAT, 256, 0.0625f};
                    pg8::gemm_phase<pg8::EpiDFT, pg8::StaticOrder, true, true>(L, g, S, E); }
                }
                GSYNC();
                {   const int mrows = last ? NLAT : NROW;
                    pg8::Gemm g{AB2, WOUT + (size_t)l * 1024 * 1024, mrows, 1024, 1024}; pg8::StaticOrder S; S.init(mrows, 1024, G, bx);
                    pg8::EpiRes E{AB, LOP, modl + 5 * 1024, modl + 4 * 1024, modl + 7 * 1024, SSB + (size_t)(l * 3 + 2) * NROW, (LAS float*)(L + TAB_OFF), 1.0f, MODW};
                    { int b2 = blockIdx.x; asm volatile("" : "+s"(b2)); stagger(b2 < 128 ? 0 : STG_OUT); }
                    pg8::gemm_phase<pg8::EpiRes, pg8::StaticOrder, true, true>(L, g, S, E); }
                GSYNC();
            }
        }
    }
    const int ftf = fresh_tid(); const int lanef = ftf & 63;
    for (int row = vcu * 8 + __builtin_amdgcn_readfirstlane(ftf >> 6); row < NLAT; row += NGW) {
        const int pmr = row >> 8, rlc = row & 255;
        const v2u* hp = (const v2u*)(AB + ((size_t)(pmr * 16 + (lanef >> 4)) * 256 + rlc) * 64 + 4 * (lanef & 15)); const unsigned* lp = (const unsigned*)(LOP + ((size_t)(pmr * 4) * 256 + rlc) * 256 + 4 * lanef);
        f32x4 v[4]; float s = 0.f;
#pragma unroll
        for (int j = 0; j < 4; ++j) { const v2u h = hp[(size_t)j * 4 * 256 * 64 / 4]; const int q = (int)lp[(size_t)j * 256 * 256 / 4];
            const unsigned b0 = h.x << 16, b1 = h.x & 0xffff0000u, b2 = h.y << 16, b3 = h.y & 0xffff0000u;
            v[j].x = pg8::lo8_dec(b0, (unsigned)q & 0xffu); v[j].y = pg8::lo8_dec(b1, ((unsigned)q >> 8) & 0xffu); v[j].z = pg8::lo8_dec(b2, ((unsigned)q >> 16) & 0xffu); v[j].w = pg8::lo8_dec(b3, (unsigned)q >> 24);
            s += (v[j].x * v[j].x + v[j].y * v[j].y) + (v[j].z * v[j].z + v[j].w * v[j].w); }
        const float rstd = 1.0f / sqrtf(wave_sum(s) * (1.0f / DMODEL) + 1e-6f);
        f32x4* xr = (f32x4*)(args.out + (size_t)row * DMODEL);
#pragma unroll
        for (int j = 0; j < 4; ++j) { const f32x4 gv = ((const f32x4*)final_gain)[lanef + 64 * j]; xr[lanef + 64 * j] = v[j] * rstd * gv; }
    }
}

extern "C" void kernel_launch(void* const* d_in, const int* in_sizes, int n_in, void* d_out, int out_size, void* d_ws, size_t ws_size, hipStream_t stream) {
    static int grid = 0;
    if (grid == 0) {
        if (n_in != 18 || out_size != NLAT * DMODEL || ws_size < WS_END) { fprintf(stderr, "kernel_launch: unexpected shapes (n_in %d, out %d, ws %zu)\n", n_in, out_size, ws_size); grid = -1; return; }
        int dev = 0, cus = 0, per_cu = 0;
        hipGetDevice(&dev); hipDeviceGetAttribute(&cus, hipDeviceAttributeMultiprocessorCount, dev);
        hipFuncSetAttribute((const void*)fwd_mega, hipFuncAttributeMaxDynamicSharedMemorySize, LDS_BYTES);
        if (hipOccupancyMaxActiveBlocksPerMultiprocessor(&per_cu, (const void*)fwd_mega, 512, LDS_BYTES) != hipSuccess || per_cu < 1) { fprintf(stderr, "kernel_launch: occupancy query says %d\n", per_cu); per_cu = 1; }
        (void)hipGetLastError();
        grid = cus * (per_cu > 1 ? 1 : per_cu);
        if (grid <= 0) grid = 256;
    }
    if (grid < 0) return;
    if (hipMemsetAsync((char*)d_ws + WS_BAR, 0, 16384, stream) != hipSuccess) { fprintf(stderr, "kernel_launch: memset of the barrier words failed\n"); return; }
    Args a{};
    for (int i = 0; i < 18; ++i) a.in[i] = (const float*)d_in[i];
    a.out = (float*)d_out; a.ws = (unsigned char*)d_ws;
    void* params[] = {&a};
    hipError_t e = hipLaunchCooperativeKernel((const void*)fwd_mega, dim3(grid), dim3(512), params, LDS_BYTES, stream);
    if (e != hipSuccess) fprintf(stderr, "cooperative launch failed: %s (grid %d)\n", hipGetErrorString(e), grid);
}
```

```cpp
#include <hip/hip_runtime.h>
#include <hip/hip_cooperative_groups.h>
#include <hip/hip_bf16.h>
#include <cstdio>
#include <cstdint>
#include <cmath>
namespace cg = cooperative_groups;
constexpr int NLAT = 65536, NCTX = 8192, NROW = NLAT + NCTX, DMODEL = 1024, DFF = 2816, MODW = 9216, KVROWS = 2304;
constexpr float QC2 = 0.125f * 1.4426950408889634f;
__device__ __forceinline__ int fresh_tid() { int t = threadIdx.x; asm volatile("" : "+v"(t)); return t; }
namespace pg8 {
#define PG8_LAS __attribute__((address_space(3)))
typedef unsigned short bf16_t;
typedef short bf16x8 __attribute__((ext_vector_type(8)));
typedef float f32x4 __attribute__((ext_vector_type(4)));
typedef unsigned u32x4 __attribute__((ext_vector_type(4)));
constexpr int BM = 256, BK = 64, HALF = 128, HTB = HALF * BK * 2  , STAGE_BYTES = 8 * HTB, NXCD = 8, WGM = 8;

__host__ __device__ __forceinline__ int lds_byte(int r, int c) { const int st = (r >> 4) * 2 + (c >> 5), rr = r & 15, cc = c & 31, ob = rr * 64 + cc * 2; return st * 1024 + (ob ^ (((ob >> 9) & 1) << 5)); }
__host__ __device__ __forceinline__ void stage_rc(int b, int& R, int& C) { const int st = b / 1024, sb = b % 1024, swz = sb ^ (((sb >> 9) & 1) << 5); R = (st >> 1) * 16 + swz / 64; C = (st & 1) * 32 + (swz % 64) / 2; }
__host__ __device__ __forceinline__ int perm32(int rho) { const int n = rho >> 4, i = rho & 15; return 8 * (i >> 2) + 4 * n + (i & 3); }

struct Unit { int pm, pn; };
struct Gemm { const bf16_t* A; const bf16_t* Bt; int M, N, K; int ablk; };

struct StaticOrder {
    int nM, nN, nwg, G, c;
    __host__ __device__ void init(int M, int N, int G_, int c_) { nM = M / BM; nN = N / BM; nwg = nM * nN; G = G_; c = c_; }
    __host__ __device__ bool next(int i, Unit& u) const {
        const long L = (long)i * G + c; if (L >= nwg) return false;
        int wgid = (int)L; { const int q = nwg / NXCD, r = nwg % NXCD, xcd = wgid % NXCD, off = wgid / NXCD; wgid = (xcd < r ? xcd * (q + 1) : r * (q + 1) + (xcd - r) * q) + off; }
        const int nig = WGM * nN, gid = wgid / nig, fm = gid * WGM, gsz = (nM - fm) < WGM ? (nM - fm) : WGM;
        u.pm = fm + ((wgid % nig) % gsz); u.pn = (wgid % nig) / gsz; return true;
    }
    __device__ __forceinline__ void a_ready(const Unit&) const {}
    __device__ __forceinline__ void done(const Unit&) const {}
};

__device__ __forceinline__ unsigned cvt_pk_bf16(float lo, float hi) { unsigned r; asm volatile("v_cvt_pk_bf16_f32 %0, %1, %2" : "=v"(r) : "v"(lo), "v"(hi)); return r; }
typedef float f32x2 __attribute__((ext_vector_type(2)));
__device__ __forceinline__ unsigned f2bf1(float f) { unsigned u = __builtin_bit_cast(unsigned, f); return (u + 0x7fffu + ((u >> 16) & 1u)) >> 16; }
__device__ __forceinline__ float silu_f(float g) { return g * __builtin_amdgcn_rcpf(1.0f + __expf(-g)); }
struct EpiGU {
    static constexpr bool PERM = true, AFTER_DRAIN = false;
    bf16_t* H; const float* SS; const float* SWT;
    __device__ __forceinline__ void operator()(const f32x4 (&acc)[2][2][4][2], const Unit& u, int wr, int wc, int fr, int fq) const {
        asm volatile("" : "+v"(fr), "+v"(fq));
        const int row0 = u.pm * BM + wr * 64 + fr, col0 = u.pn * 128 + wc * 32 + 8 * fq;
        const int b = u.pm < 256 ? (u.pm >> 3) : 32;
        const float* swp = SWT + ((size_t)u.pn * 33 + b) * 256 + wc * 32 + 8 * fq;
        const f32x4 sg0 = *(const f32x4*)(swp), sg1 = *(const f32x4*)(swp + 4), su0 = *(const f32x4*)(swp + 128), su1 = *(const f32x4*)(swp + 132);
        float ssv[2][4];
#pragma unroll
        for (int ai = 0; ai < 2; ++ai)
#pragma unroll
            for (int m = 0; m < 4; ++m) ssv[ai][m] = SS[row0 + ai * HALF + m * 16];
#pragma unroll
        for (int ai = 0; ai < 2; ++ai)
#pragma unroll
            for (int m = 0; m < 4; ++m) {
                const float rs = __builtin_amdgcn_rsqf(ssv[ai][m] * (1.0f / 1024.0f) + 1e-6f);
                bf16_t* p = H + ((size_t)(u.pm * 44 + u.pn * 2 + (wc >> 1)) * 256 + (wr * 64 + fr + ai * HALF + m * 16)) * 64 + (wc & 1) * 32 + 8 * fq;
                const f32x2 rs2 = {rs, rs}; u32x4 w;
#define SILU2(G, U, SG, SU) ({ const f32x2 g_ = (G) * rs2 + (SG), u_ = (U) * rs2 + (SU); const f32x2 t_ = g_ * (-1.4426950408889634f); f32x2 d_; d_.x = __builtin_amdgcn_exp2f(t_.x); d_.y = __builtin_amdgcn_exp2f(t_.y); d_ = d_ + 1.0f; \
                    f32x2 r_; r_.x = __builtin_amdgcn_rcpf(d_.x); r_.y = __builtin_amdgcn_rcpf(d_.y); const f32x2 h_ = (g_ * u_) * r_; cvt_pk_bf16(h_.x, h_.y); })
                w.x = SILU2(acc[ai][0][m][0].xy, acc[ai][1][m][0].xy, sg0.xy, su0.xy); w.y = SILU2(acc[ai][0][m][0].zw, acc[ai][1][m][0].zw, sg0.zw, su0.zw);
                w.z = SILU2(acc[ai][0][m][1].xy, acc[ai][1][m][1].xy, sg1.xy, su1.xy); w.w = SILU2(acc[ai][0][m][1].zw, acc[ai][1][m][1].zw, sg1.zw, su1.zw);
#undef SILU2
                __builtin_nontemporal_store(w, (u32x4*)p);
            }
    }
};
__device__ __forceinline__ f32x4 clamp_m(f32x4 s) { f32x4 m = s + 1.0f;
#pragma unroll
    for (int e = 0; e < 4; ++e) m[e] = __builtin_fabsf(m[e]) < 1e-6f ? __builtin_copysignf(1e-6f, m[e]) : m[e];
    return m; }
typedef unsigned u32x2 __attribute__((ext_vector_type(2)));
__device__ __forceinline__ unsigned lo4_enc(float y, unsigned hb  ) { return ((__float_as_uint(y) - (hb + 0xffff8000u)) >> 12) & 0xfu; }
__device__ __forceinline__ float lo4_dec(unsigned hb  , unsigned nib) { return __uint_as_float((hb | (nib << 12)) + 0xffff8800u); }
#define LO4_NIB(lw_, q_) ((((q_) >= 3) ? ((lw_) >> (4 * (q_) - 12)) : ((lw_) << (12 - 4 * (q_)))) & 0xf000u)
#define LO4_PUT(t_, q_) ((((q_) <= 3) ? ((t_) >> (12 - 4 * (q_))) : ((t_) << (4 * (q_) - 12))) & (0xfu << (4 * (q_))))
struct EpiRes {
    static constexpr bool PERM = true, AFTER_DRAIN = false;
    bf16_t* HI; unsigned char* LO; const float* gate; const float* dsc; const float* nsc; float* SSn; PG8_LAS float* cst; float gs; int nstride;
    __device__ __forceinline__ void operator()(const f32x4 (&acc)[2][2][4][2], const Unit& u, int wr, int wc, int fr, int fq) const {
        asm volatile("" : "+v"(fr), "+v"(fq));
        const int pm = u.pm; const int b = pm < 256 ? (pm >> 3) : 32;
        const int rl = pm * BM + wr * 64 + fr, col0 = u.pn * BM + wc * 64 + 16 * fq;
        f32x4 gv[2][2], mev[2][2], rdv[2][2];
#pragma unroll
        for (int bj = 0; bj < 2; ++bj)
#pragma unroll
            for (int n = 0; n < 2; ++n) { gv[bj][n] = *(const f32x4*)(gate + (size_t)b * MODW + col0 + bj * 8 + n * 4) * gs;
                mev[bj][n] = clamp_m(*(const f32x4*)(nsc + (size_t)b * nstride + col0 + bj * 8 + n * 4));
                const f32x4 md = clamp_m(*(const f32x4*)(dsc + (size_t)b * MODW + col0 + bj * 8 + n * 4));
#pragma unroll
                for (int e = 0; e < 4; ++e) rdv[bj][n][e] = __builtin_amdgcn_rcpf(md[e]); }
        constexpr int PF = 1, NB = PF + 1;
        u32x4 RH[NB][2]; u32x2 RL[NB];
        const int rloc0 = wr * 64 + fr; const size_t hib = ((size_t)(pm * 16 + u.pn * 4 + wc) * 256) * 64 + 16 * fq, lob = ((size_t)(pm * 4 + u.pn) * 256) * 128 + wc * 32 + 8 * fq;
#define HI_OFF(rloc_, bj_) (hib + (size_t)(rloc_) * 64 + (bj_) * 8)
#define LO_OFF(rloc_) (lob + (size_t)(rloc_) * 128)
#define RES_LOAD(slot, j_) do { const int rloc_ = rloc0 + ((j_) >> 2) * HALF + ((j_) & 3) * 16; \
            _Pragma("unroll") for (int bj = 0; bj < 2; ++bj) RH[slot][bj] = *(const u32x4*)(HI + HI_OFF(rloc_, bj)); RL[slot] = *(const u32x2*)(LO + LO_OFF(rloc_)); } while (0)
#pragma unroll
        for (int j = 0; j < PF; ++j) RES_LOAD(j % NB, j);
#pragma unroll
        for (int j = 0; j < 8; ++j) {
            if (j + PF < 8) RES_LOAD((j + PF) % NB, j + PF);
            asm volatile("" ::: "memory");
            const int ai = j >> 2, m = j & 3; const int r = rl + ai * HALF + m * 16; const int rloc = rloc0 + ai * HALF + m * 16;
            f32x2 ss2 = {0.f, 0.f}; u32x2 wl;
#pragma unroll
            for (int bj = 0; bj < 2; ++bj) { u32x4 wh; unsigned wlo = 0u;
#pragma unroll
                for (int n = 0; n < 2; ++n) { const f32x4 me_ = mev[bj][n], rd_ = rdv[bj][n], gq = gv[bj][n], aq = acc[ai][bj][m][n];
                    const unsigned hw0 = RH[j % NB][bj][2 * n], hw1 = RH[j % NB][bj][2 * n + 1], lw = RL[j % NB][bj];
                    f32x2 y01, y23;
                    y01.x = __uint_as_float(((hw0 << 16) | LO4_NIB(lw, 4 * n + 0)) + 0xffff8800u); y01.y = __uint_as_float(((hw0 & 0xffff0000u) | LO4_NIB(lw, 4 * n + 1)) + 0xffff8800u);
                    y23.x = __uint_as_float(((hw1 << 16) | LO4_NIB(lw, 4 * n + 2)) + 0xffff8800u); y23.y = __uint_as_float(((hw1 & 0xffff0000u) | LO4_NIB(lw, 4 * n + 3)) + 0xffff8800u);
                    const f32x2 o01 = y01 * rd_.xy + gq.xy * aq.xy, o23 = y23 * rd_.zw + gq.zw * aq.zw;
                    ss2 += o01 * o01; ss2 += o23 * o23;
                    y01 = o01 * me_.xy; y23 = o23 * me_.zw;
                    const unsigned h0 = cvt_pk_bf16(y01.x, y01.y), h1 = cvt_pk_bf16(y23.x, y23.y);
                    const unsigned t0 = __float_as_uint(y01.x) - ((h0 << 16) + 0xffff8000u), t1 = __float_as_uint(y01.y) - ((h0 & 0xffff0000u) + 0xffff8000u);
                    const unsigned t2 = __float_as_uint(y23.x) - ((h1 << 16) + 0xffff8000u), t3 = __float_as_uint(y23.y) - ((h1 & 0xffff0000u) + 0xffff8000u);
                    wh[2 * n] = h0; wh[2 * n + 1] = h1;
                    wlo |= LO4_PUT(t0, 4 * n + 0) | LO4_PUT(t1, 4 * n + 1) | LO4_PUT(t2, 4 * n + 2) | LO4_PUT(t3, 4 * n + 3); }
                *(u32x4*)(HI + HI_OFF(rloc, bj)) = wh; wl[bj] = wlo; }
            *(u32x2*)(LO + LO_OFF(rloc)) = wl;
            float ss = ss2.x + ss2.y;
            { ss += __shfl_xor(ss, 16); ss += __shfl_xor(ss, 32); if (fq == 0) unsafeAtomicAdd(SSn + r, ss); }
            asm volatile("" ::: "memory");
        }
#undef RES_LOAD
#undef HI_OFF
#undef LO_OFF
    }
};
struct EpiSW {
    static constexpr bool PERM = true, AFTER_DRAIN = false;
    float* SWT;
    __device__ __forceinline__ void operator()(const f32x4 (&acc)[2][2][4][2], const Unit& u, int wr, int wc, int fr, int fq) const {
        asm volatile("" : "+v"(fr), "+v"(fq));
        if (wr != 0) return;
#pragma unroll
        for (int m = 0; m < 3; ++m) { const int row = m * 16 + fr;
            if (row < 33) { float* p = SWT + ((size_t)u.pn * 33 + row) * 256 + wc * 32 + 8 * fq;
#pragma unroll
                for (int bj = 0; bj < 2; ++bj)
#pragma unroll
                    for (int n = 0; n < 2; ++n) *(f32x4*)(p + bj * HALF + 4 * n) = acc[0][bj][m][n]; } }
    }
};
struct SwOrder {
    int G, c, L;
    __device__ bool next(int i, Unit& u) const { const int j = i * G + c; if (c < 0 || j >= 50) return false; const int pn = j < 44 ? L * 44 + j : 176 + L * 6 + (j - 44); u.pn = pn;
        if (pn < 176) { const int mi = pn / 22; u.pm = (mi >> 1) * 3 + 2 * (mi & 1); } else u.pm = ((pn - 176) / 6) * 3 + 1; return true; }
    __device__ __forceinline__ void a_ready(const Unit&) const {}
    __device__ __forceinline__ void done(const Unit&) const {}
};
struct EpiIN {
    static constexpr bool PERM = true, AFTER_DRAIN = false;
    bf16_t *Q, *Kb, *Vb, *UP, *VT, *VTC; const float *qg, *kg, *ropeC, *ropeS; const float* SS; const float* SWT;
    __device__ __forceinline__ void operator()(const f32x4 (&acc)[2][2][4][2], const Unit& u, int wr, int wc, int fr, int fq) const {
        asm volatile("" : "+v"(fr), "+v"(fq));
        const int pn = u.pn, pm = u.pm; const bool lat = pm < 256;
        const int rbase = pm * BM + wr * 64 + fr;
        f32x4 sw[2][2]; float rsv[2][4];
        { const int b = lat ? (pm >> 3) : 32; const float* swp = SWT + ((size_t)pn * 33 + b) * 256 + wc * 32 + 8 * fq;
#pragma unroll
          for (int bj = 0; bj < 2; ++bj)
#pragma unroll
            for (int n = 0; n < 2; ++n) sw[bj][n] = *(const f32x4*)(swp + bj * HALF + 4 * n);
#pragma unroll
          for (int ai = 0; ai < 2; ++ai)
#pragma unroll
            for (int m = 0; m < 4; ++m) rsv[ai][m] = __builtin_amdgcn_rsqf(SS[rbase + ai * HALF + m * 16] * (1.0f / 1024.0f) + 1e-6f); }
#define ZV(ai, bj, m, n) (acc[ai][bj][m][n] * rsv[ai][m] + sw[bj][n])
        if (pn <= 2) {
            if (pn == 2 && wc >= 2) {
#pragma unroll
                for (int ai = 0; ai < 2; ++ai)
#pragma unroll
                    for (int m = 0; m < 4; ++m) { const int row = rbase + ai * HALF + m * 16;
                        const int kvrow = lat ? (row >> 11) * KVROWS + (row & 2047) : ((row - NLAT) >> 8) * KVROWS + 2048 + (row & 255);
                        bf16_t* p = Vb + (size_t)kvrow * 128 + (wc - 2) * 64 + 8 * fq;
#pragma unroll
                        for (int bj = 0; bj < 2; ++bj) { const f32x4 a = ZV(ai, bj, m, 0), c = ZV(ai, bj, m, 1); u32x4 w; w.x = cvt_pk_bf16(a[0], a[1]); w.y = cvt_pk_bf16(a[2], a[3]); w.z = cvt_pk_bf16(c[0], c[1]); w.w = cvt_pk_bf16(c[2], c[3]); *(u32x4*)(p + 32 * bj) = w; } }
            } else {
                const bool isq = pn < 2; const float* gp = isq ? qg : kg; const float osc = isq ? QC2 : 1.0f;
                f32x4 gn[2][2];
#pragma unroll
                for (int bj = 0; bj < 2; ++bj)
#pragma unroll
                    for (int n = 0; n < 2; ++n) gn[bj][n] = *(const f32x4*)(gp + 32 * bj + 8 * fq + 4 * n);
#pragma unroll
                for (int ai = 0; ai < 2; ++ai)
#pragma unroll
                    for (int m = 0; m < 4; ++m) { const int row = rbase + ai * HALF + m * 16;
                        float ss = 0.f;
#pragma unroll
                        for (int bj = 0; bj < 2; ++bj)
#pragma unroll
                            for (int n = 0; n < 2; ++n) { const f32x4 x = ZV(ai, bj, m, n); ss += (x[0] * x[0] + x[1] * x[1]) + (x[2] * x[2] + x[3] * x[3]); }
                        ss += __shfl_xor(ss, 16); ss += __shfl_xor(ss, 32);
                        const float rstd = __builtin_amdgcn_rsqf(ss * (1.0f / 64.0f) + 1e-6f);
                        f32x4 o1[2], o2[2];
#pragma unroll
                        for (int n = 0; n < 2; ++n) { o1[n] = ZV(ai, 0, m, n) * rstd * gn[0][n]; o2[n] = ZV(ai, 1, m, n) * rstd * gn[1][n]; }
                        if (lat) { const int t = row & 2047;
#pragma unroll
                            for (int n = 0; n < 2; ++n) { const f32x4 c = *(const f32x4*)(ropeC + t * 32 + 8 * fq + 4 * n), s = *(const f32x4*)(ropeS + t * 32 + 8 * fq + 4 * n);
                                const f32x4 a = o1[n] * c - o2[n] * s, bq = o1[n] * s + o2[n] * c; o1[n] = a; o2[n] = bq; } }
                        bf16_t* p;
                        if (isq) p = Q + (size_t)row * 512 + (4 * pn + wc) * 64 + 8 * fq;
                        else { const int kvrow = lat ? (row >> 11) * KVROWS + (row & 2047) : ((row - NLAT) >> 8) * KVROWS + 2048 + (row & 255); p = Kb + (size_t)kvrow * 128 + wc * 64 + 8 * fq; }
                        u32x4 w;
                        w.x = cvt_pk_bf16(o1[0][0] * osc, o1[0][1] * osc); w.y = cvt_pk_bf16(o1[0][2] * osc, o1[0][3] * osc); w.z = cvt_pk_bf16(o1[1][0] * osc, o1[1][1] * osc); w.w = cvt_pk_bf16(o1[1][2] * osc, o1[1][3] * osc);
                        *(u32x4*)p = w;
                        w.x = cvt_pk_bf16(o2[0][0] * osc, o2[0][1] * osc); w.y = cvt_pk_bf16(o2[0][2] * osc, o2[0][3] * osc); w.z = cvt_pk_bf16(o2[1][0] * osc, o2[1][1] * osc); w.w = cvt_pk_bf16(o2[1][2] * osc, o2[1][3] * osc);
                        *(u32x4*)(p + 32) = w; }
            }
        } else if (pn == 3) {
#pragma unroll
            for (int ai = 0; ai < 2; ++ai)
#pragma unroll
                for (int m = 0; m < 4; ++m) { const int row = rbase + ai * HALF + m * 16; bf16_t* p = UP + (size_t)row * 256 + wc * 32 + 8 * fq;
#pragma unroll
                    for (int bj = 0; bj < 2; ++bj) { const f32x4 a = ZV(ai, bj, m, 0), c = ZV(ai, bj, m, 1); u32x4 w; w.x = cvt_pk_bf16(a[0], a[1]); w.y = cvt_pk_bf16(a[2], a[3]); w.z = cvt_pk_bf16(c[0], c[1]); w.w = cvt_pk_bf16(c[2], c[3]); *(u32x4*)(p + HALF * bj) = w; } }
        } else {
            const int half = pn - 4;
#pragma unroll
            for (int ai = 0; ai < 2; ++ai)
#pragma unroll
                for (int m = 0; m < 4; ++m) { const int row = rbase + ai * HALF + m * 16;
                    if (lat) { const int b = row >> 11, t = row & 2047; bf16_t* p = VT + ((size_t)b * 256 + 32 * wc + 8 * fq) * 4096 + half * 2048 + t; asm volatile("" : "+v"(p)); __attribute__((address_space(1))) bf16_t* gp = (__attribute__((address_space(1))) bf16_t*)p;
#pragma unroll
                        for (int bj = 0; bj < 2; ++bj)
#pragma unroll
                            for (int n = 0; n < 2; ++n)
#pragma unroll
                                for (int e = 0; e < 4; ++e) gp[(size_t)(128 * bj + 4 * n + e) * 4096] = (bf16_t)f2bf1(ZV(ai, bj, m, n)[e]); }
                    else { const int b = (row - NLAT) >> 8, t = row & 255; bf16_t* p = VTC + ((size_t)b * 256 + 32 * wc + 8 * fq) * 512 + half * 256 + t; asm volatile("" : "+v"(p)); __attribute__((address_space(1))) bf16_t* gp = (__attribute__((address_space(1))) bf16_t*)p;
#pragma unroll
                        for (int bj = 0; bj < 2; ++bj)
#pragma unroll
                            for (int n = 0; n < 2; ++n)
#pragma unroll
                                for (int e = 0; e < 4; ++e) gp[(size_t)(128 * bj + 4 * n + e) * 512] = (bf16_t)f2bf1(ZV(ai, bj, m, n)[e]); } }
        }
    }
#undef ZV
};
struct EpiDFT {
    static constexpr bool PERM = true, AFTER_DRAIN = false;
    bf16_t* AM; int rowbase, L; float sc;
    __device__ __forceinline__ void operator()(const f32x4 (&acc)[2][2][4][2], const Unit& u, int wr, int wc, int fr, int fq) const {
        asm volatile("" : "+v"(fr), "+v"(fq));
        const int r0 = rowbase + u.pn * L + u.pm * BM + wr * 64 + fr;
#pragma unroll
        for (int ai = 0; ai < 2; ++ai)
#pragma unroll
            for (int m = 0; m < 4; ++m) { bf16_t* p = AM + (size_t)(r0 + ai * HALF + m * 16) * DMODEL + 768 + wc * 32 + 8 * fq;
#pragma unroll
                for (int bj = 0; bj < 2; ++bj) { const f32x4 a = acc[ai][bj][m][0] * sc, c = acc[ai][bj][m][1] * sc; u32x4 w; w.x = cvt_pk_bf16(a[0], a[1]); w.y = cvt_pk_bf16(a[2], a[3]); w.z = cvt_pk_bf16(c[0], c[1]); w.w = cvt_pk_bf16(c[2], c[3]); *(u32x4*)(p + HALF * bj) = w; } }
    }
};
struct EpiDummy {
    static constexpr bool PERM = true, AFTER_DRAIN = false;
    float* X;
    __device__ __forceinline__ void operator()(const f32x4 (&acc)[2][2][4][2], const Unit& u, int wr, int wc, int fr, int fq) const {
        f32x4 t = {0.f, 0.f, 0.f, 0.f};
#pragma unroll
        for (int ai = 0; ai < 2; ++ai)
#pragma unroll
            for (int bj = 0; bj < 2; ++bj)
#pragma unroll
                for (int m = 0; m < 4; ++m)
#pragma unroll
                    for (int n = 0; n < 2; ++n) t += acc[ai][bj][m][n];
        if (t[0] + t[1] + t[2] + t[3] == 12345.6789f) X[0] = 1.0f;
    }
};
template <class Epi, class Sched, bool ALIGN_EPI = false, bool SP2 = false>
__device__ __forceinline__ void gemm_phase(PG8_LAS unsigned char* lds, const Gemm g, const Sched& S, const Epi& E) {
    const int tid = fresh_tid(), wid = __builtin_amdgcn_readfirstlane(tid >> 6), lane = tid & 63, wr = wid >> 2, wc = wid & 3, fr = lane & 15, fq = lane >> 4;
    const int K = g.K, nt = K / BK;
    const int pitchA = g.ablk ? BK : K;
    unsigned voffA[2], voffB[2];
#pragma unroll
    for (int i = 0; i < 2; ++i) { int R, C; stage_rc(tid * 16 + i * 8192, R, C); const int Rb = Epi::PERM ? ((R & ~31) + perm32(R & 31)) : R;
        voffA[i] = (unsigned)(R * pitchA + C) * 2u; voffB[i] = (unsigned)(Rb * K + C) * 2u; }
    const size_t kstep = (size_t)(BK * 2);
    const size_t hstep = (size_t)HALF * K * 2;
    const size_t kstepA = g.ablk ? (size_t)BM * BK * 2 : kstep, hstepA = (size_t)HALF * pitchA * 2;
    const size_t tstep = 2 * hstep;
    const unsigned ldsw = (unsigned)wid * 1024u;
    const int aoff = lds_byte(wr * 64 + fr, fq * 8), boff = lds_byte(wc * 32 + fr, fq * 8);
#define PG8_SA(b, h) (((b) * 2 + (h)) * HTB)
#define PG8_SB(b, h) ((4 + (b) * 2 + (h)) * HTB)
#define PG8_STAGE(bufoff, gbase, voff) do { _Pragma("unroll") for (int _i = 0; _i < 2; ++_i) \
        __builtin_amdgcn_global_load_lds((const unsigned*)((const char*)(gbase) + (voff)[_i]), (PG8_LAS unsigned*)(lds + (bufoff) + ldsw + _i * 8192), 16, 0, 0); } while (0)
#define PG8_LDA(dst, b, h) do { _Pragma("unroll") for (int m = 0; m < 4; ++m) _Pragma("unroll") for (int k = 0; k < 2; ++k) dst[m][k] = *(const PG8_LAS bf16x8*)(lds + PG8_SA(b, h) + aoff + m * 2048 + k * 1024); } while (0)
#define PG8_LDB(dst, b, h) do { _Pragma("unroll") for (int n = 0; n < 2; ++n) _Pragma("unroll") for (int k = 0; k < 2; ++k) dst[n][k] = *(const PG8_LAS bf16x8*)(lds + PG8_SB(b, h) + boff + n * 2048 + k * 1024); } while (0)
#define PG8_MMA(ai, bj, At, Bt) do { __builtin_amdgcn_s_setprio(1); _Pragma("unroll") for (int m = 0; m < 4; ++m) _Pragma("unroll") for (int n = 0; n < 2; ++n) _Pragma("unroll") for (int k = 0; k < 2; ++k) \
        acc[ai][bj][m][n] = __builtin_amdgcn_mfma_f32_16x16x32_bf16(Bt[n][k], At[m][k], acc[ai][bj][m][n], 0, 0, 0); __builtin_amdgcn_s_setprio(0); } while (0)
#define PG8_WAIT_V(n) asm volatile("s_waitcnt vmcnt(" #n ")" ::: "memory")
#define PG8_WAIT_L(n) asm volatile("s_waitcnt lgkmcnt(" #n ")" ::: "memory")
#define PG8_BAR __builtin_amdgcn_s_barrier()
#define PG8_SCHED __builtin_amdgcn_sched_barrier(0)
    Unit cur, nxt; int ui = 0;
    if (!S.next(0, cur)) return;
    f32x4 acc[2][2][4][2];
#pragma unroll
    for (int a = 0; a < 2; ++a)
#pragma unroll
        for (int b = 0; b < 2; ++b)
#pragma unroll
            for (int m = 0; m < 4; ++m)
#pragma unroll
                for (int n = 0; n < 2; ++n) acc[a][b][m][n] = (f32x4){0.f, 0.f, 0.f, 0.f};
    bf16x8 At[4][2], B0[2][2], B1[2][2];
    const char* cA = (const char*)g.A + (size_t)cur.pm * tstep; const char* cB = (const char*)g.Bt + (size_t)cur.pn * tstep;
    S.a_ready(cur);
    if constexpr (SP2) {
        PG8_STAGE(PG8_SB(0, 0), cB, voffB); PG8_STAGE(PG8_SB(0, 1), cB + hstep, voffB); PG8_STAGE(PG8_SA(0, 0), cA, voffA); PG8_STAGE(PG8_SA(0, 1), cA + hstepA, voffA);
        if (wr == 1) PG8_BAR;
        PG8_WAIT_V(2); PG8_BAR;
        PG8_STAGE(PG8_SB(1, 0), cB + kstep, voffB); PG8_STAGE(PG8_SA(1, 0), cA + kstepA, voffA); PG8_STAGE(PG8_SB(1, 1), cB + hstep + kstep, voffB);
        PG8_WAIT_V(6); PG8_BAR;
    } else {
        PG8_STAGE(PG8_SB(0, 0), cB, voffB); PG8_STAGE(PG8_SA(0, 0), cA, voffA); PG8_STAGE(PG8_SB(0, 1), cB + hstep, voffB); PG8_STAGE(PG8_SA(0, 1), cA + hstepA, voffA);
        if (wr == 1) PG8_BAR;
        PG8_WAIT_V(4); PG8_BAR;
        PG8_STAGE(PG8_SB(1, 0), cB + kstep, voffB); PG8_STAGE(PG8_SA(1, 0), cA + kstepA, voffA); PG8_STAGE(PG8_SB(1, 1), cB + hstep + kstep, voffB);
        PG8_WAIT_V(6); PG8_BAR;
    }
    for (;;) {
        const bool has_next = S.next(ui + 1, nxt);
        const char* nA = has_next ? (const char*)g.A + (size_t)nxt.pm * tstep : cA; const char* nB = has_next ? (const char*)g.Bt + (size_t)nxt.pn * tstep : cB;
        for (int t = 0; t < nt; t += 2) {
            const bool last = (t == nt - 2);
            const char* a1 = cA + (size_t)(t + 1) * kstepA;
            const char* a2 = last ? nA : cA + (size_t)(t + 2) * kstepA; const char* b2 = last ? nB : cB + (size_t)(t + 2) * kstep;
            const char* a3 = a2 + kstepA; const char* b3 = b2 + kstep;
            if (last && has_next) S.a_ready(nxt);
            if constexpr (SP2) {
            PG8_LDB(B0, 0, 0); PG8_LDB(B1, 0, 1); PG8_SCHED; PG8_LDA(At, 0, 0); PG8_STAGE(PG8_SA(1, 1), a1 + hstepA, voffA);
            PG8_WAIT_V(8); PG8_WAIT_L(0); PG8_BAR; PG8_MMA(0, 0, At, B0); PG8_MMA(0, 1, At, B1); PG8_BAR; PG8_SCHED;
            PG8_LDA(At, 0, 1); PG8_STAGE(PG8_SB(0, 0), b2, voffB); PG8_STAGE(PG8_SB(0, 1), b2 + hstep, voffB); PG8_STAGE(PG8_SA(0, 0), a2, voffA);
            PG8_WAIT_V(8); PG8_WAIT_L(0); PG8_BAR; PG8_MMA(1, 0, At, B0); PG8_MMA(1, 1, At, B1); PG8_BAR; PG8_SCHED;
            PG8_LDB(B0, 1, 0); PG8_LDB(B1, 1, 1); PG8_SCHED; PG8_LDA(At, 1, 0); PG8_STAGE(PG8_SA(0, 1), a2 + hstepA, voffA);
            PG8_WAIT_V(8); PG8_WAIT_L(0); PG8_BAR; PG8_MMA(0, 0, At, B0); PG8_MMA(0, 1, At, B1); PG8_BAR; PG8_SCHED;
            PG8_LDA(At, 1, 1); PG8_STAGE(PG8_SB(1, 0), b3, voffB); PG8_STAGE(PG8_SB(1, 1), b3 + hstep, voffB); PG8_STAGE(PG8_SA(1, 0), a3, voffA);
            PG8_WAIT_V(8); PG8_WAIT_L(0); PG8_BAR; PG8_MMA(1, 0, At, B0); PG8_MMA(1, 1, At, B1); PG8_BAR; PG8_SCHED;
            } else {
            PG8_LDB(B0, 0, 0); PG8_SCHED; PG8_LDA(At, 0, 0); PG8_STAGE(PG8_SA(1, 1), a1 + hstepA, voffA);
            PG8_WAIT_L(8); PG8_BAR; PG8_WAIT_L(0); PG8_MMA(0, 0, At, B0); PG8_BAR; PG8_SCHED;
            PG8_LDB(B1, 0, 1); PG8_STAGE(PG8_SB(0, 0), b2, voffB);
            PG8_BAR; PG8_WAIT_L(0); PG8_MMA(0, 1, At, B1); PG8_BAR;
            PG8_LDA(At, 0, 1); PG8_STAGE(PG8_SA(0, 0), a2, voffA);
            PG8_BAR; PG8_WAIT_L(0); PG8_MMA(1, 0, At, B0); PG8_BAR; PG8_SCHED;
            PG8_STAGE(PG8_SB(0, 1), b2 + hstep, voffB);
            PG8_WAIT_V(6); PG8_BAR; PG8_MMA(1, 1, At, B1); PG8_BAR;
            PG8_LDB(B0, 1, 0); PG8_SCHED; PG8_LDA(At, 1, 0); PG8_STAGE(PG8_SA(0, 1), a2 + hstepA, voffA);
            PG8_WAIT_L(8); PG8_BAR; PG8_WAIT_L(0); PG8_MMA(0, 0, At, B0); PG8_BAR; PG8_SCHED;
            PG8_LDB(B1, 1, 1); PG8_STAGE(PG8_SB(1, 0), b3, voffB);
            PG8_BAR; PG8_WAIT_L(0); PG8_MMA(0, 1, At, B1); PG8_BAR;
            PG8_LDA(At, 1, 1); PG8_STAGE(PG8_SA(1, 0), a3, voffA);
            PG8_BAR; PG8_WAIT_L(0); PG8_MMA(1, 0, At, B0); PG8_BAR; PG8_SCHED;
            PG8_STAGE(PG8_SB(1, 1), b3 + hstep, voffB);
            PG8_WAIT_V(6); PG8_BAR; PG8_MMA(1, 1, At, B1); PG8_BAR;
            }
        }
        if constexpr (ALIGN_EPI) { if (wr == 0) PG8_BAR; }
        if constexpr (!Epi::AFTER_DRAIN) { E(acc, cur, wr, wc, fr, fq); S.done(cur); }
        if (!has_next) break;
#pragma unroll
        for (int a = 0; a < 2; ++a)
#pragma unroll
            for (int b = 0; b < 2; ++b)
#pragma unroll
                for (int m = 0; m < 4; ++m)
#pragma unroll
                    for (int n = 0; n < 2; ++n) acc[a][b][m][n] = (f32x4){0.f, 0.f, 0.f, 0.f};
        cur = nxt; cA = nA; cB = nB; ++ui;
        if constexpr (ALIGN_EPI) { if (wr == 1) PG8_BAR; }
    }
    PG8_WAIT_V(0);
    if constexpr (!ALIGN_EPI) { if (wr == 0) PG8_BAR; }
    PG8_BAR;
    if constexpr (Epi::AFTER_DRAIN) { E.fused(acc, cur, wr, wc, fr, fq, lds, wid, lane); S.done(cur); }
#undef PG8_SA
#undef PG8_SB
#undef PG8_STAGE
#undef PG8_LDA
#undef PG8_LDB
#undef PG8_MMA
#undef PG8_WAIT_V
#undef PG8_WAIT_L
#undef PG8_BAR
#undef PG8_SCHED
}
}
#include <hip/hip_bf16.h>
#include <cmath>
namespace attn_body {
using bf16=__hip_bfloat16;
using bf16x8=__attribute__((ext_vector_type(8)))short;
using s16x4=__attribute__((ext_vector_type(4)))short;
using f32x16=__attribute__((ext_vector_type(16)))float;
using u32x4=__attribute__((ext_vector_type(4)))unsigned;
constexpr int D=64,QP=512,KVP=128,OP=1024;
constexpr int NW=8,QBLK=32,QB=QBLK*NW,KVBLK=64;
__device__ __forceinline__ int crow(int r,int hi){return (r&3)+8*(r>>2)+4*hi;}
#define SBAR() __builtin_amdgcn_sched_barrier(0)
constexpr int NSLOT=3, SLOTB=8192;
constexpr int LDS_K=0, LDS_V=NSLOT*SLOTB, LDS_WS=2*NSLOT*SLOTB, LDS_OST=LDS_WS+NW*64*4, LDS_BYTES=LDS_OST+NW*4096;
constexpr float C2=0.125f*1.4426950408889634f;
__device__ __forceinline__ void glds16(const void*gsrc,unsigned lds_dst){unsigned keep;
  asm volatile("s_mov_b32 %0, m0\n\ts_mov_b32 m0, %2\n\ts_nop 0\n\tglobal_load_lds_dwordx4 %1, off\n\ts_mov_b32 m0, %0":"=&s"(keep):"v"(gsrc),"s"(lds_dst):"memory");}
__device__ __forceinline__ float max3f(float a,float b,float c){float r;asm("v_max3_f32 %0, %1, %2, %3":"=v"(r):"v"(a),"v"(b),"v"(c));return r;}
__device__ __forceinline__ float max2f(float a,float b){float r;asm("v_max_f32_e32 %0, %1, %2":"=v"(r):"v"(a),"v"(b));return r;}
__device__ __forceinline__ float fadd_s(float a,float b){float r;asm("v_add_f32_e32 %0, %1, %2":"=v"(r):"v"(a),"v"(b));return r;}
__device__ __forceinline__ float fsub_s(float a,float b){float r;asm("v_sub_f32_e32 %0, %1, %2":"=v"(r):"v"(a),"v"(b));return r;}
typedef float f32x2_t __attribute__((ext_vector_type(2))); typedef __bf16 bf16x2_t __attribute__((ext_vector_type(2)));
__device__ __forceinline__ unsigned cvtpk_s(float lo,float hi){f32x2_t v={lo,hi};bf16x2_t b=__builtin_convertvector(v,bf16x2_t);return __builtin_bit_cast(unsigned,b);}
#define WAIT_BAR(N) asm volatile("s_waitcnt vmcnt(" #N ") lgkmcnt(0)\n\ts_barrier":::"memory")

__device__ __forceinline__ void qkt(f32x16&p0,f32x16&p1,const char*Kslot,const bf16x8*qr,const f32x16&negm,int r32,int hi){
  const char*kb=Kslot+hi*1024+r32*16;
  #pragma unroll
  for(int d0=0;d0<4;++d0){
    const bf16x8 b0=*reinterpret_cast<const bf16x8*>(kb+d0*2048);
    const bf16x8 b1=*reinterpret_cast<const bf16x8*>(kb+d0*2048+512);
    if(d0==0){p0=__builtin_amdgcn_mfma_f32_32x32x16_bf16(b0,qr[0],negm,0,0,0);p1=__builtin_amdgcn_mfma_f32_32x32x16_bf16(b1,qr[0],negm,0,0,0);}
    else{p0=__builtin_amdgcn_mfma_f32_32x32x16_bf16(b0,qr[d0],p0,0,0,0);p1=__builtin_amdgcn_mfma_f32_32x32x16_bf16(b1,qr[d0],p1,0,0,0);}}
}
typedef __attribute__((address_space(3))) const char* lds_cptr;
typedef short v4i16_t __attribute__((ext_vector_type(4)));
__device__ __forceinline__ void kload8(bf16x8*kf,lds_cptr kp){
  kf[0]=*(const __attribute__((address_space(3))) bf16x8*)(kp);      kf[1]=*(const __attribute__((address_space(3))) bf16x8*)(kp+512);
  kf[2]=*(const __attribute__((address_space(3))) bf16x8*)(kp+2048); kf[3]=*(const __attribute__((address_space(3))) bf16x8*)(kp+2560);
  kf[4]=*(const __attribute__((address_space(3))) bf16x8*)(kp+4096); kf[5]=*(const __attribute__((address_space(3))) bf16x8*)(kp+4608);
  kf[6]=*(const __attribute__((address_space(3))) bf16x8*)(kp+6144); kf[7]=*(const __attribute__((address_space(3))) bf16x8*)(kp+6656);
}
__device__ __forceinline__ void kload2(bf16x8*kf,lds_cptr kp,int j){ kf[2*j]=*(const __attribute__((address_space(3))) bf16x8*)(kp+j*2048); kf[2*j+1]=*(const __attribute__((address_space(3))) bf16x8*)(kp+j*2048+512); }
__device__ __forceinline__ s16x4 vtr(lds_cptr p){ return __builtin_bit_cast(s16x4,__builtin_amdgcn_ds_read_tr16_b64_v4i16((__attribute__((address_space(3))) v4i16_t*)p)); }
__device__ __forceinline__ float rowmax(const f32x16&p0,const f32x16&p1){
  float a=max3f(p0[0],p0[1],p1[0]),b=max3f(p0[2],p0[3],p1[1]);a=max3f(a,p1[2],p1[3]);
  #pragma unroll
  for(int r=4;r<16;r+=4){a=max3f(a,p0[r],p0[r+1]);b=max3f(b,p0[r+2],p0[r+3]);a=max3f(a,p1[r],p1[r+1]);b=max3f(b,p1[r+2],p1[r+3]);}
  const float m=max2f(a,b);
  auto rr=__builtin_amdgcn_permlane32_swap(__float_as_uint(m),__float_as_uint(m),false,false);
  return max2f(__uint_as_float(rr[0]),__uint_as_float(rr[1]));
}
__device__ __forceinline__ void pv(f32x16*o,int vb,bf16x8 pa0,bf16x8 pa1,bf16x8 pa2,bf16x8 pa3){
  #pragma unroll
  for(int d0=0;d0<2;++d0){s16x4 lo[4],hi[4];
    #pragma unroll
    for(int ks=0;ks<4;++ks){
      asm volatile("ds_read_b64_tr_b16 %0,%1 offset:%c2":"=&v"(lo[ks]):"v"(vb),"i"(d0*4096+ks*1024):"memory");
      asm volatile("ds_read_b64_tr_b16 %0,%1 offset:%c2":"=&v"(hi[ks]):"v"(vb),"i"(d0*4096+ks*1024+512):"memory");}
    asm volatile("s_waitcnt lgkmcnt(0)":::"memory");SBAR();
    #define PK(k) (bf16x8){lo[k][0],lo[k][1],lo[k][2],lo[k][3],hi[k][0],hi[k][1],hi[k][2],hi[k][3]}
    o[d0]=__builtin_amdgcn_mfma_f32_32x32x16_bf16(pa0,PK(0),o[d0],0,0,0);
    o[d0]=__builtin_amdgcn_mfma_f32_32x32x16_bf16(pa1,PK(1),o[d0],0,0,0);
    o[d0]=__builtin_amdgcn_mfma_f32_32x32x16_bf16(pa2,PK(2),o[d0],0,0,0);
    o[d0]=__builtin_amdgcn_mfma_f32_32x32x16_bf16(pa3,PK(3),o[d0],0,0,0);
    #undef PK
  }
}

#ifndef ATTN_STORE16
#define ATTN_STORE16(p,v) (*(u32x4*)(p)=(v))
#endif
template<int THRL> __device__ __forceinline__ void attn_unit(const bf16*Qb,const bf16*Kh,const bf16*Vh,bf16*Ob,const int NT,char*shm){
  const int tid=fresh_tid(),lane=tid&63,r32=lane&31,hi=lane>>5; const int wid=__builtin_amdgcn_readfirstlane(tid>>6);
  const bf16*Qw=Qb+(long)(wid*QBLK)*QP;
  const unsigned lds0=(unsigned)(uintptr_t)shm;
  float*wsf=(float*)(shm+LDS_WS)+wid*64;
  const bf16*ksrc=Kh+(long)lane*KVP+wid*8;
  const bf16*vsrc=Vh+(long)(16*(wid&3)+(lane>>2))*KVP+(wid>>2)*32+(lane&3)*8;
  const unsigned kdst=lds0+LDS_K+wid*1024, vdst=lds0+LDS_V+wid*1024;
  #define DMA_K(t,slot) glds16(ksrc+(long)(t)*KVBLK*KVP,(unsigned)__builtin_amdgcn_readfirstlane(kdst+(slot)))
  #define DMA_V(t,slot) glds16(vsrc+(long)(t)*KVBLK*KVP,(unsigned)__builtin_amdgcn_readfirstlane(vdst+(slot)))
  const int vb0=(int)(lds0+LDS_V)+((lane>>4)&1)*32+(lane&3)*8+(4*hi+((lane&15)>>2))*64;
  const char*Kbase=shm+LDS_K; bf16x8 kf[8];
  const lds_cptr shm3=(lds_cptr)shm; const lds_cptr kp0=shm3+LDS_K+hi*1024+r32*16; const lds_cptr vp0=shm3+LDS_V+((lane>>4)&1)*32+(lane&3)*8+(4*hi+((lane&15)>>2))*64;
  DMA_K(0,0);DMA_V(0,0);DMA_K(1,SLOTB);
  bf16x8 qr[4];
  #pragma unroll
  for(int d0=0;d0<4;++d0)qr[d0]=*reinterpret_cast<const bf16x8*>(&Qw[(long)r32*QP+d0*16+hi*8]);
  float mhat=0.f,l_reg=0.f;f32x16 o[2];o[0]=f32x16{};o[1]=f32x16{};f32x16 negm=f32x16{};asm volatile("":"+v"(negm));
  const int qrel=wid*QBLK+r32;
  #define CMASK(P0,P1,t) do{}while(0)
  bool resc=false;
  #define START(P0,P1) do{ const float rm=rowmax(P0,P1); resc=false; \
    { const float dl=rm; mhat=fadd_s(mhat,dl); \
      _Pragma("unroll") for(int r=0;r<16;++r){P0[r]=fsub_s(P0[r],dl);P1[r]=fsub_s(P1[r],dl);} \
      _Pragma("unroll") for(int r=0;r<16;++r)negm[r]=-mhat; asm volatile("":"+v"(negm)); } \
    _Pragma("unroll") for(int r=0;r<16;++r)P0[r]=__builtin_amdgcn_exp2f(P0[r]); }while(0)
  #define RESC() do{ if(resc){ asm volatile("s_waitcnt lgkmcnt(0)":::"memory"); \
      _Pragma("unroll") for(int d_=0;d_<2;++d_) _Pragma("unroll") for(int r=0;r<16;++r)o[d_][r]*=wsf[crow(r,hi)]; } }while(0)
  f32x16 pA0,pA1,pB0,pB1;
  int sl_prev=0,sl_cur=0,sl_next=SLOTB;
  #define ROT() do{sl_prev=sl_cur;sl_cur=sl_next;sl_next=(sl_next==(NSLOT-1)*SLOTB)?0:sl_next+SLOTB;}while(0)
  DMA_K(2,2*SLOTB);
  WAIT_BAR(3);
  qkt(pA0,pA1,Kbase,qr,negm,r32,hi);asm volatile("s_nop 15\n\ts_nop 7":"+v"(pA0),"+v"(pA1));CMASK(pA0,pA1,0);
  START(pA0,pA1);
  _Pragma("unroll") for(int r=0;r<16;++r)pA1[r]=__builtin_amdgcn_exp2f(pA1[r]);
  WAIT_BAR(0);
  DMA_K(3,0);DMA_V(1,SLOTB);
  ROT();
  kload8(kf,kp0+sl_cur);
  WAIT_BAR(2);
  s16x4 vlo[8],vhi[8]; u32x4 pw0,pw1,pw2,pw3;
  #define PKW(P,B) cvtpk_s(P[B],P[B+1])
  #define PAF(k) __builtin_bit_cast(bf16x8,pw##k)
  #define VFR(i) (bf16x8){vlo[i][0],vlo[i][1],vlo[i][2],vlo[i][3],vhi[i][0],vhi[i][1],vhi[i][2],vhi[i][3]}
  #define PIN(x) asm volatile("":"+v"(x))
  #define MX3(a,b,c) __builtin_fmaxf(__builtin_fmaxf((a),(b)),(c))
  #define GAPA(MF,A0,A1,A2,A3,W0,W1,PW) do{ MF; sacc+=A0; sacc+=A1; sacc+=A2; sacc+=A3; PIN(sacc); W0; W1; PIN(PW); SBAR(); }while(0)
  #define EX(v) __builtin_amdgcn_exp2f(v)
  #define GAPB(MF,X,B) do{ MF; X[B]=EX(X[B]); X[B+1]=EX(X[B+1]); X[B+2]=EX(X[B+2]); X[B+3]=EX(X[B+3]); PIN(X); SBAR(); }while(0)
  #define VRD(i) do{ vlo[i]=vtr(vp_+(((i)>>2)*4096+((i)&3)*1024)); vhi[i]=vtr(vp_+(((i)>>2)*4096+((i)&3)*1024+512)); }while(0)
  #define KRD(G,j) do{ if(G){ kload2(kf,kp0+sl_next,j); SBAR(); } }while(0)
  #define STEP(C0,C1,P0,P1,t,GK,GV,GL) do{ SBAR(); \
    const lds_cptr vp_=vp0+sl_prev; \
    VRD(0); SBAR(); float sacc=(P0[0]+P0[1]); \
    GAPA(C0=__builtin_amdgcn_mfma_f32_32x32x16_bf16(kf[0],qr[0],negm,0,0,0), P0[2],P0[3],P0[4],P0[5],     pw0[0]=PKW(P0,0), pw0[1]=PKW(P0,2), pw0); \
    VRD(4); SBAR(); GAPA(C1=__builtin_amdgcn_mfma_f32_32x32x16_bf16(kf[1],qr[0],negm,0,0,0), P0[6],P0[7],P0[8],P0[9],     pw0[2]=PKW(P0,4), pw0[3]=PKW(P0,6), pw0); \
    VRD(1); SBAR(); GAPA(C0=__builtin_amdgcn_mfma_f32_32x32x16_bf16(kf[2],qr[1],C0,0,0,0),   P0[10],P0[11],P0[12],P0[13], pw1[0]=PKW(P0,8), pw1[1]=PKW(P0,10), pw1); \
    VRD(5); SBAR(); GAPA(C1=__builtin_amdgcn_mfma_f32_32x32x16_bf16(kf[3],qr[1],C1,0,0,0),   P0[14],P0[15],P1[0],P1[1],   pw1[2]=PKW(P0,12),pw1[3]=PKW(P0,14), pw1); \
    VRD(2); SBAR(); GAPA(C0=__builtin_amdgcn_mfma_f32_32x32x16_bf16(kf[4],qr[2],C0,0,0,0),   P1[2],P1[3],P1[4],P1[5],     pw2[0]=PKW(P1,0), pw2[1]=PKW(P1,2), pw2); \
    VRD(6); SBAR(); GAPA(C1=__builtin_amdgcn_mfma_f32_32x32x16_bf16(kf[5],qr[2],C1,0,0,0),   P1[6],P1[7],P1[8],P1[9],     pw2[2]=PKW(P1,4), pw2[3]=PKW(P1,6), pw2); \
    VRD(3); SBAR(); GAPA(C0=__builtin_amdgcn_mfma_f32_32x32x16_bf16(kf[6],qr[3],C0,0,0,0),   P1[10],P1[11],P1[12],P1[13], pw3[0]=PKW(P1,8), pw3[1]=PKW(P1,10), pw3); \
    VRD(7); SBAR(); GAPA(C1=__builtin_amdgcn_mfma_f32_32x32x16_bf16(kf[7],qr[3],C1,0,0,0),   P1[14],P1[15],0.f,0.f,       pw3[2]=PKW(P1,12),pw3[3]=PKW(P1,14), pw3); \
    l_reg+=sacc; \
    if(GK){DMA_K((t)+3,sl_cur);} if(GV){DMA_V((t)+1,sl_next);} \
    CMASK(C0,C1,t); \
    { float a=MX3(C0[0],C0[1],C1[0]),b=MX3(C0[2],C0[3],C1[1]); a=MX3(a,C1[2],C1[3]); \
      _Pragma("unroll") for(int r=4;r<16;r+=4){a=MX3(a,C0[r],C0[r+1]);b=MX3(b,C0[r+2],C0[r+3]);a=MX3(a,C1[r],C1[r+1]);b=MX3(b,C1[r+2],C1[r+3]);} \
      float rm=__builtin_fmaxf(a,b); { auto rr=__builtin_amdgcn_permlane32_swap(__float_as_uint(rm),__float_as_uint(rm),false,false); rm=__builtin_fmaxf(__uint_as_float(rr[0]),__uint_as_float(rr[1])); } \
      resc=false; \
      if(__builtin_expect(__any(rm>(float)THRL),0)){ const float dl=__builtin_fmaxf(rm,0.f); mhat+=dl; \
        _Pragma("unroll") for(int r=0;r<16;++r){C0[r]-=dl;C1[r]-=dl;} \
        _Pragma("unroll") for(int r=0;r<16;++r)negm[r]=-mhat; asm volatile("":"+v"(negm)); \
        const float f=__builtin_amdgcn_exp2f(-dl); l_reg*=f; if(hi==0)wsf[r32]=f; resc=true; } } \
    SBAR(); \
    GAPB(o[0]=__builtin_amdgcn_mfma_f32_32x32x16_bf16(PAF(0),VFR(0),o[0],0,0,0), C0,0); \
    GAPB(o[1]=__builtin_amdgcn_mfma_f32_32x32x16_bf16(PAF(0),VFR(4),o[1],0,0,0), C0,4); \
    KRD(GL,0); GAPB(o[0]=__builtin_amdgcn_mfma_f32_32x32x16_bf16(PAF(1),VFR(1),o[0],0,0,0), C0,8); \
    KRD(GL,1); GAPB(o[1]=__builtin_amdgcn_mfma_f32_32x32x16_bf16(PAF(1),VFR(5),o[1],0,0,0), C0,12); \
    KRD(GL,2); GAPB(o[0]=__builtin_amdgcn_mfma_f32_32x32x16_bf16(PAF(2),VFR(2),o[0],0,0,0), C1,0); \
    KRD(GL,3); GAPB(o[1]=__builtin_amdgcn_mfma_f32_32x32x16_bf16(PAF(2),VFR(6),o[1],0,0,0), C1,4); \
    GAPB(o[0]=__builtin_amdgcn_mfma_f32_32x32x16_bf16(PAF(3),VFR(3),o[0],0,0,0), C1,8); \
    GAPB(o[1]=__builtin_amdgcn_mfma_f32_32x32x16_bf16(PAF(3),VFR(7),o[1],0,0,0), C1,12); \
    }while(0)
  int t=1;
  #undef CMASK
  #define CMASK(P0,P1,t) do{}while(0)
  for(;t+5<NT;t+=2){
    STEP(pB0,pB1,pA0,pA1,t,true,true,true);     WAIT_BAR(2); RESC(); ROT();
    STEP(pA0,pA1,pB0,pB1,t+1,true,true,true);   WAIT_BAR(2); RESC(); ROT();
  }
  #undef CMASK
  #define CMASK(P0,P1,t) do{}while(0)
  #define ENDW(tt) do{ if((tt)+3<NT){WAIT_BAR(2);} else if((tt)+2<NT){WAIT_BAR(1);} else {WAIT_BAR(0);} }while(0)
  for(;t+1<NT;t+=2){
    STEP(pB0,pB1,pA0,pA1,t,(t+3<NT),(t+1<NT),(t+1<NT));       ENDW(t);   RESC(); ROT();
    STEP(pA0,pA1,pB0,pB1,t+1,(t+4<NT),(t+2<NT),(t+2<NT));     ENDW(t+1); RESC(); ROT();
  }
  STEP(pB0,pB1,pA0,pA1,NT-1,false,false,false); RESC();
  { float sacc=pB0[0]+pB0[1]; _Pragma("unroll") for(int r=2;r<16;++r)sacc+=pB0[r]; _Pragma("unroll") for(int r=0;r<16;++r)sacc+=pB1[r]; l_reg+=sacc;
    pw0=(u32x4){PKW(pB0,0),PKW(pB0,2),PKW(pB0,4),PKW(pB0,6)};pw1=(u32x4){PKW(pB0,8),PKW(pB0,10),PKW(pB0,12),PKW(pB0,14)};pw2=(u32x4){PKW(pB1,0),PKW(pB1,2),PKW(pB1,4),PKW(pB1,6)};pw3=(u32x4){PKW(pB1,8),PKW(pB1,10),PKW(pB1,12),PKW(pB1,14)};
    SBAR(); pv(o,vb0+sl_cur,PAF(0),PAF(1),PAF(2),PAF(3)); }
  #undef PKW
  #undef PAF
  #undef VFR
  #undef PIN
  #undef MX3
  #undef GAPA
  #undef GAPB
  #undef EX
  #undef VRD
  #undef KRD
  #undef STEP
  #undef ENDW
  {auto rr=__builtin_amdgcn_permlane32_swap(__float_as_uint(l_reg),__float_as_uint(l_reg),false,false);l_reg=__uint_as_float(rr[0])+__uint_as_float(rr[1]);}
  if(hi==0)wsf[32+r32]=l_reg;asm volatile("s_waitcnt lgkmcnt(0)":::"memory");
  float rli[16];
  #pragma unroll
  for(int r=0;r<16;++r)rli[r]=__builtin_amdgcn_rcpf(wsf[32+crow(r,hi)]);
  bf16*Ow=Ob+(long)(wid*QBLK)*OP;
  { bf16*stg=(bf16*)(shm+LDS_OST)+wid*2048;
    #pragma unroll
    for(int r=0;r<16;++r){const int orow=crow(r,hi);
      #pragma unroll
      for(int d0=0;d0<2;++d0)stg[orow*64+d0*32+r32]=__float2bfloat16(o[d0][r]*rli[r]);}
    asm volatile("s_waitcnt lgkmcnt(0)":::"memory");
    #pragma unroll
    for(int i=0;i<4;++i){const int row=i*8+(lane>>3),ch=lane&7; const u32x4 v=*(const u32x4*)(stg+row*64+ch*8); ATTN_STORE16(Ow+(long)row*OP+ch*8,v);} }
  asm volatile("s_waitcnt lgkmcnt(0)\n\ts_barrier":::"memory");
  #undef DMA_K
  #undef DMA_V
  #undef CMASK
  #undef START
  #undef RESC
  #undef ROT
}
constexpr int ATTN_LDS_BYTES=LDS_BYTES;
#undef SBAR
#undef WAIT_BAR
}
#define LAS __attribute__((address_space(3)))
typedef unsigned short bf16;
typedef float f32x4 __attribute__((ext_vector_type(4)));
typedef unsigned v4u __attribute__((ext_vector_type(4)));
typedef unsigned v2u __attribute__((ext_vector_type(2)));
constexpr size_t MiB = 1u << 20;
constexpr size_t WS_MOD = 1 * MiB;
constexpr size_t WS_ROPE = 6 * MiB;
constexpr size_t WS_ACAT = 7 * MiB;
constexpr size_t WS_ACATC = 23 * MiB;
constexpr size_t WS_WGU = 24 * MiB;
constexpr size_t WS_WIN = 112 * MiB;
constexpr size_t WS_WDN = 124 * MiB;
constexpr size_t WS_WOUT = 168 * MiB;
constexpr size_t WS_ZERO = 0;
constexpr size_t WS_A = 176 * MiB;
constexpr size_t WS_HID = 320 * MiB;
constexpr size_t WS_Q = WS_HID;
constexpr size_t WS_K = WS_HID + 72 * MiB;
constexpr size_t WS_V = WS_HID + 90 * MiB;
constexpr size_t WS_UP = WS_HID + 108 * MiB;
constexpr size_t WS_VT = WS_HID + 144 * MiB;
constexpr size_t WS_VTC = WS_HID + 208 * MiB;
constexpr size_t WS_MODP = WS_HID;
constexpr size_t WS_A2 = 716 * MiB;
constexpr size_t WS_SS = 860 * MiB;
constexpr size_t WS_SH = 864 * MiB;
constexpr size_t WS_SWT = 870 * MiB;
constexpr size_t WS_LO = 878 * MiB;
constexpr size_t WS_END = 950 * MiB;
constexpr int LDS_BYTES = 147456, TAB_OFF = 131072;

#define XB_TMO      128
#define XB_XCNT(j)  (256  + 64 * (j))
#define XB_XSUB(j)  (1280 + 64 * (j))
#define XB_XGEN(j)  (2304 + 64 * (j))
#define XB_TOP      3328
#define XB_TOPGEN   3392
#define XCD_BAR_WORDS 3456
#define XB_SPIN_CAP (1u << 18)

__device__ __forceinline__ unsigned xb_ld(unsigned* p)              { return __hip_atomic_load(p, __ATOMIC_RELAXED, __HIP_MEMORY_SCOPE_AGENT); }
__device__ __forceinline__ unsigned xb_add(unsigned* p, unsigned v) { return __hip_atomic_fetch_add(p, v, __ATOMIC_RELAXED, __HIP_MEMORY_SCOPE_AGENT); }
__device__ __forceinline__ unsigned xb_xcc_id() { return (unsigned)__builtin_amdgcn_s_getreg((3 << 11) | 20) & 0xFu; }
#define XB_SPIN(cond, bar) do { unsigned _sp = 0; while (cond) { __builtin_amdgcn_s_sleep(1); \
    if ((++_sp & 255u) == 0u) { if (xb_ld(&(bar)[XB_TMO])) break; if (_sp > XB_SPIN_CAP) { atomicAdd(&(bar)[XB_TMO], 1u); break; } } } } while (0)

struct XcdBarrier {
    unsigned* bar; unsigned x;
    volatile LAS unsigned* st;
};

__device__ __forceinline__ XcdBarrier xcd_barrier_post(unsigned* bar, volatile LAS unsigned* st) {
    XcdBarrier b; b.bar = bar; b.x = xb_xcc_id(); b.st = st;
    if (threadIdx.x == 0) (void)xb_add(&bar[XB_XCNT(b.x)], 1u);
    return b;
}
__device__ __forceinline__ void xcd_barrier_complete(unsigned* bar, unsigned x, unsigned& nloc, unsigned& nx) {
    const unsigned G = gridDim.x * gridDim.y * gridDim.z;
    unsigned sum, cnt, mine, sp = 0u;
    for (;;) {
        sum = 0u; cnt = 0u; mine = 0u;
#pragma unroll
        for (unsigned j = 0; j < 16; ++j) { const unsigned c = xb_ld(&bar[XB_XCNT(j)]); sum += c; cnt += (c > 0u) ? 1u : 0u; mine = (j == x) ? c : mine; }
        if (sum == G) break;
        __builtin_amdgcn_s_sleep(1);
        if ((++sp & 255u) == 0u) { if (xb_ld(&bar[XB_TMO])) break; if (sp > XB_SPIN_CAP) { atomicAdd(&bar[XB_TMO], 1u); break; } }
    }
    nloc = mine > 0u ? mine : 1u; nx = cnt > 0u ? cnt : 1u;
}

__device__ __forceinline__ void xcd_barrier(const XcdBarrier& b) {
    asm volatile("s_waitcnt vmcnt(0)" ::: "memory");
    __syncthreads();
    if (threadIdx.x == 0) {
        unsigned* bar = b.bar;
        __builtin_amdgcn_s_waitcnt(0);
        unsigned nloc = b.st[0], nx = b.st[1];
        if (nloc == 0u) { xcd_barrier_complete(bar, b.x, nloc, nx); b.st[0] = nloc; b.st[1] = nx; }
        const unsigned old = xb_add(&bar[XB_XSUB(b.x)], 1u);
        const unsigned gen = old / nloc;
        if (old + 1u == (gen + 1u) * nloc) {
            __builtin_amdgcn_fence(__ATOMIC_RELEASE, "agent");
            asm volatile("s_waitcnt vmcnt(0)" ::: "memory");
            const unsigned og = xb_add(&bar[XB_TOP], 1u);
            const unsigned tg = og / nx;
            if (og + 1u == (tg + 1u) * nx) xb_add(&bar[XB_TOPGEN], 1u);
            else XB_SPIN(xb_ld(&bar[XB_TOPGEN]) == tg, bar);
            __builtin_amdgcn_fence(__ATOMIC_ACQUIRE, "agent");
            xb_add(&bar[XB_XGEN(b.x)], 1u);
            asm volatile("s_waitcnt vmcnt(0)" ::: "memory");
        } else {
            XB_SPIN(xb_ld(&bar[XB_XGEN(b.x)]) == gen, bar);
            __builtin_amdgcn_fence(__ATOMIC_ACQUIRE, "agent");
            asm volatile("s_waitcnt vmcnt(0)" ::: "memory");
        }
    }
    __syncthreads();
}

#ifndef PROBE
#define PROBE 0
#endif
#if PROBE == 6
#define GSYNC() do { xcd_barrier(mk_xbar(args.ws, L)); xcd_barrier(mk_xbar(args.ws, L)); } while (0)
#else
#define GSYNC() xcd_barrier(mk_xbar(args.ws, L))
#endif
constexpr size_t WS_BAR = 65536;
constexpr int XB_LDS_OFF = TAB_OFF + 12288;
__device__ __forceinline__ XcdBarrier mk_xbar(unsigned char* ws, LAS unsigned char* L) { asm volatile("" : "+s"(ws)); XcdBarrier b; b.bar = (unsigned*)(ws + WS_BAR); b.x = xb_xcc_id(); b.st = (volatile LAS unsigned*)(L + XB_LDS_OFF); return b; }
struct Args { const float* in[18]; float* out; unsigned char* ws; };
constexpr int I_GU = 16 * 176, I_DN = 44 * 32, I_IN = 16 * 32, I_OUT = 8 * 32;

__device__ __forceinline__ void stagger(int ticks) {
    if (ticks > 0) { const unsigned long long t0 = __builtin_amdgcn_s_memrealtime(); while ((long long)(__builtin_amdgcn_s_memrealtime() - t0) < (long long)ticks) __builtin_amdgcn_s_sleep(8); }
}
#ifndef STG_GU
#define STG_GU 0
#endif
#ifndef STG_DN
#define STG_DN 0
#endif
#ifndef STG_OUT
#define STG_OUT 0
#endif
__device__ __forceinline__ float wave_sum(float v) {
#pragma unroll
    for (int o = 1; o < 64; o <<= 1) v += __shfl_xor(v, o);
    return v;
}
__device__ __forceinline__ unsigned pk2(float lo, float hi) { return pg8::cvt_pk_bf16(lo, hi); }
__device__ __forceinline__ int map_row(int mode, int n) {
    if (mode == 0) return n;
    if (mode == 3) return 256 * (n >> 8) + 128 * ((n >> 3) & 1) + 32 * ((n >> 6) & 3) + 8 * ((n >> 4) & 3) + (n & 7);
    if (mode == 1) { const int isu = n >= DFF ? 1 : 0; const int j = n - isu * DFF; return 256 * (j >> 7) + 128 * isu + (j & 127); }
    if (n < 512) { const int h = n >> 6, d = n & 63; return 256 * (h >> 2) + 128 * (d >> 5) + 32 * (h & 3) + (d & 31); }
    if (n < 768) { const int wc = (n - 512) >> 6, d = n & 63; return 512 + 128 * (d >> 5) + 32 * wc + (d & 31); }
    return n;
}
__device__ __forceinline__ void transpose_item(const float* W, int ldw, bf16* WT, int ldt, int mode, LAS float* scr, int kb, int nb, int lane) {
    const int k0 = 64 * kb, n0 = 32 * nb;
#pragma unroll 8
    for (int i = 0; i < 32; ++i) { const int kk = 2 * i + (lane >> 5); scr[kk * 33 + (lane & 31)] = W[(size_t)(k0 + kk) * ldw + n0 + (lane & 31)]; }
    asm volatile("s_waitcnt lgkmcnt(0)" ::: "memory");
    const int c = lane & 7;
#pragma unroll
    for (int j = 0; j < 4; ++j) { const int n = (lane >> 3) + 8 * j; const LAS float* s = scr + (8 * c) * 33 + n;
        v4u o; o.x = pk2(s[0 * 33], s[1 * 33]); o.y = pk2(s[2 * 33], s[3 * 33]); o.z = pk2(s[4 * 33], s[5 * 33]); o.w = pk2(s[6 * 33], s[7 * 33]);
        *(v4u*)(WT + (size_t)map_row(mode, n0 + n) * ldt + k0 + 8 * c) = o; }
    asm volatile("s_waitcnt lgkmcnt(0)" ::: "memory");
}
__device__ __forceinline__ void norm_rows(const float* srcL, const float* srcC, bf16* A, const float* modl, int sidx, int nrows, int gw_, int NGW) {
    const int ft = fresh_tid(); const int lane = ft & 63; const int gw = gw_ + __builtin_amdgcn_readfirstlane(ft >> 6);
    for (int row = gw; row < nrows; row += NGW) {
        const float* xr = row < NLAT ? srcL + (size_t)row * DMODEL : srcC + (size_t)(row - NLAT) * DMODEL;
        const int b = row < NLAT ? (row >> 11) : 32;
        const float* sh = modl + (size_t)b * MODW + sidx * 1024; const float* sc = sh + 1024;
        f32x4 v[4]; float s = 0.f;
#pragma unroll
        for (int j = 0; j < 4; ++j) { v[j] = ((const f32x4*)xr)[lane + 64 * j]; s += (v[j].x * v[j].x + v[j].y * v[j].y) + (v[j].z * v[j].z + v[j].w * v[j].w); }
        const float rstd = 1.0f / sqrtf(wave_sum(s) * (1.0f / DMODEL) + 1e-6f);
        v2u* o8 = (v2u*)(A + (size_t)row * DMODEL) + lane;
#pragma unroll
        for (int j = 0; j < 4; ++j) { const f32x4 shv = ((const f32x4*)sh)[lane + 64 * j], scv = ((const f32x4*)sc)[lane + 64 * j];
            const f32x4 o = v[j] * rstd * (scv + 1.0f) + shv; v2u w; w.x = pk2(o.x, o.y); w.y = pk2(o.z, o.w); o8[64 * j] = w; }
    }
}

__global__ void __launch_bounds__(512, 2) fwd_mega(Args args) {
    extern __shared__ __attribute__((aligned(16))) unsigned char lds[];
    cg::grid_group grid = cg::this_grid();
    LAS unsigned char* L = (LAS unsigned char*)lds;
    const int tid = threadIdx.x, lane = tid & 63, wave = __builtin_amdgcn_readfirstlane(tid >> 6);
    const int G = gridDim.x, bx = blockIdx.x; const int vcu = (G % 8 == 0) ? (bx % 8) * (G / 8) + bx / 8 : bx;
    const int gw = vcu * 8 + wave, NGW = G * 8; const int gtid = bx * 512 + tid, NTHR = G * 512;
    unsigned char* ws = args.ws;
    if (tid < 2) ((volatile LAS unsigned*)(L + XB_LDS_OFF))[tid] = 0u;
    __syncthreads();
    (void)xcd_barrier_post((unsigned*)(ws + WS_BAR), (volatile LAS unsigned*)(L + XB_LDS_OFF));
    const float* x_in = args.in[0]; const float* c_in = args.in[1]; const float* ctx_in = args.in[2]; const float* cctx_in = args.in[3];
    const float* ada_w = args.in[4]; const float* ada_b = args.in[5];
    const float* w_in = args.in[8]; const float* q_gain = args.in[9]; const float* k_gain = args.in[10];
    const float* pool_w = args.in[11]; const float* pool_scale = args.in[12]; const float* fft_w = args.in[13]; const float* w_out = args.in[14];
    const float* final_gain = args.in[17];
    float* ZERO = (float*)(ws + WS_ZERO); unsigned char* LOP = ws + WS_LO;
    float* MOD = (float*)(ws + WS_MOD); float* MODP = (float*)(ws + WS_MODP);
    float* ROPEC = (float*)(ws + WS_ROPE); float* ROPES = ROPEC + 2048 * 32;
    bf16* ACAT = (bf16*)(ws + WS_ACAT); bf16* ACATC = (bf16*)(ws + WS_ACATC);
    bf16* WGU = (bf16*)(ws + WS_WGU); bf16* WDN = (bf16*)(ws + WS_WDN); bf16* WIN = (bf16*)(ws + WS_WIN); bf16* WOUT = (bf16*)(ws + WS_WOUT);
    bf16* AB = (bf16*)(ws + WS_A); bf16* AB2 = (bf16*)(ws + WS_A2); bf16* HID = (bf16*)(ws + WS_HID);
    float* SSB = (float*)(ws + WS_SS); bf16* SH = (bf16*)(ws + WS_SH); float* SWT = (float*)(ws + WS_SWT);
    bf16* QB_ = (bf16*)(ws + WS_Q); bf16* KB_ = (bf16*)(ws + WS_K); bf16* VB_ = (bf16*)(ws + WS_V); bf16* UP = (bf16*)(ws + WS_UP); bf16* VT = (bf16*)(ws + WS_VT); bf16* VTC = (bf16*)(ws + WS_VTC);

#if PROBE == 4
    for (int prep_ = 0; prep_ < 2; ++prep_) {
#else
    {
#endif
#define TRANSPOSE_ITEM(it_) do { int r = (it_); \
        if (r < 8 * I_GU) { const int mi = r / I_GU; r %= I_GU; const int l_ = mi >> 1, f_ = mi & 1; \
            transpose_item(args.in[f_ ? 15 : 6] + (size_t)l_ * 1024 * 5632, 5632, WGU + (size_t)mi * 5632 * 1024, 1024, 1, scr, r / 176, r % 176, lane_); } \
        else if (r < 8 * I_GU + 8 * I_DN) { r -= 8 * I_GU; const int mi = r / I_DN; r %= I_DN; const int l_ = mi >> 1, f_ = mi & 1; \
            transpose_item(args.in[f_ ? 16 : 7] + (size_t)l_ * 2816 * 1024, 1024, WDN + (size_t)mi * 1024 * 2816, 2816, 3, scr, r / 32, r % 32, lane_); } \
        else if (r < 8 * I_GU + 8 * I_DN + 4 * I_IN) { r -= 8 * I_GU + 8 * I_DN; const int l_ = r / I_IN; r %= I_IN; \
            transpose_item(w_in + (size_t)l_ * 1024 * 1280, 1280, WIN + (size_t)l_ * 1536 * 1024, 1024, 2, scr, r / 32, r % 32, lane_); } \
        else { r -= 8 * I_GU + 8 * I_DN + 4 * I_IN; const int l_ = r / I_OUT; r %= I_OUT; \
            transpose_item(w_out + (size_t)l_ * 1024 * 1024, 1024, WOUT + (size_t)l_ * 1024 * 1024, 1024, 3, scr, r / 32, r % 32, lane_); } } while (0)
    {   LAS float* scr = (LAS float*)(L + wave * 16384); const int lane_ = lane;
        for (int k = gw; k < 2 * I_GU + 2 * I_DN + I_IN + I_OUT; k += NGW) {
            const int it = k < 2 * I_GU ? k : k < 2 * I_GU + 2 * I_DN ? 8 * I_GU + (k - 2 * I_GU) : k < 2 * I_GU + 2 * I_DN + I_IN ? 8 * I_GU + 8 * I_DN + (k - 2 * I_GU - 2 * I_DN) : 8 * I_GU + 8 * I_DN + 4 * I_IN + (k - 2 * I_GU - 2 * I_DN - I_IN);
            TRANSPOSE_ITEM(it); }
    }
    __syncthreads();
    LAS float* T2048 = (LAS float*)(L + TAB_OFF); LAS float* T64 = T2048 + 2048;
    for (int i = tid; i < 2048; i += 512) T2048[i] = cospif((float)i * (1.0f / 1024.0f));
    if (tid < 64) T64[tid] = cospif((float)tid * (1.0f / 32.0f));
    __syncthreads();
#define FOLD_CH(idx) do { \
        const int k = idx & 1023; const int hi_ = __builtin_amdgcn_readfirstlane(idx >> 10); const int l = hi_ >> 8, cc = hi_ & 255, g = cc >> 6, cp = cc & 63; \
        const float* src = w_in + ((size_t)l * 1024 + k) * 1280 + 1024 + 64 * g; \
        float ac = 0.f, as = 0.f; \
        _Pragma("unroll 4") \
        for (int c4 = 0; c4 < 16; ++c4) { const f32x4 w = *(const f32x4*)(src + 4 * c4); \
        _Pragma("unroll") \
            for (int e = 0; e < 4; ++e) { const int m = (4 * c4 + e) * cp; ac += w[e] * T64[m & 63]; as += w[e] * T64[(m - 16) & 63]; } } \
        bf16* d = WIN + (size_t)l * 1536 * 1024 + k; \
        d[(size_t)(1024 + cc) * 1024] = (bf16)pg8::f2bf1(ac * 0.125f); d[(size_t)(1280 + cc) * 1024] = (bf16)pg8::f2bf1(as * 0.125f); \
    } while (0)
#define FOLD_POOL(idx) do { \
        const int n = idx & 1023; const int hi_ = __builtin_amdgcn_readfirstlane(idx >> 10); \
        const int l = hi_ >> 5, gc = hi_ & 31, g = gc >> 3, c0 = (gc & 7) * 8; \
        const float* wo = w_out + (size_t)l * 1024 * 1024 + (size_t)(512 + 64 * g) * 1024 + n; \
        const float* ps = pool_scale + l * 256 + 64 * g; const float* pw = pool_w + ((size_t)(l * 4 + g) * 64 + c0) * 64; \
        float a[8]; \
        _Pragma("unroll") \
        for (int i = 0; i < 8; ++i) a[i] = 0.f; \
        for (int d0 = 0; d0 < 64; d0 += 8) { float w[8]; \
        _Pragma("unroll") \
            for (int dd = 0; dd < 8; ++dd) w[dd] = wo[(size_t)(d0 + dd) * 1024]; \
        _Pragma("unroll") \
            for (int dd = 0; dd < 8; ++dd) { const float ww = ps[d0 + dd] * w[dd]; \
        _Pragma("unroll") \
                for (int i = 0; i < 8; ++i) a[i] += pw[i * 64 + d0 + dd] * ww; } } \
        v4u o; o.x = pk2(a[0], a[1]); o.y = pk2(a[2], a[3]); o.z = pk2(a[4], a[5]); o.w = pk2(a[6], a[7]); \
        *(v4u*)(WOUT + (size_t)l * 1024 * 1024 + (size_t)map_row(3, n) * 1024 + 512 + 64 * g + c0) = o; \
    } while (0)
#define FOLD_FFT(idx) do { \
        const int n = idx & 1023; const int hi_ = __builtin_amdgcn_readfirstlane(idx >> 10); \
        const int l = hi_ >> 5, i0 = (hi_ & 31) * 8; \
        const float* wo = w_out + (size_t)l * 1024 * 1024 + (size_t)768 * 1024 + n; \
        const float* fw = fft_w + (size_t)l * 65536 + (size_t)i0 * 256; \
        float a[8]; \
        _Pragma("unroll") \
        for (int i = 0; i < 8; ++i) a[i] = 0.f; \
        for (int j0 = 0; j0 < 256; j0 += 8) { float w[8]; \
        _Pragma("unroll") \
            for (int jj = 0; jj < 8; ++jj) w[jj] = wo[(size_t)(j0 + jj) * 1024]; \
        _Pragma("unroll") \
            for (int i = 0; i < 8; ++i) \
        _Pragma("unroll") \
                for (int jj = 0; jj < 8; ++jj) a[i] += fw[i * 256 + j0 + jj] * w[jj]; } \
        v4u o; o.x = pk2(a[0], a[1]); o.y = pk2(a[2], a[3]); o.z = pk2(a[4], a[5]); o.w = pk2(a[6], a[7]); \
        *(v4u*)(WOUT + (size_t)l * 1024 * 1024 + (size_t)map_row(3, n) * 1024 + 768 + i0) = o; \
    } while (0)
    for (int idx = bx * 512 + fresh_tid(); idx < 262144; idx += NTHR) FOLD_CH(idx);
    for (int idx = bx * 512 + fresh_tid(); idx < 32768; idx += NTHR) FOLD_POOL(idx);
    for (int idx = bx * 512 + fresh_tid(); idx < 32768; idx += NTHR) FOLD_FFT(idx);
    for (int idx = bx * 512 + fresh_tid(); idx < 13 * NROW / 4; idx += NTHR) { ((f32x4*)SSB)[idx] = (f32x4){0.f, 0.f, 0.f, 0.f}; if (idx < 256) ((f32x4*)ZERO)[idx] = (f32x4){0.f, 0.f, 0.f, 0.f}; }
    for (int idx = bx * 512 + fresh_tid(); idx < 65536; idx += NTHR) {
        const int t = idx >> 5, i = idx & 31; const int pos = i < 16 ? (t >> 6) : (t & 63);
        const float inv = powf(10000.0f, -(float)(i & 15) * (1.0f / 16.0f)); const float ang = (float)pos * inv;
        ROPEC[idx] = cosf(ang); ROPES[idx] = sinf(ang);
    }
    for (int idx = bx * 512 + fresh_tid(); idx < 2048 * 512; idx += NTHR) {
        const int kp = idx >> 9, ch = idx & 511; unsigned w[4];
#pragma unroll
        for (int e2 = 0; e2 < 4; ++e2) { unsigned pr[2];
#pragma unroll
            for (int q = 0; q < 2; ++q) { const int np = ch * 8 + e2 * 2 + q; const int m = np < 2048 ? (kp * np) & 2047 : (kp * (np - 2048) + 512) & 2047; pr[q] = pg8::f2bf1(T2048[m]); }
            w[e2] = pr[0] | (pr[1] << 16); }
        v4u o; o.x = w[0]; o.y = w[1]; o.z = w[2]; o.w = w[3];
        *(v4u*)(ACAT + (size_t)kp * 4096 + ch * 8) = o;
    }
    for (int idx = bx * 512 + fresh_tid(); idx < 256 * 64; idx += NTHR) {
        const int kp = idx >> 6, ch = idx & 63; unsigned w[4];
#pragma unroll
        for (int e2 = 0; e2 < 4; ++e2) { unsigned pr[2];
#pragma unroll
            for (int q = 0; q < 2; ++q) { const int np = ch * 8 + e2 * 2 + q; const int m = np < 256 ? (8 * kp * np) & 2047 : (8 * kp * (np - 256) + 512) & 2047; pr[q] = pg8::f2bf1(T2048[m]); }
            w[e2] = pr[0] | (pr[1] << 16); }
        v4u o; o.x = w[0]; o.y = w[1]; o.z = w[2]; o.w = w[3];
        *(v4u*)(ACATC + (size_t)kp * 512 + ch * 8) = o;
    }
    {
        LAS float* sc = (LAS float*)L;
        for (int task = bx; task < 576; task += G) {
            const int ks = task / 72, cb = task % 72;
            __syncthreads();
            for (int e = tid; e < 128 * 33; e += 512) { const int kk = e / 33, b = e % 33; const int k = ks * 128 + kk;
                const float cv = b < 32 ? c_in[b * 1024 + k] : cctx_in[k]; sc[kk * 36 + b] = cv / (1.0f + expf(-cv)); }
            __syncthreads();
            const int j = cb * 512 + tid; const int l = j / MODW, jj = j % MODW;
            const float* wp = ada_w + ((size_t)l * 1024 + ks * 128) * MODW + jj;
            typedef float f32x2v __attribute__((ext_vector_type(2)));
            f32x2v a2[16]; float a32 = 0.f;
#pragma unroll
            for (int b = 0; b < 16; ++b) a2[b] = (f32x2v){0.f, 0.f};
            for (int k0 = 0; k0 < 128; k0 += 8) { float wv[8];
#pragma unroll
                for (int kq = 0; kq < 8; ++kq) wv[kq] = wp[(size_t)(k0 + kq) * MODW];
#pragma unroll
                for (int kq = 0; kq < 8; ++kq) { const f32x2v w2 = {wv[kq], wv[kq]}; const int kk = k0 + kq;
#pragma unroll
                    for (int q = 0; q < 8; ++q) { const f32x4 s = *(const LAS f32x4*)(sc + kk * 36 + 4 * q); a2[2 * q] += w2 * s.xy; a2[2 * q + 1] += w2 * s.zw; }
                    a32 += wv[kq] * sc[kk * 36 + 32]; } }
            float a[33];
#pragma unroll
            for (int b = 0; b < 16; ++b) { a[2 * b] = a2[b].x; a[2 * b + 1] = a2[b].y; }
            a[32] = a32;
#pragma unroll
            for (int b = 0; b < 33; ++b) MODP[((size_t)ks * 33 + b) * 36864 + j] = a[b];
        }
    }
    grid.sync();

    for (int idx = bx * 512 + fresh_tid(); idx < 33 * 36864; idx += NTHR) {
        const int b = idx / 36864, j = idx % 36864, l = j / MODW, jj = j % MODW;
        float s = ada_b[j];
#pragma unroll
        for (int ks = 0; ks < 8; ++ks) s += MODP[((size_t)ks * 33 + b) * 36864 + j];
        MOD[((size_t)l * 33 + b) * MODW + jj] = s;
        const int which = jj >> 10;
        if (which == 0 || which == 3 || which == 6) SH[((size_t)(l * 3 + which / 3) * 256 + b) * 1024 + (jj & 1023)] = (bf16)pg8::f2bf1(s);
    }
    GSYNC();
    {   pg8::Gemm g{SH, WGU, 12 * 256, 51200, 1024}; pg8::SwOrder S{G, bx, 0}; pg8::EpiSW E{SWT};
        pg8::gemm_phase<pg8::EpiSW, pg8::SwOrder, true, true>(L, g, S, E); }
    {   const int ft = fresh_tid(); const int ln = ft & 63;
        for (int row = vcu * 8 + __builtin_amdgcn_readfirstlane(ft >> 6); row < NROW; row += NGW) {
            const float* xr = row < NLAT ? x_in + (size_t)row * DMODEL : ctx_in + (size_t)(row - NLAT) * DMODEL;
            const int b = row < NLAT ? (row >> 11) : 32; const float* sc = MOD + (size_t)b * MODW + 1024;
            float s = 0.f; const int pmr = row >> 8, rlc = row & 255;
            v2u* o8 = (v2u*)(AB + ((size_t)(pmr * 16 + (ln >> 4)) * 256 + rlc) * 64 + 4 * (ln & 15)); unsigned short* l8 = (unsigned short*)(LOP + ((size_t)(pmr * 4) * 256 + rlc) * 128 + 2 * ln);
#pragma unroll
            for (int j = 0; j < 4; ++j) { const f32x4 v = ((const f32x4*)xr)[ln + 64 * j]; s += (v.x * v.x + v.y * v.y) + (v.z * v.z + v.w * v.w);
                const f32x4 o = v * pg8::clamp_m(((const f32x4*)sc)[ln + 64 * j]); v2u w; w.x = pk2(o.x, o.y); w.y = pk2(o.z, o.w); o8[(size_t)j * 4 * 256 * 64 / 4] = w;
                const unsigned b0 = w.x << 16, b1 = w.x & 0xffff0000u, b2 = w.y << 16, b3 = w.y & 0xffff0000u;
                const unsigned w8 = pg8::lo4_enc(o.x, b0) | (pg8::lo4_enc(o.y, b1) << 4) | (pg8::lo4_enc(o.z, b2) << 8) | (pg8::lo4_enc(o.w, b3) << 12);
                l8[(size_t)j * 256 * 128 / 2] = (unsigned short)w8; }
            s = wave_sum(s); if (ln == 0) SSB[row] = s;
        }
    }
    GSYNC();

    }
    for (int l = 0; l < 4; ++l) {
        const bool last = (l == 3);
        const float* modl = MOD + (size_t)l * 33 * MODW;
        for (int f = 0; f < 2; ++f) {
            const bool first = (l == 0 && f == 0);
            const int nrows = (last && f == 1) ? NLAT : NROW;
            {   pg8::Gemm g{AB, WGU + (size_t)(l * 2 + f) * 5632 * 1024, nrows, 5632, 1024, 1}; pg8::StaticOrder S; S.init(nrows, 5632, G, bx);
                pg8::EpiGU E{HID, SSB + (size_t)(l * 3 + 2 * f) * NROW, SWT + (size_t)((l * 2 + f) * 22) * 33 * 256};
                { int b2 = blockIdx.x; asm volatile("" : "+s"(b2)); stagger(nrows == NROW ? (b2 < 96 ? 0 : b2 < 192 ? STG_GU : b2 < 224 ? STG_GU / 2 : STG_GU * 3 / 2) : (b2 < 128 ? 0 : STG_GU)); }
                pg8::gemm_phase<pg8::EpiGU, pg8::StaticOrder, true, true>(L, g, S, E);
#if PROBE == 1
                pg8::gemm_phase<pg8::EpiGU, pg8::StaticOrder, true, true>(L, g, S, E);
#endif
            }
            GSYNC();
            {   pg8::Gemm g{HID, WDN + (size_t)(l * 2 + f) * 1024 * 2816, nrows, 1024, 2816, 1}; pg8::StaticOrder S; S.init(nrows, 1024, G, bx);
                const float* dsc = modl + (f == 0 ? 1 : 7) * 1024;
                const float* nsc = f == 0 ? modl + 4 * 1024 : (last ? ZERO : modl + (size_t)33 * MODW + 1 * 1024);
                float* ssn = f == 0 ? SSB + (size_t)(l * 3 + 1) * NROW : SSB + (size_t)((l + 1) * 3) * NROW;
                pg8::EpiRes E{AB, LOP, modl + (f == 0 ? 2 : 8) * 1024, dsc, nsc, ssn, (LAS float*)(L + TAB_OFF), 0.5f, (f == 1 && last) ? 0 : MODW};
                { int b2 = blockIdx.x; asm volatile("" : "+s"(b2)); stagger(b2 < 128 ? 0 : STG_DN); }
                pg8::gemm_phase<pg8::EpiRes, pg8::StaticOrder, true, true>(L, g, S, E);
#if PROBE == 5
                pg8::EpiDummy ED{(float*)(ws + WS_SWT)};
                pg8::gemm_phase<pg8::EpiDummy, pg8::StaticOrder, true, true>(L, g, S, ED);
#endif
            }
            if (!last && bx >= (G >> 1)) {
                const int hb = G >> 1, nW = G - hb;
                const int ftt = fresh_tid(); const int lane_ = ftt & 63; const int wv = __builtin_amdgcn_readfirstlane(ftt >> 6);
                LAS float* scr = (LAS float*)(L + wv * 16384); const int Ln = l + 1;
                if (f == 0) { for (int k = (bx - hb) * 8 + wv; k < 2 * I_GU + I_IN; k += nW * 8) { const int it = k < 2 * I_GU ? Ln * 2 * I_GU + k : 8 * I_GU + 8 * I_DN + Ln * I_IN + (k - 2 * I_GU); TRANSPOSE_ITEM(it); }
                    LAS float* T64 = (LAS float*)(L + TAB_OFF) + 2048; __syncthreads(); if (ftt < 64) T64[ftt] = cospif((float)ftt * (1.0f / 32.0f)); __syncthreads();
                    for (int idx = Ln * 262144 + (bx - hb) * 512 + ftt; idx < (Ln + 1) * 262144; idx += nW * 512) FOLD_CH(idx); }
                else { for (int idx = Ln * 32768 + (bx - hb) * 512 + ftt; idx < (Ln + 1) * 32768; idx += nW * 512) { FOLD_POOL(idx); FOLD_FFT(idx); }
                    for (int k = (bx - hb) * 8 + wv; k < 2 * I_DN + I_OUT; k += nW * 8) { const int it = k < 2 * I_DN ? 8 * I_GU + Ln * 2 * I_DN + k : 8 * I_GU + 8 * I_DN + 4 * I_IN + Ln * I_OUT + (k - 2 * I_DN); TRANSPOSE_ITEM(it); }
                    __syncthreads();
                    pg8::Gemm g2{SH, WGU, 12 * 256, 51200, 1024}; pg8::SwOrder S2{nW, bx - hb, Ln}; pg8::EpiSW E2{SWT};
                    pg8::gemm_phase<pg8::EpiSW, pg8::SwOrder, true, true>(L, g2, S2, E2); }
            }
            GSYNC();
            if (f == 0) {
                {   pg8::Gemm g{AB, WIN + (size_t)l * 1536 * 1024, NROW, 1536, 1024, 1}; pg8::StaticOrder S; S.init(NROW, 1536, G, bx);
                    pg8::EpiIN E{QB_, KB_, VB_, UP, VT, VTC, q_gain + l * 64, k_gain + l * 64, ROPEC, ROPES, SSB + (size_t)(l * 3 + 1) * NROW, SWT + (size_t)(176 + l * 6) * 33 * 256};
                    pg8::gemm_phase<pg8::EpiIN, pg8::StaticOrder, true, true>(L, g, S, E);
#if PROBE == 3
                    pg8::gemm_phase<pg8::EpiIN, pg8::StaticOrder, true, true>(L, g, S, E);
#endif
                }
                GSYNC();
#if PROBE == 2
                for (int rep_ = 0; rep_ < 2; ++rep_) {
#else
                {
#endif
                for (int v = vcu; v < 256; v += G) {
                    const int p = v >> 2, s = v & 3, b = p >> 1, kvh = p & 1, h = 4 * kvh + s;
                    const attn_body::bf16* Kh = (const attn_body::bf16*)KB_ + (size_t)b * KVROWS * 128 + kvh * 64;
                    const attn_body::bf16* Vh = (const attn_body::bf16*)VB_ + (size_t)b * KVROWS * 128 + kvh * 64;
                    for (int qb = 0; qb < 8; ++qb) { const size_t r0 = (size_t)b * 2048 + qb * 256;
                        attn_body::attn_unit<8>((const attn_body::bf16*)QB_ + r0 * 512 + h * 64, Kh, Vh, (attn_body::bf16*)AB2 + r0 * 1024 + h * 64, 36, (char*)lds); }
                    if (!last) { const int cb = v >> 3, ch = v & 7; const size_t r0 = (size_t)NLAT + cb * 256;
                        const attn_body::bf16* Kc = (const attn_body::bf16*)KB_ + ((size_t)cb * KVROWS + 2048) * 128 + (ch >> 2) * 64;
                        const attn_body::bf16* Vc = (const attn_body::bf16*)VB_ + ((size_t)cb * KVROWS + 2048) * 128 + (ch >> 2) * 64;
                        attn_body::attn_unit<8>((const attn_body::bf16*)QB_ + r0 * 512 + ch * 64, Kc, Vc, (attn_body::bf16*)AB2 + r0 * 1024 + ch * 64, 4, (char*)lds); }
                }
                {   const int prow = last ? NLAT : NROW;
                    const int pskip = (!last && G > 64) ? 32 : 0;
                    for (int idx = (bx < pskip ? prow * 32 : (bx - pskip) * 512 + fresh_tid()); idx < prow * 32; idx += (G - pskip) * 512) {
                        const int p8 = prow * 8; const int g = __builtin_amdgcn_readfirstlane((idx >= p8) + (idx >= 2 * p8) + (idx >= 3 * p8)); const int rem = idx - g * p8; const int row = rem >> 3, c0 = g * 64 + (rem & 7) * 8, w2 = 1 << g, w = 2 << g;
                        int Ls, t; if (row < NLAT) { Ls = 2048; t = row & 2047; } else { Ls = 256; t = row & 255; }
                        const int base = row - t; const int lo = max(t - w2, 0), hi = min(t + w - w2, Ls);
                        float s[8];
#pragma unroll
                        for (int i = 0; i < 8; ++i) s[i] = 0.f;
                        v4u wq[16]; float wt[16];
#pragma unroll
                        for (int j = 0; j < 16; ++j) { wt[j] = 0.f; wq[j] = (v4u){0u, 0u, 0u, 0u}; if (j < w) { const int pos = t - w2 + j; const bool ok = pos >= 0 && pos < Ls; wt[j] = ok ? 1.0f : 0.0f; wq[j] = *(const v4u*)(UP + (size_t)(base + (ok ? pos : t)) * 256 + c0); } }
#pragma unroll
                        for (int j = 0; j < 16; ++j) if (j < w) { const v4u q = wq[j]; const float wj = wt[j];
                            s[0] += wj * __uint_as_float(q.x << 16); s[1] += wj * __uint_as_float(q.x & 0xffff0000u); s[2] += wj * __uint_as_float(q.y << 16); s[3] += wj * __uint_as_float(q.y & 0xffff0000u);
                            s[4] += wj * __uint_as_float(q.z << 16); s[5] += wj * __uint_as_float(q.z & 0xffff0000u); s[6] += wj * __uint_as_float(q.w << 16); s[7] += wj * __uint_as_float(q.w & 0xffff0000u); }
                        const v4u q = *(const v4u*)(UP + (size_t)row * 256 + c0); const float ic = 1.0f / (float)(hi - lo);
                        v4u o;
                        o.x = pk2(s[0] * ic - __uint_as_float(q.x << 16), s[1] * ic - __uint_as_float(q.x & 0xffff0000u));
                        o.y = pk2(s[2] * ic - __uint_as_float(q.y << 16), s[3] * ic - __uint_as_float(q.y & 0xffff0000u));
                        o.z = pk2(s[4] * ic - __uint_as_float(q.z << 16), s[5] * ic - __uint_as_float(q.z & 0xffff0000u));
                        o.w = pk2(s[6] * ic - __uint_as_float(q.w << 16), s[7] * ic - __uint_as_float(q.w & 0xffff0000u));
                        *(v4u*)(AB2 + (size_t)row * 1024 + 512 + c0) = o;
                    }
                }
                {   pg8::Gemm g{ACAT, VT, 2048, 8192, 4096}; pg8::StaticOrder S; S.init(2048, 8192, G, bx);
                    pg8::EpiDFT E{AB2, 0, 2048, 0.022097086912079608f};
                    pg8::gemm_phase<pg8::EpiDFT, pg8::StaticOrder, true, true>(L, g, S, E); }
                if (!last) { pg8::Gemm g{ACATC, VTC, 256, 8192, 512}; pg8::StaticOrder S; S.init(256, 8192, G, bx);
                    pg8::EpiDFT E{AB2, NLAT, 256, 0.0625f};
                    pg8::gemm_phase<pg8::EpiDFT, pg8::StaticOrder, true, true>(L, g, S, E); }
                }
                GSYNC();
                {   const int mrows = last ? NLAT : NROW;
                    pg8::Gemm g{AB2, WOUT + (size_t)l * 1024 * 1024, mrows, 1024, 1024}; pg8::StaticOrder S; S.init(mrows, 1024, G, bx);
                    pg8::EpiRes E{AB, LOP, modl + 5 * 1024, modl + 4 * 1024, modl + 7 * 1024, SSB + (size_t)(l * 3 + 2) * NROW, (LAS float*)(L + TAB_OFF), 1.0f, MODW};
                    { int b2 = blockIdx.x; asm volatile("" : "+s"(b2)); stagger(b2 < 128 ? 0 : STG_OUT); }
                    pg8::gemm_phase<pg8::EpiRes, pg8::StaticOrder, true, true>(L, g, S, E); }
                GSYNC();
            }
        }
    }
    const int ftf = fresh_tid(); const int lanef = ftf & 63;
    for (int row = vcu * 8 + __builtin_amdgcn_readfirstlane(ftf >> 6); row < NLAT; row += NGW) {
        const int pmr = row >> 8, rlc = row & 255;
        const v2u* hp = (const v2u*)(AB + ((size_t)(pmr * 16 + (lanef >> 4)) * 256 + rlc) * 64 + 4 * (lanef & 15)); const unsigned short* lp = (const unsigned short*)(LOP + ((size_t)(pmr * 4) * 256 + rlc) * 128 + 2 * lanef);
        f32x4 v[4]; float s = 0.f;
#pragma unroll
        for (int j = 0; j < 4; ++j) { const v2u h = hp[(size_t)j * 4 * 256 * 64 / 4]; const unsigned q = lp[(size_t)j * 256 * 128 / 2];
            const unsigned b0 = h.x << 16, b1 = h.x & 0xffff0000u, b2 = h.y << 16, b3 = h.y & 0xffff0000u;
            v[j].x = pg8::lo4_dec(b0, q & 0xfu); v[j].y = pg8::lo4_dec(b1, (q >> 4) & 0xfu); v[j].z = pg8::lo4_dec(b2, (q >> 8) & 0xfu); v[j].w = pg8::lo4_dec(b3, (q >> 12) & 0xfu);
            s += (v[j].x * v[j].x + v[j].y * v[j].y) + (v[j].z * v[j].z + v[j].w * v[j].w); }
        const float rstd = 1.0f / sqrtf(wave_sum(s) * (1.0f / DMODEL) + 1e-6f);
        f32x4* xr = (f32x4*)(args.out + (size_t)row * DMODEL);
#pragma unroll
        for (int j = 0; j < 4; ++j) { const f32x4 gv = ((const f32x4*)final_gain)[lanef + 64 * j]; xr[lanef + 64 * j] = v[j] * rstd * gv; }
    }
}

extern "C" void kernel_launch(void* const* d_in, const int* in_sizes, int n_in, void* d_out, int out_size, void* d_ws, size_t ws_size, hipStream_t stream) {
    static int grid = 0;
    if (grid == 0) {
        if (n_in != 18 || out_size != NLAT * DMODEL || ws_size < WS_END) { fprintf(stderr, "kernel_launch: unexpected shapes (n_in %d, out %d, ws %zu)\n", n_in, out_size, ws_size); grid = -1; return; }
        int dev = 0, cus = 0, per_cu = 0;
        hipGetDevice(&dev); hipDeviceGetAttribute(&cus, hipDeviceAttributeMultiprocessorCount, dev);
        hipFuncSetAttribute((const void*)fwd_mega, hipFuncAttributeMaxDynamicSharedMemorySize, LDS_BYTES);
        if (hipOccupancyMaxActiveBlocksPerMultiprocessor(&per_cu, (const void*)fwd_mega, 512, LDS_BYTES) != hipSuccess || per_cu < 1) { fprintf(stderr, "kernel_launch: occupancy query says %d\n", per_cu); per_cu = 1; }
        (void)hipGetLastError();
        grid = cus * (per_cu > 1 ? 1 : per_cu);
        if (grid <= 0) grid = 256;
    }
    if (grid < 0) return;
    if (hipMemsetAsync((char*)d_ws + WS_BAR, 0, 16384, stream) != hipSuccess) { fprintf(stderr, "kernel_launch: memset of the barrier words failed\n"); return; }
    Args a{};
    for (int i = 0; i < 18; ++i) a.in[i] = (const float*)d_in[i];
    a.out = (float*)d_out; a.ws = (unsigned char*)d_ws;
    void* params[] = {&a};
    hipError_t e = hipLaunchCooperativeKernel((const void*)fwd_mega, dim3(grid), dim3(512), params, LDS_BYTES, stream);
    if (e != hipSuccess) fprintf(stderr, "cooperative launch failed: %s (grid %d)\n", hipGetErrorString(e), grid);
}
```

```cpp
#include <hip/hip_runtime.h>
#include <hip/hip_cooperative_groups.h>
#include <hip/hip_bf16.h>
#include <cstdio>
#include <cstdint>
#include <cmath>
namespace cg = cooperative_groups;
constexpr int NLAT = 65536, NCTX = 8192, NROW = NLAT + NCTX, DMODEL = 1024, DFF = 2816, MODW = 9216, KVROWS = 2304;
constexpr float QC2 = 0.125f * 1.4426950408889634f;
__device__ __forceinline__ int fresh_tid() { int t = threadIdx.x; asm volatile("" : "+v"(t)); return t; }
namespace pg8 {
#define PG8_LAS __attribute__((address_space(3)))
typedef unsigned short bf16_t;
typedef short bf16x8 __attribute__((ext_vector_type(8)));
typedef float f32x4 __attribute__((ext_vector_type(4)));
typedef unsigned u32x4 __attribute__((ext_vector_type(4)));
constexpr int BM = 256, BK = 64, HALF = 128, HTB = HALF * BK * 2  , STAGE_BYTES = 8 * HTB, NXCD = 8, WGM = 8;

__host__ __device__ __forceinline__ int lds_byte(int r, int c) { const int st = (r >> 4) * 2 + (c >> 5), rr = r & 15, cc = c & 31, ob = rr * 64 + cc * 2; return st * 1024 + (ob ^ (((ob >> 9) & 1) << 5)); }
__host__ __device__ __forceinline__ void stage_rc(int b, int& R, int& C) { const int st = b / 1024, sb = b % 1024, swz = sb ^ (((sb >> 9) & 1) << 5); R = (st >> 1) * 16 + swz / 64; C = (st & 1) * 32 + (swz % 64) / 2; }
__host__ __device__ __forceinline__ int perm32(int rho) { const int n = rho >> 4, i = rho & 15; return 8 * (i >> 2) + 4 * n + (i & 3); }

struct Unit { int pm, pn; };
struct Gemm { const bf16_t* A; const bf16_t* Bt; int M, N, K; int ablk; };

struct StaticOrder {
    int nM, nN, nwg, G, c;
    __host__ __device__ void init(int M, int N, int G_, int c_) { nM = M / BM; nN = N / BM; nwg = nM * nN; G = G_; c = c_; }
    __host__ __device__ bool next(int i, Unit& u) const {
        const long L = (long)i * G + c; if (L >= nwg) return false;
        int wgid = (int)L; { const int q = nwg / NXCD, r = nwg % NXCD, xcd = wgid % NXCD, off = wgid / NXCD; wgid = (xcd < r ? xcd * (q + 1) : r * (q + 1) + (xcd - r) * q) + off; }
        const int nig = WGM * nN, gid = wgid / nig, fm = gid * WGM, gsz = (nM - fm) < WGM ? (nM - fm) : WGM;
        u.pm = fm + ((wgid % nig) % gsz); u.pn = (wgid % nig) / gsz; return true;
    }
    __device__ __forceinline__ void a_ready(const Unit&) const {}
    __device__ __forceinline__ void done(const Unit&) const {}
};

__device__ __forceinline__ unsigned cvt_pk_bf16(float lo, float hi) { unsigned r; asm volatile("v_cvt_pk_bf16_f32 %0, %1, %2" : "=v"(r) : "v"(lo), "v"(hi)); return r; }
typedef float f32x2 __attribute__((ext_vector_type(2)));
__device__ __forceinline__ unsigned f2bf1(float f) { unsigned u = __builtin_bit_cast(unsigned, f); return (u + 0x7fffu + ((u >> 16) & 1u)) >> 16; }
__device__ __forceinline__ float silu_f(float g) { return g * __builtin_amdgcn_rcpf(1.0f + __expf(-g)); }
struct EpiGU {
    static constexpr bool PERM = true, AFTER_DRAIN = false;
    bf16_t* H; const float* SS; const float* SWT;
    __device__ __forceinline__ void operator()(const f32x4 (&acc)[2][2][4][2], const Unit& u, int wr, int wc, int fr, int fq) const {
        asm volatile("" : "+v"(fr), "+v"(fq));
        const int row0 = u.pm * BM + wr * 64 + fr, col0 = u.pn * 128 + wc * 32 + 8 * fq;
        const int b = u.pm < 256 ? (u.pm >> 3) : 32;
        const float* swp = SWT + ((size_t)u.pn * 33 + b) * 256 + wc * 32 + 8 * fq;
        const f32x4 sg0 = *(const f32x4*)(swp), sg1 = *(const f32x4*)(swp + 4), su0 = *(const f32x4*)(swp + 128), su1 = *(const f32x4*)(swp + 132);
        float ssv[2][4];
#pragma unroll
        for (int ai = 0; ai < 2; ++ai)
#pragma unroll
            for (int m = 0; m < 4; ++m) ssv[ai][m] = SS[row0 + ai * HALF + m * 16];
#pragma unroll
        for (int ai = 0; ai < 2; ++ai)
#pragma unroll
            for (int m = 0; m < 4; ++m) {
                const float rs = __builtin_amdgcn_rsqf(ssv[ai][m] * (1.0f / 1024.0f) + 1e-6f);
                bf16_t* p = H + ((size_t)(u.pm * 44 + u.pn * 2 + (wc >> 1)) * 256 + (wr * 64 + fr + ai * HALF + m * 16)) * 64 + (wc & 1) * 32 + 8 * fq;
                const f32x2 rs2 = {rs, rs}; u32x4 w;
#define SILU2(G, U, SG, SU) ({ const f32x2 g_ = (G) * rs2 + (SG), u_ = (U) * rs2 + (SU); const f32x2 t_ = g_ * (-1.4426950408889634f); f32x2 d_; d_.x = __builtin_amdgcn_exp2f(t_.x); d_.y = __builtin_amdgcn_exp2f(t_.y); d_ = d_ + 1.0f; \
                    f32x2 r_; r_.x = __builtin_amdgcn_rcpf(d_.x); r_.y = __builtin_amdgcn_rcpf(d_.y); const f32x2 h_ = (g_ * u_) * r_; cvt_pk_bf16(h_.x, h_.y); })
                w.x = SILU2(acc[ai][0][m][0].xy, acc[ai][1][m][0].xy, sg0.xy, su0.xy); w.y = SILU2(acc[ai][0][m][0].zw, acc[ai][1][m][0].zw, sg0.zw, su0.zw);
                w.z = SILU2(acc[ai][0][m][1].xy, acc[ai][1][m][1].xy, sg1.xy, su1.xy); w.w = SILU2(acc[ai][0][m][1].zw, acc[ai][1][m][1].zw, sg1.zw, su1.zw);
#undef SILU2
                __builtin_nontemporal_store(w, (u32x4*)p);
            }
    }
};
__device__ __forceinline__ f32x4 clamp_m(f32x4 s) { f32x4 m = s + 1.0f;
#pragma unroll
    for (int e = 0; e < 4; ++e) m[e] = __builtin_fabsf(m[e]) < 1e-6f ? __builtin_copysignf(1e-6f, m[e]) : m[e];
    return m; }
typedef unsigned u32x2 __attribute__((ext_vector_type(2)));
__device__ __forceinline__ unsigned lo2_enc(float y, unsigned hb  ) { return ((__float_as_uint(y) - (hb + 0xffff8000u)) >> 14) & 0x3u; }
__device__ __forceinline__ float lo2_dec(unsigned hb  , unsigned f2) { return __uint_as_float((hb | (f2 << 14)) + 0xffffa000u); }
#define LO2_GET(lw_, p_) ((((p_) >= 7) ? ((lw_) >> (2 * (p_) - 14)) : ((lw_) << (14 - 2 * (p_)))) & 0xc000u)
#define LO2_PUT(t_, p_) ((((p_) <= 7) ? ((t_) >> (14 - 2 * (p_))) : ((t_) << (2 * (p_) - 14))) & (0x3u << (2 * (p_))))
struct EpiRes {
    static constexpr bool PERM = true, AFTER_DRAIN = false;
    bf16_t* HI; unsigned char* LO; const float* gate; const float* dsc; const float* nsc; float* SSn; PG8_LAS float* cst; float gs; int nstride;
    __device__ __forceinline__ void operator()(const f32x4 (&acc)[2][2][4][2], const Unit& u, int wr, int wc, int fr, int fq) const {
        asm volatile("" : "+v"(fr), "+v"(fq));
        const int pm = u.pm; const int b = pm < 256 ? (pm >> 3) : 32;
        const int rl = pm * BM + wr * 64 + fr, col0 = u.pn * BM + wc * 64 + 16 * fq;
        f32x4 gv[2][2], mev[2][2], rdv[2][2];
#pragma unroll
        for (int bj = 0; bj < 2; ++bj)
#pragma unroll
            for (int n = 0; n < 2; ++n) { gv[bj][n] = *(const f32x4*)(gate + (size_t)b * MODW + col0 + bj * 8 + n * 4) * gs;
                mev[bj][n] = clamp_m(*(const f32x4*)(nsc + (size_t)b * nstride + col0 + bj * 8 + n * 4));
                const f32x4 md = clamp_m(*(const f32x4*)(dsc + (size_t)b * MODW + col0 + bj * 8 + n * 4));
#pragma unroll
                for (int e = 0; e < 4; ++e) rdv[bj][n][e] = __builtin_amdgcn_rcpf(md[e]); }
        constexpr int PF = 1, NB = PF + 1;
        u32x4 RH[NB][2]; unsigned RL[NB];
        const int rloc0 = wr * 64 + fr; const size_t hib = ((size_t)(pm * 16 + u.pn * 4 + wc) * 256) * 64 + 16 * fq, lob = ((size_t)(pm * 4 + u.pn) * 256) * 64 + wc * 16 + 4 * fq;
#define HI_OFF(rloc_, bj_) (hib + (size_t)(rloc_) * 64 + (bj_) * 8)
#define LO_OFF(rloc_) (lob + (size_t)(rloc_) * 64)
#define RES_LOAD(slot, j_) do { const int rloc_ = rloc0 + ((j_) >> 2) * HALF + ((j_) & 3) * 16; \
            _Pragma("unroll") for (int bj = 0; bj < 2; ++bj) RH[slot][bj] = *(const u32x4*)(HI + HI_OFF(rloc_, bj)); RL[slot] = *(const unsigned*)(LO + LO_OFF(rloc_)); } while (0)
#pragma unroll
        for (int j = 0; j < PF; ++j) RES_LOAD(j % NB, j);
#pragma unroll
        for (int j = 0; j < 8; ++j) {
            if (j + PF < 8) RES_LOAD((j + PF) % NB, j + PF);
            asm volatile("" ::: "memory");
            const int ai = j >> 2, m = j & 3; const int r = rl + ai * HALF + m * 16; const int rloc = rloc0 + ai * HALF + m * 16;
            f32x2 ss2 = {0.f, 0.f}; unsigned wl = 0u;
#pragma unroll
            for (int bj = 0; bj < 2; ++bj) { u32x4 wh;
#pragma unroll
                for (int n = 0; n < 2; ++n) { const f32x4 me_ = mev[bj][n], rd_ = rdv[bj][n], gq = gv[bj][n], aq = acc[ai][bj][m][n];
                    const unsigned hw0 = RH[j % NB][bj][2 * n], hw1 = RH[j % NB][bj][2 * n + 1], lw = RL[j % NB];
                    f32x2 y01, y23;
                    y01.x = __uint_as_float(((hw0 << 16) | LO2_GET(lw, 8 * bj + 4 * n + 0)) + 0xffffa000u); y01.y = __uint_as_float(((hw0 & 0xffff0000u) | LO2_GET(lw, 8 * bj + 4 * n + 1)) + 0xffffa000u);
                    y23.x = __uint_as_float(((hw1 << 16) | LO2_GET(lw, 8 * bj + 4 * n + 2)) + 0xffffa000u); y23.y = __uint_as_float(((hw1 & 0xffff0000u) | LO2_GET(lw, 8 * bj + 4 * n + 3)) + 0xffffa000u);
                    const f32x2 o01 = y01 * rd_.xy + gq.xy * aq.xy, o23 = y23 * rd_.zw + gq.zw * aq.zw;
                    ss2 += o01 * o01; ss2 += o23 * o23;
                    y01 = o01 * me_.xy; y23 = o23 * me_.zw;
                    const unsigned h0 = cvt_pk_bf16(y01.x, y01.y), h1 = cvt_pk_bf16(y23.x, y23.y);
                    const unsigned t0 = __float_as_uint(y01.x) - ((h0 << 16) + 0xffff8000u), t1 = __float_as_uint(y01.y) - ((h0 & 0xffff0000u) + 0xffff8000u);
                    const unsigned t2 = __float_as_uint(y23.x) - ((h1 << 16) + 0xffff8000u), t3 = __float_as_uint(y23.y) - ((h1 & 0xffff0000u) + 0xffff8000u);
                    wh[2 * n] = h0; wh[2 * n + 1] = h1;
                    wl |= LO2_PUT(t0, 8 * bj + 4 * n + 0) | LO2_PUT(t1, 8 * bj + 4 * n + 1) | LO2_PUT(t2, 8 * bj + 4 * n + 2) | LO2_PUT(t3, 8 * bj + 4 * n + 3); }
                *(u32x4*)(HI + HI_OFF(rloc, bj)) = wh; }
            *(unsigned*)(LO + LO_OFF(rloc)) = wl;
            float ss = ss2.x + ss2.y;
            { ss += __shfl_xor(ss, 16); ss += __shfl_xor(ss, 32); if (fq == 0) unsafeAtomicAdd(SSn + r, ss); }
            asm volatile("" ::: "memory");
        }
#undef RES_LOAD
#undef HI_OFF
#undef LO_OFF
    }
};
struct EpiSW {
    static constexpr bool PERM = true, AFTER_DRAIN = false;
    float* SWT;
    __device__ __forceinline__ void operator()(const f32x4 (&acc)[2][2][4][2], const Unit& u, int wr, int wc, int fr, int fq) const {
        asm volatile("" : "+v"(fr), "+v"(fq));
        if (wr != 0) return;
#pragma unroll
        for (int m = 0; m < 3; ++m) { const int row = m * 16 + fr;
            if (row < 33) { float* p = SWT + ((size_t)u.pn * 33 + row) * 256 + wc * 32 + 8 * fq;
#pragma unroll
                for (int bj = 0; bj < 2; ++bj)
#pragma unroll
                    for (int n = 0; n < 2; ++n) *(f32x4*)(p + bj * HALF + 4 * n) = acc[0][bj][m][n]; } }
    }
};
struct SwOrder {
    int G, c, L;
    __device__ bool next(int i, Unit& u) const { const int j = i * G + c; if (c < 0 || j >= 50) return false; const int pn = j < 44 ? L * 44 + j : 176 + L * 6 + (j - 44); u.pn = pn;
        if (pn < 176) { const int mi = pn / 22; u.pm = (mi >> 1) * 3 + 2 * (mi & 1); } else u.pm = ((pn - 176) / 6) * 3 + 1; return true; }
    __device__ __forceinline__ void a_ready(const Unit&) const {}
    __device__ __forceinline__ void done(const Unit&) const {}
};
struct EpiIN {
    static constexpr bool PERM = true, AFTER_DRAIN = false;
    bf16_t *Q, *Kb, *Vb, *UP, *VT, *VTC; const float *qg, *kg, *ropeC, *ropeS; const float* SS; const float* SWT;
    __device__ __forceinline__ void operator()(const f32x4 (&acc)[2][2][4][2], const Unit& u, int wr, int wc, int fr, int fq) const {
        asm volatile("" : "+v"(fr), "+v"(fq));
        const int pn = u.pn, pm = u.pm; const bool lat = pm < 256;
        const int rbase = pm * BM + wr * 64 + fr;
        f32x4 sw[2][2]; float rsv[2][4];
        { const int b = lat ? (pm >> 3) : 32; const float* swp = SWT + ((size_t)pn * 33 + b) * 256 + wc * 32 + 8 * fq;
#pragma unroll
          for (int bj = 0; bj < 2; ++bj)
#pragma unroll
            for (int n = 0; n < 2; ++n) sw[bj][n] = *(const f32x4*)(swp + bj * HALF + 4 * n);
#pragma unroll
          for (int ai = 0; ai < 2; ++ai)
#pragma unroll
            for (int m = 0; m < 4; ++m) rsv[ai][m] = __builtin_amdgcn_rsqf(SS[rbase + ai * HALF + m * 16] * (1.0f / 1024.0f) + 1e-6f); }
#define ZV(ai, bj, m, n) (acc[ai][bj][m][n] * rsv[ai][m] + sw[bj][n])
        if (pn <= 2) {
            if (pn == 2 && wc >= 2) {
#pragma unroll
                for (int ai = 0; ai < 2; ++ai)
#pragma unroll
                    for (int m = 0; m < 4; ++m) { const int row = rbase + ai * HALF + m * 16;
                        const int kvrow = lat ? (row >> 11) * KVROWS + (row & 2047) : ((row - NLAT) >> 8) * KVROWS + 2048 + (row & 255);
                        bf16_t* p = Vb + (size_t)kvrow * 128 + (wc - 2) * 64 + 8 * fq;
#pragma unroll
                        for (int bj = 0; bj < 2; ++bj) { const f32x4 a = ZV(ai, bj, m, 0), c = ZV(ai, bj, m, 1); u32x4 w; w.x = cvt_pk_bf16(a[0], a[1]); w.y = cvt_pk_bf16(a[2], a[3]); w.z = cvt_pk_bf16(c[0], c[1]); w.w = cvt_pk_bf16(c[2], c[3]); *(u32x4*)(p + 32 * bj) = w; } }
            } else {
                const bool isq = pn < 2; const float* gp = isq ? qg : kg; const float osc = isq ? QC2 : 1.0f;
                f32x4 gn[2][2];
#pragma unroll
                for (int bj = 0; bj < 2; ++bj)
#pragma unroll
                    for (int n = 0; n < 2; ++n) gn[bj][n] = *(const f32x4*)(gp + 32 * bj + 8 * fq + 4 * n);
#pragma unroll
                for (int ai = 0; ai < 2; ++ai)
#pragma unroll
                    for (int m = 0; m < 4; ++m) { const int row = rbase + ai * HALF + m * 16;
                        float ss = 0.f;
#pragma unroll
                        for (int bj = 0; bj < 2; ++bj)
#pragma unroll
                            for (int n = 0; n < 2; ++n) { const f32x4 x = ZV(ai, bj, m, n); ss += (x[0] * x[0] + x[1] * x[1]) + (x[2] * x[2] + x[3] * x[3]); }
                        ss += __shfl_xor(ss, 16); ss += __shfl_xor(ss, 32);
                        const float rstd = __builtin_amdgcn_rsqf(ss * (1.0f / 64.0f) + 1e-6f);
                        f32x4 o1[2], o2[2];
#pragma unroll
                        for (int n = 0; n < 2; ++n) { o1[n] = ZV(ai, 0, m, n) * rstd * gn[0][n]; o2[n] = ZV(ai, 1, m, n) * rstd * gn[1][n]; }
                        if (lat) { const int t = row & 2047;
#pragma unroll
                            for (int n = 0; n < 2; ++n) { const f32x4 c = *(const f32x4*)(ropeC + t * 32 + 8 * fq + 4 * n), s = *(const f32x4*)(ropeS + t * 32 + 8 * fq + 4 * n);
                                const f32x4 a = o1[n] * c - o2[n] * s, bq = o1[n] * s + o2[n] * c; o1[n] = a; o2[n] = bq; } }
                        bf16_t* p;
                        if (isq) p = Q + (size_t)row * 512 + (4 * pn + wc) * 64 + 8 * fq;
                        else { const int kvrow = lat ? (row >> 11) * KVROWS + (row & 2047) : ((row - NLAT) >> 8) * KVROWS + 2048 + (row & 255); p = Kb + (size_t)kvrow * 128 + wc * 64 + 8 * fq; }
                        u32x4 w;
                        w.x = cvt_pk_bf16(o1[0][0] * osc, o1[0][1] * osc); w.y = cvt_pk_bf16(o1[0][2] * osc, o1[0][3] * osc); w.z = cvt_pk_bf16(o1[1][0] * osc, o1[1][1] * osc); w.w = cvt_pk_bf16(o1[1][2] * osc, o1[1][3] * osc);
                        *(u32x4*)p = w;
                        w.x = cvt_pk_bf16(o2[0][0] * osc, o2[0][1] * osc); w.y = cvt_pk_bf16(o2[0][2] * osc, o2[0][3] * osc); w.z = cvt_pk_bf16(o2[1][0] * osc, o2[1][1] * osc); w.w = cvt_pk_bf16(o2[1][2] * osc, o2[1][3] * osc);
                        *(u32x4*)(p + 32) = w; }
            }
        } else if (pn == 3) {
#pragma unroll
            for (int ai = 0; ai < 2; ++ai)
#pragma unroll
                for (int m = 0; m < 4; ++m) { const int row = rbase + ai * HALF + m * 16; bf16_t* p = UP + (size_t)row * 256 + wc * 32 + 8 * fq;
#pragma unroll
                    for (int bj = 0; bj < 2; ++bj) { const f32x4 a = ZV(ai, bj, m, 0), c = ZV(ai, bj, m, 1); u32x4 w; w.x = cvt_pk_bf16(a[0], a[1]); w.y = cvt_pk_bf16(a[2], a[3]); w.z = cvt_pk_bf16(c[0], c[1]); w.w = cvt_pk_bf16(c[2], c[3]); *(u32x4*)(p + HALF * bj) = w; } }
        } else {
            const int half = pn - 4;
#pragma unroll
            for (int ai = 0; ai < 2; ++ai)
#pragma unroll
                for (int m = 0; m < 4; ++m) { const int row = rbase + ai * HALF + m * 16;
                    if (lat) { const int b = row >> 11, t = row & 2047; bf16_t* p = VT + ((size_t)b * 256 + 32 * wc + 8 * fq) * 4096 + half * 2048 + t; asm volatile("" : "+v"(p)); __attribute__((address_space(1))) bf16_t* gp = (__attribute__((address_space(1))) bf16_t*)p;
#pragma unroll
                        for (int bj = 0; bj < 2; ++bj)
#pragma unroll
                            for (int n = 0; n < 2; ++n)
#pragma unroll
                                for (int e = 0; e < 4; ++e) gp[(size_t)(128 * bj + 4 * n + e) * 4096] = (bf16_t)f2bf1(ZV(ai, bj, m, n)[e]); }
                    else { const int b = (row - NLAT) >> 8, t = row & 255; bf16_t* p = VTC + ((size_t)b * 256 + 32 * wc + 8 * fq) * 512 + half * 256 + t; asm volatile("" : "+v"(p)); __attribute__((address_space(1))) bf16_t* gp = (__attribute__((address_space(1))) bf16_t*)p;
#pragma unroll
                        for (int bj = 0; bj < 2; ++bj)
#pragma unroll
                            for (int n = 0; n < 2; ++n)
#pragma unroll
                                for (int e = 0; e < 4; ++e) gp[(size_t)(128 * bj + 4 * n + e) * 512] = (bf16_t)f2bf1(ZV(ai, bj, m, n)[e]); } }
        }
    }
#undef ZV
};
struct EpiDFT {
    static constexpr bool PERM = true, AFTER_DRAIN = false;
    bf16_t* AM; int rowbase, L; float sc;
    __device__ __forceinline__ void operator()(const f32x4 (&acc)[2][2][4][2], const Unit& u, int wr, int wc, int fr, int fq) const {
        asm volatile("" : "+v"(fr), "+v"(fq));
        const int r0 = rowbase + u.pn * L + u.pm * BM + wr * 64 + fr;
#pragma unroll
        for (int ai = 0; ai < 2; ++ai)
#pragma unroll
            for (int m = 0; m < 4; ++m) { bf16_t* p = AM + (size_t)(r0 + ai * HALF + m * 16) * DMODEL + 768 + wc * 32 + 8 * fq;
#pragma unroll
                for (int bj = 0; bj < 2; ++bj) { const f32x4 a = acc[ai][bj][m][0] * sc, c = acc[ai][bj][m][1] * sc; u32x4 w; w.x = cvt_pk_bf16(a[0], a[1]); w.y = cvt_pk_bf16(a[2], a[3]); w.z = cvt_pk_bf16(c[0], c[1]); w.w = cvt_pk_bf16(c[2], c[3]); *(u32x4*)(p + HALF * bj) = w; } }
    }
};
struct EpiDummy {
    static constexpr bool PERM = true, AFTER_DRAIN = false;
    float* X;
    __device__ __forceinline__ void operator()(const f32x4 (&acc)[2][2][4][2], const Unit& u, int wr, int wc, int fr, int fq) const {
        f32x4 t = {0.f, 0.f, 0.f, 0.f};
#pragma unroll
        for (int ai = 0; ai < 2; ++ai)
#pragma unroll
            for (int bj = 0; bj < 2; ++bj)
#pragma unroll
                for (int m = 0; m < 4; ++m)
#pragma unroll
                    for (int n = 0; n < 2; ++n) t += acc[ai][bj][m][n];
        if (t[0] + t[1] + t[2] + t[3] == 12345.6789f) X[0] = 1.0f;
    }
};
template <class Epi, class Sched, bool ALIGN_EPI = false, bool SP2 = false>
__device__ __forceinline__ void gemm_phase(PG8_LAS unsigned char* lds, const Gemm g, const Sched& S, const Epi& E) {
    const int tid = fresh_tid(), wid = __builtin_amdgcn_readfirstlane(tid >> 6), lane = tid & 63, wr = wid >> 2, wc = wid & 3, fr = lane & 15, fq = lane >> 4;
    const int K = g.K, nt = K / BK;
    const int pitchA = g.ablk ? BK : K;
    unsigned voffA[2], voffB[2];
#pragma unroll
    for (int i = 0; i < 2; ++i) { int R, C; stage_rc(tid * 16 + i * 8192, R, C); const int Rb = Epi::PERM ? ((R & ~31) + perm32(R & 31)) : R;
        voffA[i] = (unsigned)(R * pitchA + C) * 2u; voffB[i] = (unsigned)(Rb * K + C) * 2u; }
    const size_t kstep = (size_t)(BK * 2);
    const size_t hstep = (size_t)HALF * K * 2;
    const size_t kstepA = g.ablk ? (size_t)BM * BK * 2 : kstep, hstepA = (size_t)HALF * pitchA * 2;
    const size_t tstep = 2 * hstep;
    const unsigned ldsw = (unsigned)wid * 1024u;
    const int aoff = lds_byte(wr * 64 + fr, fq * 8), boff = lds_byte(wc * 32 + fr, fq * 8);
#define PG8_SA(b, h) (((b) * 2 + (h)) * HTB)
#define PG8_SB(b, h) ((4 + (b) * 2 + (h)) * HTB)
#define PG8_STAGE(bufoff, gbase, voff) do { _Pragma("unroll") for (int _i = 0; _i < 2; ++_i) \
        __builtin_amdgcn_global_load_lds((const unsigned*)((const char*)(gbase) + (voff)[_i]), (PG8_LAS unsigned*)(lds + (bufoff) + ldsw + _i * 8192), 16, 0, 0); } while (0)
#define PG8_LDA(dst, b, h) do { _Pragma("unroll") for (int m = 0; m < 4; ++m) _Pragma("unroll") for (int k = 0; k < 2; ++k) dst[m][k] = *(const PG8_LAS bf16x8*)(lds + PG8_SA(b, h) + aoff + m * 2048 + k * 1024); } while (0)
#define PG8_LDB(dst, b, h) do { _Pragma("unroll") for (int n = 0; n < 2; ++n) _Pragma("unroll") for (int k = 0; k < 2; ++k) dst[n][k] = *(const PG8_LAS bf16x8*)(lds + PG8_SB(b, h) + boff + n * 2048 + k * 1024); } while (0)
#define PG8_MMA(ai, bj, At, Bt) do { __builtin_amdgcn_s_setprio(1); _Pragma("unroll") for (int m = 0; m < 4; ++m) _Pragma("unroll") for (int n = 0; n < 2; ++n) _Pragma("unroll") for (int k = 0; k < 2; ++k) \
        acc[ai][bj][m][n] = __builtin_amdgcn_mfma_f32_16x16x32_bf16(Bt[n][k], At[m][k], acc[ai][bj][m][n], 0, 0, 0); __builtin_amdgcn_s_setprio(0); } while (0)
#define PG8_WAIT_V(n) asm volatile("s_waitcnt vmcnt(" #n ")" ::: "memory")
#define PG8_WAIT_L(n) asm volatile("s_waitcnt lgkmcnt(" #n ")" ::: "memory")
#define PG8_BAR __builtin_amdgcn_s_barrier()
#define PG8_SCHED __builtin_amdgcn_sched_barrier(0)
    Unit cur, nxt; int ui = 0;
    if (!S.next(0, cur)) return;
    f32x4 acc[2][2][4][2];
#pragma unroll
    for (int a = 0; a < 2; ++a)
#pragma unroll
        for (int b = 0; b < 2; ++b)
#pragma unroll
            for (int m = 0; m < 4; ++m)
#pragma unroll
                for (int n = 0; n < 2; ++n) acc[a][b][m][n] = (f32x4){0.f, 0.f, 0.f, 0.f};
    bf16x8 At[4][2], B0[2][2], B1[2][2];
    const char* cA = (const char*)g.A + (size_t)cur.pm * tstep; const char* cB = (const char*)g.Bt + (size_t)cur.pn * tstep;
    S.a_ready(cur);
    if constexpr (SP2) {
        PG8_STAGE(PG8_SB(0, 0), cB, voffB); PG8_STAGE(PG8_SB(0, 1), cB + hstep, voffB); PG8_STAGE(PG8_SA(0, 0), cA, voffA); PG8_STAGE(PG8_SA(0, 1), cA + hstepA, voffA);
        if (wr == 1) PG8_BAR;
        PG8_WAIT_V(2); PG8_BAR;
        PG8_STAGE(PG8_SB(1, 0), cB + kstep, voffB); PG8_STAGE(PG8_SA(1, 0), cA + kstepA, voffA); PG8_STAGE(PG8_SB(1, 1), cB + hstep + kstep, voffB);
        PG8_WAIT_V(6); PG8_BAR;
    } else {
        PG8_STAGE(PG8_SB(0, 0), cB, voffB); PG8_STAGE(PG8_SA(0, 0), cA, voffA); PG8_STAGE(PG8_SB(0, 1), cB + hstep, voffB); PG8_STAGE(PG8_SA(0, 1), cA + hstepA, voffA);
        if (wr == 1) PG8_BAR;
        PG8_WAIT_V(4); PG8_BAR;
        PG8_STAGE(PG8_SB(1, 0), cB + kstep, voffB); PG8_STAGE(PG8_SA(1, 0), cA + kstepA, voffA); PG8_STAGE(PG8_SB(1, 1), cB + hstep + kstep, voffB);
        PG8_WAIT_V(6); PG8_BAR;
    }
    for (;;) {
        const bool has_next = S.next(ui + 1, nxt);
        const char* nA = has_next ? (const char*)g.A + (size_t)nxt.pm * tstep : cA; const char* nB = has_next ? (const char*)g.Bt + (size_t)nxt.pn * tstep : cB;
        for (int t = 0; t < nt; t += 2) {
            const bool last = (t == nt - 2);
            const char* a1 = cA + (size_t)(t + 1) * kstepA;
            const char* a2 = last ? nA : cA + (size_t)(t + 2) * kstepA; const char* b2 = last ? nB : cB + (size_t)(t + 2) * kstep;
            const char* a3 = a2 + kstepA; const char* b3 = b2 + kstep;
            if (last && has_next) S.a_ready(nxt);
            if constexpr (SP2) {
            PG8_LDB(B0, 0, 0); PG8_LDB(B1, 0, 1); PG8_SCHED; PG8_LDA(At, 0, 0); PG8_STAGE(PG8_SA(1, 1), a1 + hstepA, voffA);
            PG8_WAIT_V(8); PG8_WAIT_L(0); PG8_BAR; PG8_MMA(0, 0, At, B0); PG8_MMA(0, 1, At, B1); PG8_BAR; PG8_SCHED;
            PG8_LDA(At, 0, 1); PG8_STAGE(PG8_SB(0, 0), b2, voffB); PG8_STAGE(PG8_SB(0, 1), b2 + hstep, voffB); PG8_STAGE(PG8_SA(0, 0), a2, voffA);
            PG8_WAIT_V(8); PG8_WAIT_L(0); PG8_BAR; PG8_MMA(1, 0, At, B0); PG8_MMA(1, 1, At, B1); PG8_BAR; PG8_SCHED;
            PG8_LDB(B0, 1, 0); PG8_LDB(B1, 1, 1); PG8_SCHED; PG8_LDA(At, 1, 0); PG8_STAGE(PG8_SA(0, 1), a2 + hstepA, voffA);
            PG8_WAIT_V(8); PG8_WAIT_L(0); PG8_BAR; PG8_MMA(0, 0, At, B0); PG8_MMA(0, 1, At, B1); PG8_BAR; PG8_SCHED;
            PG8_LDA(At, 1, 1); PG8_STAGE(PG8_SB(1, 0), b3, voffB); PG8_STAGE(PG8_SB(1, 1), b3 + hstep, voffB); PG8_STAGE(PG8_SA(1, 0), a3, voffA);
            PG8_WAIT_V(8); PG8_WAIT_L(0); PG8_BAR; PG8_MMA(1, 0, At, B0); PG8_MMA(1, 1, At, B1); PG8_BAR; PG8_SCHED;
            } else {
            PG8_LDB(B0, 0, 0); PG8_SCHED; PG8_LDA(At, 0, 0); PG8_STAGE(PG8_SA(1, 1), a1 + hstepA, voffA);
            PG8_WAIT_L(8); PG8_BAR; PG8_WAIT_L(0); PG8_MMA(0, 0, At, B0); PG8_BAR; PG8_SCHED;
            PG8_LDB(B1, 0, 1); PG8_STAGE(PG8_SB(0, 0), b2, voffB);
            PG8_BAR; PG8_WAIT_L(0); PG8_MMA(0, 1, At, B1); PG8_BAR;
            PG8_LDA(At, 0, 1); PG8_STAGE(PG8_SA(0, 0), a2, voffA);
            PG8_BAR; PG8_WAIT_L(0); PG8_MMA(1, 0, At, B0); PG8_BAR; PG8_SCHED;
            PG8_STAGE(PG8_SB(0, 1), b2 + hstep, voffB);
            PG8_WAIT_V(6); PG8_BAR; PG8_MMA(1, 1, At, B1); PG8_BAR;
            PG8_LDB(B0, 1, 0); PG8_SCHED; PG8_LDA(At, 1, 0); PG8_STAGE(PG8_SA(0, 1), a2 + hstepA, voffA);
            PG8_WAIT_L(8); PG8_BAR; PG8_WAIT_L(0); PG8_MMA(0, 0, At, B0); PG8_BAR; PG8_SCHED;
            PG8_LDB(B1, 1, 1); PG8_STAGE(PG8_SB(1, 0), b3, voffB);
            PG8_BAR; PG8_WAIT_L(0); PG8_MMA(0, 1, At, B1); PG8_BAR;
            PG8_LDA(At, 1, 1); PG8_STAGE(PG8_SA(1, 0), a3, voffA);
            PG8_BAR; PG8_WAIT_L(0); PG8_MMA(1, 0, At, B0); PG8_BAR; PG8_SCHED;
            PG8_STAGE(PG8_SB(1, 1), b3 + hstep, voffB);
            PG8_WAIT_V(6); PG8_BAR; PG8_MMA(1, 1, At, B1); PG8_BAR;
            }
        }
        if constexpr (ALIGN_EPI) { if (wr == 0) PG8_BAR; }
        if constexpr (!Epi::AFTER_DRAIN) { E(acc, cur, wr, wc, fr, fq); S.done(cur); }
        if (!has_next) break;
#pragma unroll
        for (int a = 0; a < 2; ++a)
#pragma unroll
            for (int b = 0; b < 2; ++b)
#pragma unroll
                for (int m = 0; m < 4; ++m)
#pragma unroll
                    for (int n = 0; n < 2; ++n) acc[a][b][m][n] = (f32x4){0.f, 0.f, 0.f, 0.f};
        cur = nxt; cA = nA; cB = nB; ++ui;
        if constexpr (ALIGN_EPI) { if (wr == 1) PG8_BAR; }
    }
    PG8_WAIT_V(0);
    if constexpr (!ALIGN_EPI) { if (wr == 0) PG8_BAR; }
    PG8_BAR;
    if constexpr (Epi::AFTER_DRAIN) { E.fused(acc, cur, wr, wc, fr, fq, lds, wid, lane); S.done(cur); }
#undef PG8_SA
#undef PG8_SB
#undef PG8_STAGE
#undef PG8_LDA
#undef PG8_LDB
#undef PG8_MMA
#undef PG8_WAIT_V
#undef PG8_WAIT_L
#undef PG8_BAR
#undef PG8_SCHED
}
}
#include <hip/hip_bf16.h>
#include <cmath>
namespace attn_body {
using bf16=__hip_bfloat16;
using bf16x8=__attribute__((ext_vector_type(8)))short;
using s16x4=__attribute__((ext_vector_type(4)))short;
using f32x16=__attribute__((ext_vector_type(16)))float;
using u32x4=__attribute__((ext_vector_type(4)))unsigned;
constexpr int D=64,QP=512,KVP=128,OP=1024;
constexpr int NW=8,QBLK=32,QB=QBLK*NW,KVBLK=64;
__device__ __forceinline__ int crow(int r,int hi){return (r&3)+8*(r>>2)+4*hi;}
#define SBAR() __builtin_amdgcn_sched_barrier(0)
constexpr int NSLOT=3, SLOTB=8192;
constexpr int LDS_K=0, LDS_V=NSLOT*SLOTB, LDS_WS=2*NSLOT*SLOTB, LDS_OST=LDS_WS+NW*64*4, LDS_BYTES=LDS_OST+NW*4096;
constexpr float C2=0.125f*1.4426950408889634f;
__device__ __forceinline__ void glds16(const void*gsrc,unsigned lds_dst){unsigned keep;
  asm volatile("s_mov_b32 %0, m0\n\ts_mov_b32 m0, %2\n\ts_nop 0\n\tglobal_load_lds_dwordx4 %1, off\n\ts_mov_b32 m0, %0":"=&s"(keep):"v"(gsrc),"s"(lds_dst):"memory");}
__device__ __forceinline__ float max3f(float a,float b,float c){float r;asm("v_max3_f32 %0, %1, %2, %3":"=v"(r):"v"(a),"v"(b),"v"(c));return r;}
__device__ __forceinline__ float max2f(float a,float b){float r;asm("v_max_f32_e32 %0, %1, %2":"=v"(r):"v"(a),"v"(b));return r;}
__device__ __forceinline__ float fadd_s(float a,float b){float r;asm("v_add_f32_e32 %0, %1, %2":"=v"(r):"v"(a),"v"(b));return r;}
__device__ __forceinline__ float fsub_s(float a,float b){float r;asm("v_sub_f32_e32 %0, %1, %2":"=v"(r):"v"(a),"v"(b));return r;}
typedef float f32x2_t __attribute__((ext_vector_type(2))); typedef __bf16 bf16x2_t __attribute__((ext_vector_type(2)));
__device__ __forceinline__ unsigned cvtpk_s(float lo,float hi){f32x2_t v={lo,hi};bf16x2_t b=__builtin_convertvector(v,bf16x2_t);return __builtin_bit_cast(unsigned,b);}
#define WAIT_BAR(N) asm volatile("s_waitcnt vmcnt(" #N ") lgkmcnt(0)\n\ts_barrier":::"memory")

__device__ __forceinline__ void qkt(f32x16&p0,f32x16&p1,const char*Kslot,const bf16x8*qr,const f32x16&negm,int r32,int hi){
  const char*kb=Kslot+hi*1024+r32*16;
  #pragma unroll
  for(int d0=0;d0<4;++d0){
    const bf16x8 b0=*reinterpret_cast<const bf16x8*>(kb+d0*2048);
    const bf16x8 b1=*reinterpret_cast<const bf16x8*>(kb+d0*2048+512);
    if(d0==0){p0=__builtin_amdgcn_mfma_f32_32x32x16_bf16(b0,qr[0],negm,0,0,0);p1=__builtin_amdgcn_mfma_f32_32x32x16_bf16(b1,qr[0],negm,0,0,0);}
    else{p0=__builtin_amdgcn_mfma_f32_32x32x16_bf16(b0,qr[d0],p0,0,0,0);p1=__builtin_amdgcn_mfma_f32_32x32x16_bf16(b1,qr[d0],p1,0,0,0);}}
}
typedef __attribute__((address_space(3))) const char* lds_cptr;
typedef short v4i16_t __attribute__((ext_vector_type(4)));
__device__ __forceinline__ void kload8(bf16x8*kf,lds_cptr kp){
  kf[0]=*(const __attribute__((address_space(3))) bf16x8*)(kp);      kf[1]=*(const __attribute__((address_space(3))) bf16x8*)(kp+512);
  kf[2]=*(const __attribute__((address_space(3))) bf16x8*)(kp+2048); kf[3]=*(const __attribute__((address_space(3))) bf16x8*)(kp+2560);
  kf[4]=*(const __attribute__((address_space(3))) bf16x8*)(kp+4096); kf[5]=*(const __attribute__((address_space(3))) bf16x8*)(kp+4608);
  kf[6]=*(const __attribute__((address_space(3))) bf16x8*)(kp+6144); kf[7]=*(const __attribute__((address_space(3))) bf16x8*)(kp+6656);
}
__device__ __forceinline__ void kload2(bf16x8*kf,lds_cptr kp,int j){ kf[2*j]=*(const __attribute__((address_space(3))) bf16x8*)(kp+j*2048); kf[2*j+1]=*(const __attribute__((address_space(3))) bf16x8*)(kp+j*2048+512); }
__device__ __forceinline__ s16x4 vtr(lds_cptr p){ return __builtin_bit_cast(s16x4,__builtin_amdgcn_ds_read_tr16_b64_v4i16((__attribute__((address_space(3))) v4i16_t*)p)); }
__device__ __forceinline__ float rowmax(const f32x16&p0,const f32x16&p1){
  float a=max3f(p0[0],p0[1],p1[0]),b=max3f(p0[2],p0[3],p1[1]);a=max3f(a,p1[2],p1[3]);
  #pragma unroll
  for(int r=4;r<16;r+=4){a=max3f(a,p0[r],p0[r+1]);b=max3f(b,p0[r+2],p0[r+3]);a=max3f(a,p1[r],p1[r+1]);b=max3f(b,p1[r+2],p1[r+3]);}
  const float m=max2f(a,b);
  auto rr=__builtin_amdgcn_permlane32_swap(__float_as_uint(m),__float_as_uint(m),false,false);
  return max2f(__uint_as_float(rr[0]),__uint_as_float(rr[1]));
}
__device__ __forceinline__ void pv(f32x16*o,int vb,bf16x8 pa0,bf16x8 pa1,bf16x8 pa2,bf16x8 pa3){
  #pragma unroll
  for(int d0=0;d0<2;++d0){s16x4 lo[4],hi[4];
    #pragma unroll
    for(int ks=0;ks<4;++ks){
      asm volatile("ds_read_b64_tr_b16 %0,%1 offset:%c2":"=&v"(lo[ks]):"v"(vb),"i"(d0*4096+ks*1024):"memory");
      asm volatile("ds_read_b64_tr_b16 %0,%1 offset:%c2":"=&v"(hi[ks]):"v"(vb),"i"(d0*4096+ks*1024+512):"memory");}
    asm volatile("s_waitcnt lgkmcnt(0)":::"memory");SBAR();
    #define PK(k) (bf16x8){lo[k][0],lo[k][1],lo[k][2],lo[k][3],hi[k][0],hi[k][1],hi[k][2],hi[k][3]}
    o[d0]=__builtin_amdgcn_mfma_f32_32x32x16_bf16(pa0,PK(0),o[d0],0,0,0);
    o[d0]=__builtin_amdgcn_mfma_f32_32x32x16_bf16(pa1,PK(1),o[d0],0,0,0);
    o[d0]=__builtin_amdgcn_mfma_f32_32x32x16_bf16(pa2,PK(2),o[d0],0,0,0);
    o[d0]=__builtin_amdgcn_mfma_f32_32x32x16_bf16(pa3,PK(3),o[d0],0,0,0);
    #undef PK
  }
}

#ifndef ATTN_STORE16
#define ATTN_STORE16(p,v) (*(u32x4*)(p)=(v))
#endif
template<int THRL> __device__ __forceinline__ void attn_unit(const bf16*Qb,const bf16*Kh,const bf16*Vh,bf16*Ob,const int NT,char*shm){
  const int tid=fresh_tid(),lane=tid&63,r32=lane&31,hi=lane>>5; const int wid=__builtin_amdgcn_readfirstlane(tid>>6);
  const bf16*Qw=Qb+(long)(wid*QBLK)*QP;
  const unsigned lds0=(unsigned)(uintptr_t)shm;
  float*wsf=(float*)(shm+LDS_WS)+wid*64;
  const bf16*ksrc=Kh+(long)lane*KVP+wid*8;
  const bf16*vsrc=Vh+(long)(16*(wid&3)+(lane>>2))*KVP+(wid>>2)*32+(lane&3)*8;
  const unsigned kdst=lds0+LDS_K+wid*1024, vdst=lds0+LDS_V+wid*1024;
  #define DMA_K(t,slot) glds16(ksrc+(long)(t)*KVBLK*KVP,(unsigned)__builtin_amdgcn_readfirstlane(kdst+(slot)))
  #define DMA_V(t,slot) glds16(vsrc+(long)(t)*KVBLK*KVP,(unsigned)__builtin_amdgcn_readfirstlane(vdst+(slot)))
  const int vb0=(int)(lds0+LDS_V)+((lane>>4)&1)*32+(lane&3)*8+(4*hi+((lane&15)>>2))*64;
  const char*Kbase=shm+LDS_K; bf16x8 kf[8];
  const lds_cptr shm3=(lds_cptr)shm; const lds_cptr kp0=shm3+LDS_K+hi*1024+r32*16; const lds_cptr vp0=shm3+LDS_V+((lane>>4)&1)*32+(lane&3)*8+(4*hi+((lane&15)>>2))*64;
  DMA_K(0,0);DMA_V(0,0);DMA_K(1,SLOTB);
  bf16x8 qr[4];
  #pragma unroll
  for(int d0=0;d0<4;++d0)qr[d0]=*reinterpret_cast<const bf16x8*>(&Qw[(long)r32*QP+d0*16+hi*8]);
  float mhat=0.f,l_reg=0.f;f32x16 o[2];o[0]=f32x16{};o[1]=f32x16{};f32x16 negm=f32x16{};asm volatile("":"+v"(negm));
  const int qrel=wid*QBLK+r32;
  #define CMASK(P0,P1,t) do{}while(0)
  bool resc=false;
  #define START(P0,P1) do{ const float rm=rowmax(P0,P1); resc=false; \
    { const float dl=rm; mhat=fadd_s(mhat,dl); \
      _Pragma("unroll") for(int r=0;r<16;++r){P0[r]=fsub_s(P0[r],dl);P1[r]=fsub_s(P1[r],dl);} \
      _Pragma("unroll") for(int r=0;r<16;++r)negm[r]=-mhat; asm volatile("":"+v"(negm)); } \
    _Pragma("unroll") for(int r=0;r<16;++r)P0[r]=__builtin_amdgcn_exp2f(P0[r]); }while(0)
  #define RESC() do{ if(resc){ asm volatile("s_waitcnt lgkmcnt(0)":::"memory"); \
      _Pragma("unroll") for(int d_=0;d_<2;++d_) _Pragma("unroll") for(int r=0;r<16;++r)o[d_][r]*=wsf[crow(r,hi)]; } }while(0)
  f32x16 pA0,pA1,pB0,pB1;
  int sl_prev=0,sl_cur=0,sl_next=SLOTB;
  #define ROT() do{sl_prev=sl_cur;sl_cur=sl_next;sl_next=(sl_next==(NSLOT-1)*SLOTB)?0:sl_next+SLOTB;}while(0)
  DMA_K(2,2*SLOTB);
  WAIT_BAR(3);
  qkt(pA0,pA1,Kbase,qr,negm,r32,hi);asm volatile("s_nop 15\n\ts_nop 7":"+v"(pA0),"+v"(pA1));CMASK(pA0,pA1,0);
  START(pA0,pA1);
  _Pragma("unroll") for(int r=0;r<16;++r)pA1[r]=__builtin_amdgcn_exp2f(pA1[r]);
  WAIT_BAR(0);
  DMA_K(3,0);DMA_V(1,SLOTB);
  ROT();
  kload8(kf,kp0+sl_cur);
  WAIT_BAR(2);
  s16x4 vlo[8],vhi[8]; u32x4 pw0,pw1,pw2,pw3;
  #define PKW(P,B) cvtpk_s(P[B],P[B+1])
  #define PAF(k) __builtin_bit_cast(bf16x8,pw##k)
  #define VFR(i) (bf16x8){vlo[i][0],vlo[i][1],vlo[i][2],vlo[i][3],vhi[i][0],vhi[i][1],vhi[i][2],vhi[i][3]}
  #define PIN(x) asm volatile("":"+v"(x))
  #define MX3(a,b,c) __builtin_fmaxf(__builtin_fmaxf((a),(b)),(c))
  #define GAPA(MF,A0,A1,A2,A3,W0,W1,PW) do{ MF; sacc+=A0; sacc+=A1; sacc+=A2; sacc+=A3; PIN(sacc); W0; W1; PIN(PW); SBAR(); }while(0)
  #define EX(v) __builtin_amdgcn_exp2f(v)
  #define GAPB(MF,X,B) do{ MF; X[B]=EX(X[B]); X[B+1]=EX(X[B+1]); X[B+2]=EX(X[B+2]); X[B+3]=EX(X[B+3]); PIN(X); SBAR(); }while(0)
  #define VRD(i) do{ vlo[i]=vtr(vp_+(((i)>>2)*4096+((i)&3)*1024)); vhi[i]=vtr(vp_+(((i)>>2)*4096+((i)&3)*1024+512)); }while(0)
  #define KRD(G,j) do{ if(G){ kload2(kf,kp0+sl_next,j); SBAR(); } }while(0)
  #define STEP(C0,C1,P0,P1,t,GK,GV,GL) do{ SBAR(); \
    const lds_cptr vp_=vp0+sl_prev; \
    VRD(0); SBAR(); float sacc=(P0[0]+P0[1]); \
    GAPA(C0=__builtin_amdgcn_mfma_f32_32x32x16_bf16(kf[0],qr[0],negm,0,0,0), P0[2],P0[3],P0[4],P0[5],     pw0[0]=PKW(P0,0), pw0[1]=PKW(P0,2), pw0); \
    VRD(4); SBAR(); GAPA(C1=__builtin_amdgcn_mfma_f32_32x32x16_bf16(kf[1],qr[0],negm,0,0,0), P0[6],P0[7],P0[8],P0[9],     pw0[2]=PKW(P0,4), pw0[3]=PKW(P0,6), pw0); \
    VRD(1); SBAR(); GAPA(C0=__builtin_amdgcn_mfma_f32_32x32x16_bf16(kf[2],qr[1],C0,0,0,0),   P0[10],P0[11],P0[12],P0[13], pw1[0]=PKW(P0,8), pw1[1]=PKW(P0,10), pw1); \
    VRD(5); SBAR(); GAPA(C1=__builtin_amdgcn_mfma_f32_32x32x16_bf16(kf[3],qr[1],C1,0,0,0),   P0[14],P0[15],P1[0],P1[1],   pw1[2]=PKW(P0,12),pw1[3]=PKW(P0,14), pw1); \
    VRD(2); SBAR(); GAPA(C0=__builtin_amdgcn_mfma_f32_32x32x16_bf16(kf[4],qr[2],C0,0,0,0),   P1[2],P1[3],P1[4],P1[5],     pw2[0]=PKW(P1,0), pw2[1]=PKW(P1,2), pw2); \
    VRD(6); SBAR(); GAPA(C1=__builtin_amdgcn_mfma_f32_32x32x16_bf16(kf[5],qr[2],C1,0,0,0),   P1[6],P1[7],P1[8],P1[9],     pw2[2]=PKW(P1,4), pw2[3]=PKW(P1,6), pw2); \
    VRD(3); SBAR(); GAPA(C0=__builtin_amdgcn_mfma_f32_32x32x16_bf16(kf[6],qr[3],C0,0,0,0),   P1[10],P1[11],P1[12],P1[13], pw3[0]=PKW(P1,8), pw3[1]=PKW(P1,10), pw3); \
    VRD(7); SBAR(); GAPA(C1=__builtin_amdgcn_mfma_f32_32x32x16_bf16(kf[7],qr[3],C1,0,0,0),   P1[14],P1[15],0.f,0.f,       pw3[2]=PKW(P1,12),pw3[3]=PKW(P1,14), pw3); \
    l_reg+=sacc; \
    if(GK){DMA_K((t)+3,sl_cur);} if(GV){DMA_V((t)+1,sl_next);} \
    CMASK(C0,C1,t); \
    { float a=MX3(C0[0],C0[1],C1[0]),b=MX3(C0[2],C0[3],C1[1]); a=MX3(a,C1[2],C1[3]); \
      _Pragma("unroll") for(int r=4;r<16;r+=4){a=MX3(a,C0[r],C0[r+1]);b=MX3(b,C0[r+2],C0[r+3]);a=MX3(a,C1[r],C1[r+1]);b=MX3(b,C1[r+2],C1[r+3]);} \
      float rm=__builtin_fmaxf(a,b); { auto rr=__builtin_amdgcn_permlane32_swap(__float_as_uint(rm),__float_as_uint(rm),false,false); rm=__builtin_fmaxf(__uint_as_float(rr[0]),__uint_as_float(rr[1])); } \
      resc=false; \
      if(__builtin_expect(__any(rm>(float)THRL),0)){ const float dl=__builtin_fmaxf(rm,0.f); mhat+=dl; \
        _Pragma("unroll") for(int r=0;r<16;++r){C0[r]-=dl;C1[r]-=dl;} \
        _Pragma("unroll") for(int r=0;r<16;++r)negm[r]=-mhat; asm volatile("":"+v"(negm)); \
        const float f=__builtin_amdgcn_exp2f(-dl); l_reg*=f; if(hi==0)wsf[r32]=f; resc=true; } } \
    SBAR(); \
    GAPB(o[0]=__builtin_amdgcn_mfma_f32_32x32x16_bf16(PAF(0),VFR(0),o[0],0,0,0), C0,0); \
    GAPB(o[1]=__builtin_amdgcn_mfma_f32_32x32x16_bf16(PAF(0),VFR(4),o[1],0,0,0), C0,4); \
    KRD(GL,0); GAPB(o[0]=__builtin_amdgcn_mfma_f32_32x32x16_bf16(PAF(1),VFR(1),o[0],0,0,0), C0,8); \
    KRD(GL,1); GAPB(o[1]=__builtin_amdgcn_mfma_f32_32x32x16_bf16(PAF(1),VFR(5),o[1],0,0,0), C0,12); \
    KRD(GL,2); GAPB(o[0]=__builtin_amdgcn_mfma_f32_32x32x16_bf16(PAF(2),VFR(2),o[0],0,0,0), C1,0); \
    KRD(GL,3); GAPB(o[1]=__builtin_amdgcn_mfma_f32_32x32x16_bf16(PAF(2),VFR(6),o[1],0,0,0), C1,4); \
    GAPB(o[0]=__builtin_amdgcn_mfma_f32_32x32x16_bf16(PAF(3),VFR(3),o[0],0,0,0), C1,8); \
    GAPB(o[1]=__builtin_amdgcn_mfma_f32_32x32x16_bf16(PAF(3),VFR(7),o[1],0,0,0), C1,12); \
    }while(0)
  int t=1;
  #undef CMASK
  #define CMASK(P0,P1,t) do{}while(0)
  for(;t+5<NT;t+=2){
    STEP(pB0,pB1,pA0,pA1,t,true,true,true);     WAIT_BAR(2); RESC(); ROT();
    STEP(pA0,pA1,pB0,pB1,t+1,true,true,true);   WAIT_BAR(2); RESC(); ROT();
  }
  #undef CMASK
  #define CMASK(P0,P1,t) do{}while(0)
  #define ENDW(tt) do{ if((tt)+3<NT){WAIT_BAR(2);} else if((tt)+2<NT){WAIT_BAR(1);} else {WAIT_BAR(0);} }while(0)
  for(;t+1<NT;t+=2){
    STEP(pB0,pB1,pA0,pA1,t,(t+3<NT),(t+1<NT),(t+1<NT));       ENDW(t);   RESC(); ROT();
    STEP(pA0,pA1,pB0,pB1,t+1,(t+4<NT),(t+2<NT),(t+2<NT));     ENDW(t+1); RESC(); ROT();
  }
  STEP(pB0,pB1,pA0,pA1,NT-1,false,false,false); RESC();
  { float sacc=pB0[0]+pB0[1]; _Pragma("unroll") for(int r=2;r<16;++r)sacc+=pB0[r]; _Pragma("unroll") for(int r=0;r<16;++r)sacc+=pB1[r]; l_reg+=sacc;
    pw0=(u32x4){PKW(pB0,0),PKW(pB0,2),PKW(pB0,4),PKW(pB0,6)};pw1=(u32x4){PKW(pB0,8),PKW(pB0,10),PKW(pB0,12),PKW(pB0,14)};pw2=(u32x4){PKW(pB1,0),PKW(pB1,2),PKW(pB1,4),PKW(pB1,6)};pw3=(u32x4){PKW(pB1,8),PKW(pB1,10),PKW(pB1,12),PKW(pB1,14)};
    SBAR(); pv(o,vb0+sl_cur,PAF(0),PAF(1),PAF(2),PAF(3)); }
  #undef PKW
  #undef PAF
  #undef VFR
  #undef PIN
  #undef MX3
  #undef GAPA
  #undef GAPB
  #undef EX
  #undef VRD
  #undef KRD
  #undef STEP
  #undef ENDW
  {auto rr=__builtin_amdgcn_permlane32_swap(__float_as_uint(l_reg),__float_as_uint(l_reg),false,false);l_reg=__uint_as_float(rr[0])+__uint_as_float(rr[1]);}
  if(hi==0)wsf[32+r32]=l_reg;asm volatile("s_waitcnt lgkmcnt(0)":::"memory");
  float rli[16];
  #pragma unroll
  for(int r=0;r<16;++r)rli[r]=__builtin_amdgcn_rcpf(wsf[32+crow(r,hi)]);
  bf16*Ow=Ob+(long)(wid*QBLK)*OP;
  { bf16*stg=(bf16*)(shm+LDS_OST)+wid*2048;
    #pragma unroll
    for(int r=0;r<16;++r){const int orow=crow(r,hi);
      #pragma unroll
      for(int d0=0;d0<2;++d0)stg[orow*64+d0*32+r32]=__float2bfloat16(o[d0][r]*rli[r]);}
    asm volatile("s_waitcnt lgkmcnt(0)":::"memory");
    #pragma unroll
    for(int i=0;i<4;++i){const int row=i*8+(lane>>3),ch=lane&7; const u32x4 v=*(const u32x4*)(stg+row*64+ch*8); ATTN_STORE16(Ow+(long)row*OP+ch*8,v);} }
  asm volatile("s_waitcnt lgkmcnt(0)\n\ts_barrier":::"memory");
  #undef DMA_K
  #undef DMA_V
  #undef CMASK
  #undef START
  #undef RESC
  #undef ROT
}
constexpr int ATTN_LDS_BYTES=LDS_BYTES;
#undef SBAR
#undef WAIT_BAR
}
#define LAS __attribute__((address_space(3)))
typedef unsigned short bf16;
typedef float f32x4 __attribute__((ext_vector_type(4)));
typedef unsigned v4u __attribute__((ext_vector_type(4)));
typedef unsigned v2u __attribute__((ext_vector_type(2)));
constexpr size_t MiB = 1u << 20;
constexpr size_t WS_MOD = 1 * MiB;
constexpr size_t WS_ROPE = 6 * MiB;
constexpr size_t WS_ACAT = 7 * MiB;
constexpr size_t WS_ACATC = 23 * MiB;
constexpr size_t WS_WGU = 24 * MiB;
constexpr size_t WS_WIN = 112 * MiB;
constexpr size_t WS_WDN = 124 * MiB;
constexpr size_t WS_WOUT = 168 * MiB;
constexpr size_t WS_ZERO = 0;
constexpr size_t WS_A = 176 * MiB;
constexpr size_t WS_HID = 320 * MiB;
constexpr size_t WS_Q = WS_HID;
constexpr size_t WS_K = WS_HID + 72 * MiB;
constexpr size_t WS_V = WS_HID + 90 * MiB;
constexpr size_t WS_UP = WS_HID + 108 * MiB;
constexpr size_t WS_VT = WS_HID + 144 * MiB;
constexpr size_t WS_VTC = WS_HID + 208 * MiB;
constexpr size_t WS_MODP = WS_HID;
constexpr size_t WS_A2 = 716 * MiB;
constexpr size_t WS_SS = 860 * MiB;
constexpr size_t WS_SH = 864 * MiB;
constexpr size_t WS_SWT = 870 * MiB;
constexpr size_t WS_LO = 878 * MiB;
constexpr size_t WS_END = 950 * MiB;
constexpr int LDS_BYTES = 147456, TAB_OFF = 131072;

#define XB_TMO      128
#define XB_XCNT(j)  (256  + 64 * (j))
#define XB_XSUB(j)  (1280 + 64 * (j))
#define XB_XGEN(j)  (2304 + 64 * (j))
#define XB_TOP      3328
#define XB_TOPGEN   3392
#define XCD_BAR_WORDS 3456
#define XB_SPIN_CAP (1u << 18)

__device__ __forceinline__ unsigned xb_ld(unsigned* p)              { return __hip_atomic_load(p, __ATOMIC_RELAXED, __HIP_MEMORY_SCOPE_AGENT); }
__device__ __forceinline__ unsigned xb_add(unsigned* p, unsigned v) { return __hip_atomic_fetch_add(p, v, __ATOMIC_RELAXED, __HIP_MEMORY_SCOPE_AGENT); }
__device__ __forceinline__ unsigned xb_xcc_id() { return (unsigned)__builtin_amdgcn_s_getreg((3 << 11) | 20) & 0xFu; }
#define XB_SPIN(cond, bar) do { unsigned _sp = 0; while (cond) { __builtin_amdgcn_s_sleep(1); \
    if ((++_sp & 255u) == 0u) { if (xb_ld(&(bar)[XB_TMO])) break; if (_sp > XB_SPIN_CAP) { atomicAdd(&(bar)[XB_TMO], 1u); break; } } } } while (0)

struct XcdBarrier {
    unsigned* bar; unsigned x;
    volatile LAS unsigned* st;
};

__device__ __forceinline__ XcdBarrier xcd_barrier_post(unsigned* bar, volatile LAS unsigned* st) {
    XcdBarrier b; b.bar = bar; b.x = xb_xcc_id(); b.st = st;
    if (threadIdx.x == 0) (void)xb_add(&bar[XB_XCNT(b.x)], 1u);
    return b;
}
__device__ __forceinline__ void xcd_barrier_complete(unsigned* bar, unsigned x, unsigned& nloc, unsigned& nx) {
    const unsigned G = gridDim.x * gridDim.y * gridDim.z;
    unsigned sum, cnt, mine, sp = 0u;
    for (;;) {
        sum = 0u; cnt = 0u; mine = 0u;
#pragma unroll
        for (unsigned j = 0; j < 16; ++j) { const unsigned c = xb_ld(&bar[XB_XCNT(j)]); sum += c; cnt += (c > 0u) ? 1u : 0u; mine = (j == x) ? c : mine; }
        if (sum == G) break;
        __builtin_amdgcn_s_sleep(1);
        if ((++sp & 255u) == 0u) { if (xb_ld(&bar[XB_TMO])) break; if (sp > XB_SPIN_CAP) { atomicAdd(&bar[XB_TMO], 1u); break; } }
    }
    nloc = mine > 0u ? mine : 1u; nx = cnt > 0u ? cnt : 1u;
}

__device__ __forceinline__ void xcd_barrier(const XcdBarrier& b) {
    asm volatile("s_waitcnt vmcnt(0)" ::: "memory");
    __syncthreads();
    if (threadIdx.x == 0) {
        unsigned* bar = b.bar;
        __builtin_amdgcn_s_waitcnt(0);
        unsigned nloc = b.st[0], nx = b.st[1];
        if (nloc == 0u) { xcd_barrier_complete(bar, b.x, nloc, nx); b.st[0] = nloc; b.st[1] = nx; }
        const unsigned old = xb_add(&bar[XB_XSUB(b.x)], 1u);
        const unsigned gen = old / nloc;
        if (old + 1u == (gen + 1u) * nloc) {
            __builtin_amdgcn_fence(__ATOMIC_RELEASE, "agent");
            asm volatile("s_waitcnt vmcnt(0)" ::: "memory");
            const unsigned og = xb_add(&bar[XB_TOP], 1u);
            const unsigned tg = og / nx;
            if (og + 1u == (tg + 1u) * nx) xb_add(&bar[XB_TOPGEN], 1u);
            else XB_SPIN(xb_ld(&bar[XB_TOPGEN]) == tg, bar);
            __builtin_amdgcn_fence(__ATOMIC_ACQUIRE, "agent");
            xb_add(&bar[XB_XGEN(b.x)], 1u);
            asm volatile("s_waitcnt vmcnt(0)" ::: "memory");
        } else {
            XB_SPIN(xb_ld(&bar[XB_XGEN(b.x)]) == gen, bar);
            __builtin_amdgcn_fence(__ATOMIC_ACQUIRE, "agent");
            asm volatile("s_waitcnt vmcnt(0)" ::: "memory");
        }
    }
    __syncthreads();
}

#ifndef PROBE
#define PROBE 0
#endif
#if PROBE == 6
#define GSYNC() do { xcd_barrier(mk_xbar(args.ws, L)); xcd_barrier(mk_xbar(args.ws, L)); } while (0)
#else
#define GSYNC() xcd_barrier(mk_xbar(args.ws, L))
#endif
constexpr size_t WS_BAR = 65536;
constexpr int XB_LDS_OFF = TAB_OFF + 12288;
__device__ __forceinline__ XcdBarrier mk_xbar(unsigned char* ws, LAS unsigned char* L) { asm volatile("" : "+s"(ws)); XcdBarrier b; b.bar = (unsigned*)(ws + WS_BAR); b.x = xb_xcc_id(); b.st = (volatile LAS unsigned*)(L + XB_LDS_OFF); return b; }
struct Args { const float* in[18]; float* out; unsigned char* ws; };
constexpr int I_GU = 16 * 176, I_DN = 44 * 32, I_IN = 16 * 32, I_OUT = 8 * 32;

__device__ __forceinline__ void stagger(int ticks) {
    if (ticks > 0) { const unsigned long long t0 = __builtin_amdgcn_s_memrealtime(); while ((long long)(__builtin_amdgcn_s_memrealtime() - t0) < (long long)ticks) __builtin_amdgcn_s_sleep(8); }
}
#ifndef STG_GU
#define STG_GU 0
#endif
#ifndef STG_DN
#define STG_DN 0
#endif
#ifndef STG_OUT
#define STG_OUT 0
#endif
__device__ __forceinline__ float wave_sum(float v) {
#pragma unroll
    for (int o = 1; o < 64; o <<= 1) v += __shfl_xor(v, o);
    return v;
}
__device__ __forceinline__ unsigned pk2(float lo, float hi) { return pg8::cvt_pk_bf16(lo, hi); }
__device__ __forceinline__ int map_row(int mode, int n) {
    if (mode == 0) return n;
    if (mode == 3) return 256 * (n >> 8) + 128 * ((n >> 3) & 1) + 32 * ((n >> 6) & 3) + 8 * ((n >> 4) & 3) + (n & 7);
    if (mode == 1) { const int isu = n >= DFF ? 1 : 0; const int j = n - isu * DFF; return 256 * (j >> 7) + 128 * isu + (j & 127); }
    if (n < 512) { const int h = n >> 6, d = n & 63; return 256 * (h >> 2) + 128 * (d >> 5) + 32 * (h & 3) + (d & 31); }
    if (n < 768) { const int wc = (n - 512) >> 6, d = n & 63; return 512 + 128 * (d >> 5) + 32 * wc + (d & 31); }
    return n;
}
__device__ __forceinline__ void transpose_item(const float* W, int ldw, bf16* WT, int ldt, int mode, LAS float* scr, int kb, int nb, int lane) {
    const int k0 = 64 * kb, n0 = 32 * nb;
#pragma unroll 8
    for (int i = 0; i < 32; ++i) { const int kk = 2 * i + (lane >> 5); scr[kk * 33 + (lane & 31)] = W[(size_t)(k0 + kk) * ldw + n0 + (lane & 31)]; }
    asm volatile("s_waitcnt lgkmcnt(0)" ::: "memory");
    const int c = lane & 7;
#pragma unroll
    for (int j = 0; j < 4; ++j) { const int n = (lane >> 3) + 8 * j; const LAS float* s = scr + (8 * c) * 33 + n;
        v4u o; o.x = pk2(s[0 * 33], s[1 * 33]); o.y = pk2(s[2 * 33], s[3 * 33]); o.z = pk2(s[4 * 33], s[5 * 33]); o.w = pk2(s[6 * 33], s[7 * 33]);
        *(v4u*)(WT + (size_t)map_row(mode, n0 + n) * ldt + k0 + 8 * c) = o; }
    asm volatile("s_waitcnt lgkmcnt(0)" ::: "memory");
}
__device__ __forceinline__ void norm_rows(const float* srcL, const float* srcC, bf16* A, const float* modl, int sidx, int nrows, int gw_, int NGW) {
    const int ft = fresh_tid(); const int lane = ft & 63; const int gw = gw_ + __builtin_amdgcn_readfirstlane(ft >> 6);
    for (int row = gw; row < nrows; row += NGW) {
        const float* xr = row < NLAT ? srcL + (size_t)row * DMODEL : srcC + (size_t)(row - NLAT) * DMODEL;
        const int b = row < NLAT ? (row >> 11) : 32;
        const float* sh = modl + (size_t)b * MODW + sidx * 1024; const float* sc = sh + 1024;
        f32x4 v[4]; float s = 0.f;
#pragma unroll
        for (int j = 0; j < 4; ++j) { v[j] = ((const f32x4*)xr)[lane + 64 * j]; s += (v[j].x * v[j].x + v[j].y * v[j].y) + (v[j].z * v[j].z + v[j].w * v[j].w); }
        const float rstd = 1.0f / sqrtf(wave_sum(s) * (1.0f / DMODEL) + 1e-6f);
        v2u* o8 = (v2u*)(A + (size_t)row * DMODEL) + lane;
#pragma unroll
        for (int j = 0; j < 4; ++j) { const f32x4 shv = ((const f32x4*)sh)[lane + 64 * j], scv = ((const f32x4*)sc)[lane + 64 * j];
            const f32x4 o = v[j] * rstd * (scv + 1.0f) + shv; v2u w; w.x = pk2(o.x, o.y); w.y = pk2(o.z, o.w); o8[64 * j] = w; }
    }
}

__global__ void __launch_bounds__(512, 2) fwd_mega(Args args) {
    extern __shared__ __attribute__((aligned(16))) unsigned char lds[];
    cg::grid_group grid = cg::this_grid();
    LAS unsigned char* L = (LAS unsigned char*)lds;
    const int tid = threadIdx.x, lane = tid & 63, wave = __builtin_amdgcn_readfirstlane(tid >> 6);
    const int G = gridDim.x, bx = blockIdx.x; const int vcu = (G % 8 == 0) ? (bx % 8) * (G / 8) + bx / 8 : bx;
    const int gw = vcu * 8 + wave, NGW = G * 8; const int gtid = bx * 512 + tid, NTHR = G * 512;
    unsigned char* ws = args.ws;
    if (tid < 2) ((volatile LAS unsigned*)(L + XB_LDS_OFF))[tid] = 0u;
    __syncthreads();
    (void)xcd_barrier_post((unsigned*)(ws + WS_BAR), (volatile LAS unsigned*)(L + XB_LDS_OFF));
    const float* x_in = args.in[0]; const float* c_in = args.in[1]; const float* ctx_in = args.in[2]; const float* cctx_in = args.in[3];
    const float* ada_w = args.in[4]; const float* ada_b = args.in[5];
    const float* w_in = args.in[8]; const float* q_gain = args.in[9]; const float* k_gain = args.in[10];
    const float* pool_w = args.in[11]; const float* pool_scale = args.in[12]; const float* fft_w = args.in[13]; const float* w_out = args.in[14];
    const float* final_gain = args.in[17];
    float* ZERO = (float*)(ws + WS_ZERO); unsigned char* LOP = ws + WS_LO;
    float* MOD = (float*)(ws + WS_MOD); float* MODP = (float*)(ws + WS_MODP);
    float* ROPEC = (float*)(ws + WS_ROPE); float* ROPES = ROPEC + 2048 * 32;
    bf16* ACAT = (bf16*)(ws + WS_ACAT); bf16* ACATC = (bf16*)(ws + WS_ACATC);
    bf16* WGU = (bf16*)(ws + WS_WGU); bf16* WDN = (bf16*)(ws + WS_WDN); bf16* WIN = (bf16*)(ws + WS_WIN); bf16* WOUT = (bf16*)(ws + WS_WOUT);
    bf16* AB = (bf16*)(ws + WS_A); bf16* AB2 = (bf16*)(ws + WS_A2); bf16* HID = (bf16*)(ws + WS_HID);
    float* SSB = (float*)(ws + WS_SS); bf16* SH = (bf16*)(ws + WS_SH); float* SWT = (float*)(ws + WS_SWT);
    bf16* QB_ = (bf16*)(ws + WS_Q); bf16* KB_ = (bf16*)(ws + WS_K); bf16* VB_ = (bf16*)(ws + WS_V); bf16* UP = (bf16*)(ws + WS_UP); bf16* VT = (bf16*)(ws + WS_VT); bf16* VTC = (bf16*)(ws + WS_VTC);

#if PROBE == 4
    for (int prep_ = 0; prep_ < 2; ++prep_) {
#else
    {
#endif
#define TRANSPOSE_ITEM(it_) do { int r = (it_); \
        if (r < 8 * I_GU) { const int mi = r / I_GU; r %= I_GU; const int l_ = mi >> 1, f_ = mi & 1; \
            transpose_item(args.in[f_ ? 15 : 6] + (size_t)l_ * 1024 * 5632, 5632, WGU + (size_t)mi * 5632 * 1024, 1024, 1, scr, r / 176, r % 176, lane_); } \
        else if (r < 8 * I_GU + 8 * I_DN) { r -= 8 * I_GU; const int mi = r / I_DN; r %= I_DN; const int l_ = mi >> 1, f_ = mi & 1; \
            transpose_item(args.in[f_ ? 16 : 7] + (size_t)l_ * 2816 * 1024, 1024, WDN + (size_t)mi * 1024 * 2816, 2816, 3, scr, r / 32, r % 32, lane_); } \
        else if (r < 8 * I_GU + 8 * I_DN + 4 * I_IN) { r -= 8 * I_GU + 8 * I_DN; const int l_ = r / I_IN; r %= I_IN; \
            transpose_item(w_in + (size_t)l_ * 1024 * 1280, 1280, WIN + (size_t)l_ * 1536 * 1024, 1024, 2, scr, r / 32, r % 32, lane_); } \
        else { r -= 8 * I_GU + 8 * I_DN + 4 * I_IN; const int l_ = r / I_OUT; r %= I_OUT; \
            transpose_item(w_out + (size_t)l_ * 1024 * 1024, 1024, WOUT + (size_t)l_ * 1024 * 1024, 1024, 3, scr, r / 32, r % 32, lane_); } } while (0)
    {   LAS float* scr = (LAS float*)(L + wave * 16384); const int lane_ = lane;
        for (int k = gw; k < 2 * I_GU + 2 * I_DN + I_IN + I_OUT; k += NGW) {
            const int it = k < 2 * I_GU ? k : k < 2 * I_GU + 2 * I_DN ? 8 * I_GU + (k - 2 * I_GU) : k < 2 * I_GU + 2 * I_DN + I_IN ? 8 * I_GU + 8 * I_DN + (k - 2 * I_GU - 2 * I_DN) : 8 * I_GU + 8 * I_DN + 4 * I_IN + (k - 2 * I_GU - 2 * I_DN - I_IN);
            TRANSPOSE_ITEM(it); }
    }
    __syncthreads();
    LAS float* T2048 = (LAS float*)(L + TAB_OFF); LAS float* T64 = T2048 + 2048;
    for (int i = tid; i < 2048; i += 512) T2048[i] = cospif((float)i * (1.0f / 1024.0f));
    if (tid < 64) T64[tid] = cospif((float)tid * (1.0f / 32.0f));
    __syncthreads();
#define FOLD_CH(idx) do { \
        const int k = idx & 1023; const int hi_ = __builtin_amdgcn_readfirstlane(idx >> 10); const int l = hi_ >> 8, cc = hi_ & 255, g = cc >> 6, cp = cc & 63; \
        const float* src = w_in + ((size_t)l * 1024 + k) * 1280 + 1024 + 64 * g; \
        float ac = 0.f, as = 0.f; \
        _Pragma("unroll 4") \
        for (int c4 = 0; c4 < 16; ++c4) { const f32x4 w = *(const f32x4*)(src + 4 * c4); \
        _Pragma("unroll") \
            for (int e = 0; e < 4; ++e) { const int m = (4 * c4 + e) * cp; ac += w[e] * T64[m & 63]; as += w[e] * T64[(m - 16) & 63]; } } \
        bf16* d = WIN + (size_t)l * 1536 * 1024 + k; \
        d[(size_t)(1024 + cc) * 1024] = (bf16)pg8::f2bf1(ac * 0.125f); d[(size_t)(1280 + cc) * 1024] = (bf16)pg8::f2bf1(as * 0.125f); \
    } while (0)
#define FOLD_POOL(idx) do { \
        const int n = idx & 1023; const int hi_ = __builtin_amdgcn_readfirstlane(idx >> 10); \
        const int l = hi_ >> 5, gc = hi_ & 31, g = gc >> 3, c0 = (gc & 7) * 8; \
        const float* wo = w_out + (size_t)l * 1024 * 1024 + (size_t)(512 + 64 * g) * 1024 + n; \
        const float* ps = pool_scale + l * 256 + 64 * g; const float* pw = pool_w + ((size_t)(l * 4 + g) * 64 + c0) * 64; \
        float a[8]; \
        _Pragma("unroll") \
        for (int i = 0; i < 8; ++i) a[i] = 0.f; \
        for (int d0 = 0; d0 < 64; d0 += 8) { float w[8]; \
        _Pragma("unroll") \
            for (int dd = 0; dd < 8; ++dd) w[dd] = wo[(size_t)(d0 + dd) * 1024]; \
        _Pragma("unroll") \
            for (int dd = 0; dd < 8; ++dd) { const float ww = ps[d0 + dd] * w[dd]; \
        _Pragma("unroll") \
                for (int i = 0; i < 8; ++i) a[i] += pw[i * 64 + d0 + dd] * ww; } } \
        v4u o; o.x = pk2(a[0], a[1]); o.y = pk2(a[2], a[3]); o.z = pk2(a[4], a[5]); o.w = pk2(a[6], a[7]); \
        *(v4u*)(WOUT + (size_t)l * 1024 * 1024 + (size_t)map_row(3, n) * 1024 + 512 + 64 * g + c0) = o; \
    } while (0)
#define FOLD_FFT(idx) do { \
        const int n = idx & 1023; const int hi_ = __builtin_amdgcn_readfirstlane(idx >> 10); \
        const int l = hi_ >> 5, i0 = (hi_ & 31) * 8; \
        const float* wo = w_out + (size_t)l * 1024 * 1024 + (size_t)768 * 1024 + n; \
        const float* fw = fft_w + (size_t)l * 65536 + (size_t)i0 * 256; \
        float a[8]; \
        _Pragma("unroll") \
        for (int i = 0; i < 8; ++i) a[i] = 0.f; \
        for (int j0 = 0; j0 < 256; j0 += 8) { float w[8]; \
        _Pragma("unroll") \
            for (int jj = 0; jj < 8; ++jj) w[jj] = wo[(size_t)(j0 + jj) * 1024]; \
        _Pragma("unroll") \
            for (int i = 0; i < 8; ++i) \
        _Pragma("unroll") \
                for (int jj = 0; jj < 8; ++jj) a[i] += fw[i * 256 + j0 + jj] * w[jj]; } \
        v4u o; o.x = pk2(a[0], a[1]); o.y = pk2(a[2], a[3]); o.z = pk2(a[4], a[5]); o.w = pk2(a[6], a[7]); \
        *(v4u*)(WOUT + (size_t)l * 1024 * 1024 + (size_t)map_row(3, n) * 1024 + 768 + i0) = o; \
    } while (0)
    for (int idx = bx * 512 + fresh_tid(); idx < 262144; idx += NTHR) FOLD_CH(idx);
    for (int idx = bx * 512 + fresh_tid(); idx < 32768; idx += NTHR) FOLD_POOL(idx);
    for (int idx = bx * 512 + fresh_tid(); idx < 32768; idx += NTHR) FOLD_FFT(idx);
    for (int idx = bx * 512 + fresh_tid(); idx < 13 * NROW / 4; idx += NTHR) { ((f32x4*)SSB)[idx] = (f32x4){0.f, 0.f, 0.f, 0.f}; if (idx < 256) ((f32x4*)ZERO)[idx] = (f32x4){0.f, 0.f, 0.f, 0.f}; }
    for (int idx = bx * 512 + fresh_tid(); idx < 65536; idx += NTHR) {
        const int t = idx >> 5, i = idx & 31; const int pos = i < 16 ? (t >> 6) : (t & 63);
        const float inv = powf(10000.0f, -(float)(i & 15) * (1.0f / 16.0f)); const float ang = (float)pos * inv;
        ROPEC[idx] = cosf(ang); ROPES[idx] = sinf(ang);
    }
    for (int idx = bx * 512 + fresh_tid(); idx < 2048 * 512; idx += NTHR) {
        const int kp = idx >> 9, ch = idx & 511; unsigned w[4];
#pragma unroll
        for (int e2 = 0; e2 < 4; ++e2) { unsigned pr[2];
#pragma unroll
            for (int q = 0; q < 2; ++q) { const int np = ch * 8 + e2 * 2 + q; const int m = np < 2048 ? (kp * np) & 2047 : (kp * (np - 2048) + 512) & 2047; pr[q] = pg8::f2bf1(T2048[m]); }
            w[e2] = pr[0] | (pr[1] << 16); }
        v4u o; o.x = w[0]; o.y = w[1]; o.z = w[2]; o.w = w[3];
        *(v4u*)(ACAT + (size_t)kp * 4096 + ch * 8) = o;
    }
    for (int idx = bx * 512 + fresh_tid(); idx < 256 * 64; idx += NTHR) {
        const int kp = idx >> 6, ch = idx & 63; unsigned w[4];
#pragma unroll
        for (int e2 = 0; e2 < 4; ++e2) { unsigned pr[2];
#pragma unroll
            for (int q = 0; q < 2; ++q) { const int np = ch * 8 + e2 * 2 + q; const int m = np < 256 ? (8 * kp * np) & 2047 : (8 * kp * (np - 256) + 512) & 2047; pr[q] = pg8::f2bf1(T2048[m]); }
            w[e2] = pr[0] | (pr[1] << 16); }
        v4u o; o.x = w[0]; o.y = w[1]; o.z = w[2]; o.w = w[3];
        *(v4u*)(ACATC + (size_t)kp * 512 + ch * 8) = o;
    }
    {
        LAS float* sc = (LAS float*)L;
        for (int task = bx; task < 576; task += G) {
            const int ks = task / 72, cb = task % 72;
            __syncthreads();
            for (int e = tid; e < 128 * 33; e += 512) { const int kk = e / 33, b = e % 33; const int k = ks * 128 + kk;
                const float cv = b < 32 ? c_in[b * 1024 + k] : cctx_in[k]; sc[kk * 36 + b] = cv / (1.0f + expf(-cv)); }
            __syncthreads();
            const int j = cb * 512 + tid; const int l = j / MODW, jj = j % MODW;
            const float* wp = ada_w + ((size_t)l * 1024 + ks * 128) * MODW + jj;
            typedef float f32x2v __attribute__((ext_vector_type(2)));
            f32x2v a2[16]; float a32 = 0.f;
#pragma unroll
            for (int b = 0; b < 16; ++b) a2[b] = (f32x2v){0.f, 0.f};
            for (int k0 = 0; k0 < 128; k0 += 8) { float wv[8];
#pragma unroll
                for (int kq = 0; kq < 8; ++kq) wv[kq] = wp[(size_t)(k0 + kq) * MODW];
#pragma unroll
                for (int kq = 0; kq < 8; ++kq) { const f32x2v w2 = {wv[kq], wv[kq]}; const int kk = k0 + kq;
#pragma unroll
                    for (int q = 0; q < 8; ++q) { const f32x4 s = *(const LAS f32x4*)(sc + kk * 36 + 4 * q); a2[2 * q] += w2 * s.xy; a2[2 * q + 1] += w2 * s.zw; }
                    a32 += wv[kq] * sc[kk * 36 + 32]; } }
            float a[33];
#pragma unroll
            for (int b = 0; b < 16; ++b) { a[2 * b] = a2[b].x; a[2 * b + 1] = a2[b].y; }
            a[32] = a32;
#pragma unroll
            for (int b = 0; b < 33; ++b) MODP[((size_t)ks * 33 + b) * 36864 + j] = a[b];
        }
    }
    grid.sync();

    for (int idx = bx * 512 + fresh_tid(); idx < 33 * 36864; idx += NTHR) {
        const int b = idx / 36864, j = idx % 36864, l = j / MODW, jj = j % MODW;
        float s = ada_b[j];
#pragma unroll
        for (int ks = 0; ks < 8; ++ks) s += MODP[((size_t)ks * 33 + b) * 36864 + j];
        MOD[((size_t)l * 33 + b) * MODW + jj] = s;
        const int which = jj >> 10;
        if (which == 0 || which == 3 || which == 6) SH[((size_t)(l * 3 + which / 3) * 256 + b) * 1024 + (jj & 1023)] = (bf16)pg8::f2bf1(s);
    }
    GSYNC();
    {   pg8::Gemm g{SH, WGU, 12 * 256, 51200, 1024}; pg8::SwOrder S{G, bx, 0}; pg8::EpiSW E{SWT};
        pg8::gemm_phase<pg8::EpiSW, pg8::SwOrder, true, true>(L, g, S, E); }
    {   const int ft = fresh_tid(); const int ln = ft & 63;
        for (int row = vcu * 8 + __builtin_amdgcn_readfirstlane(ft >> 6); row < NROW; row += NGW) {
            const float* xr = row < NLAT ? x_in + (size_t)row * DMODEL : ctx_in + (size_t)(row - NLAT) * DMODEL;
            const int b = row < NLAT ? (row >> 11) : 32; const float* sc = MOD + (size_t)b * MODW + 1024;
            float s = 0.f; const int pmr = row >> 8, rlc = row & 255;
            v2u* o8 = (v2u*)(AB + ((size_t)(pmr * 16 + (ln >> 4)) * 256 + rlc) * 64 + 4 * (ln & 15)); unsigned char* l8 = LOP + ((size_t)(pmr * 4) * 256 + rlc) * 64 + ln;
#pragma unroll
            for (int j = 0; j < 4; ++j) { const f32x4 v = ((const f32x4*)xr)[ln + 64 * j]; s += (v.x * v.x + v.y * v.y) + (v.z * v.z + v.w * v.w);
                const f32x4 o = v * pg8::clamp_m(((const f32x4*)sc)[ln + 64 * j]); v2u w; w.x = pk2(o.x, o.y); w.y = pk2(o.z, o.w); o8[(size_t)j * 4 * 256 * 64 / 4] = w;
                const unsigned b0 = w.x << 16, b1 = w.x & 0xffff0000u, b2 = w.y << 16, b3 = w.y & 0xffff0000u;
                const unsigned w8 = pg8::lo2_enc(o.x, b0) | (pg8::lo2_enc(o.y, b1) << 2) | (pg8::lo2_enc(o.z, b2) << 4) | (pg8::lo2_enc(o.w, b3) << 6);
                l8[(size_t)j * 256 * 64] = (unsigned char)w8; }
            s = wave_sum(s); if (ln == 0) SSB[row] = s;
        }
    }
    GSYNC();

    }
    for (int l = 0; l < 4; ++l) {
        const bool last = (l == 3);
        const float* modl = MOD + (size_t)l * 33 * MODW;
        for (int f = 0; f < 2; ++f) {
            const bool first = (l == 0 && f == 0);
            const int nrows = (last && f == 1) ? NLAT : NROW;
            {   pg8::Gemm g{AB, WGU + (size_t)(l * 2 + f) * 5632 * 1024, nrows, 5632, 1024, 1}; pg8::StaticOrder S; S.init(nrows, 5632, G, bx);
                pg8::EpiGU E{HID, SSB + (size_t)(l * 3 + 2 * f) * NROW, SWT + (size_t)((l * 2 + f) * 22) * 33 * 256};
                { int b2 = blockIdx.x; asm volatile("" : "+s"(b2)); stagger(nrows == NROW ? (b2 < 96 ? 0 : b2 < 192 ? STG_GU : b2 < 224 ? STG_GU / 2 : STG_GU * 3 / 2) : (b2 < 128 ? 0 : STG_GU)); }
                pg8::gemm_phase<pg8::EpiGU, pg8::StaticOrder, true, true>(L, g, S, E);
#if PROBE == 1
                pg8::gemm_phase<pg8::EpiGU, pg8::StaticOrder, true, true>(L, g, S, E);
#endif
            }
            GSYNC();
            {   pg8::Gemm g{HID, WDN + (size_t)(l * 2 + f) * 1024 * 2816, nrows, 1024, 2816, 1}; pg8::StaticOrder S; S.init(nrows, 1024, G, bx);
                const float* dsc = modl + (f == 0 ? 1 : 7) * 1024;
                const float* nsc = f == 0 ? modl + 4 * 1024 : (last ? ZERO : modl + (size_t)33 * MODW + 1 * 1024);
                float* ssn = f == 0 ? SSB + (size_t)(l * 3 + 1) * NROW : SSB + (size_t)((l + 1) * 3) * NROW;
                pg8::EpiRes E{AB, LOP, modl + (f == 0 ? 2 : 8) * 1024, dsc, nsc, ssn, (LAS float*)(L + TAB_OFF), 0.5f, (f == 1 && last) ? 0 : MODW};
                { int b2 = blockIdx.x; asm volatile("" : "+s"(b2)); stagger(b2 < 128 ? 0 : STG_DN); }
                pg8::gemm_phase<pg8::EpiRes, pg8::StaticOrder, true, true>(L, g, S, E);
#if PROBE == 5
                pg8::EpiDummy ED{(float*)(ws + WS_SWT)};
                pg8::gemm_phase<pg8::EpiDummy, pg8::StaticOrder, true, true>(L, g, S, ED);
#endif
            }
            if (!last && bx >= (G >> 1)) {
                const int hb = G >> 1, nW = G - hb;
                const int ftt = fresh_tid(); const int lane_ = ftt & 63; const int wv = __builtin_amdgcn_readfirstlane(ftt >> 6);
                LAS float* scr = (LAS float*)(L + wv * 16384); const int Ln = l + 1;
                if (f == 0) { for (int k = (bx - hb) * 8 + wv; k < 2 * I_GU + I_IN; k += nW * 8) { const int it = k < 2 * I_GU ? Ln * 2 * I_GU + k : 8 * I_GU + 8 * I_DN + Ln * I_IN + (k - 2 * I_GU); TRANSPOSE_ITEM(it); }
                    LAS float* T64 = (LAS float*)(L + TAB_OFF) + 2048; __syncthreads(); if (ftt < 64) T64[ftt] = cospif((float)ftt * (1.0f / 32.0f)); __syncthreads();
                    for (int idx = Ln * 262144 + (bx - hb) * 512 + ftt; idx < (Ln + 1) * 262144; idx += nW * 512) FOLD_CH(idx); }
                else { for (int idx = Ln * 32768 + (bx - hb) * 512 + ftt; idx < (Ln + 1) * 32768; idx += nW * 512) { FOLD_POOL(idx); FOLD_FFT(idx); }
                    for (int k = (bx - hb) * 8 + wv; k < 2 * I_DN + I_OUT; k += nW * 8) { const int it = k < 2 * I_DN ? 8 * I_GU + Ln * 2 * I_DN + k : 8 * I_GU + 8 * I_DN + 4 * I_IN + Ln * I_OUT + (k - 2 * I_DN); TRANSPOSE_ITEM(it); }
                    __syncthreads();
                    pg8::Gemm g2{SH, WGU, 12 * 256, 51200, 1024}; pg8::SwOrder S2{nW, bx - hb, Ln}; pg8::EpiSW E2{SWT};
                    pg8::gemm_phase<pg8::EpiSW, pg8::SwOrder, true, true>(L, g2, S2, E2); }
            }
            GSYNC();
            if (f == 0) {
                {   pg8::Gemm g{AB, WIN + (size_t)l * 1536 * 1024, NROW, 1536, 1024, 1}; pg8::StaticOrder S; S.init(NROW, 1536, G, bx);
                    pg8::EpiIN E{QB_, KB_, VB_, UP, VT, VTC, q_gain + l * 64, k_gain + l * 64, ROPEC, ROPES, SSB + (size_t)(l * 3 + 1) * NROW, SWT + (size_t)(176 + l * 6) * 33 * 256};
                    pg8::gemm_phase<pg8::EpiIN, pg8::StaticOrder, true, true>(L, g, S, E);
#if PROBE == 3
                    pg8::gemm_phase<pg8::EpiIN, pg8::StaticOrder, true, true>(L, g, S, E);
#endif
                }
                GSYNC();
#if PROBE == 2
                for (int rep_ = 0; rep_ < 2; ++rep_) {
#else
                {
#endif
                for (int v = vcu; v < 256; v += G) {
                    const int p = v >> 2, s = v & 3, b = p >> 1, kvh = p & 1, h = 4 * kvh + s;
                    const attn_body::bf16* Kh = (const attn_body::bf16*)KB_ + (size_t)b * KVROWS * 128 + kvh * 64;
                    const attn_body::bf16* Vh = (const attn_body::bf16*)VB_ + (size_t)b * KVROWS * 128 + kvh * 64;
                    for (int qb = 0; qb < 8; ++qb) { const size_t r0 = (size_t)b * 2048 + qb * 256;
                        attn_body::attn_unit<8>((const attn_body::bf16*)QB_ + r0 * 512 + h * 64, Kh, Vh, (attn_body::bf16*)AB2 + r0 * 1024 + h * 64, 36, (char*)lds); }
                    if (!last) { const int cb = v >> 3, ch = v & 7; const size_t r0 = (size_t)NLAT + cb * 256;
                        const attn_body::bf16* Kc = (const attn_body::bf16*)KB_ + ((size_t)cb * KVROWS + 2048) * 128 + (ch >> 2) * 64;
                        const attn_body::bf16* Vc = (const attn_body::bf16*)VB_ + ((size_t)cb * KVROWS + 2048) * 128 + (ch >> 2) * 64;
                        attn_body::attn_unit<8>((const attn_body::bf16*)QB_ + r0 * 512 + ch * 64, Kc, Vc, (attn_body::bf16*)AB2 + r0 * 1024 + ch * 64, 4, (char*)lds); }
                }
                {   const int prow = last ? NLAT : NROW;
                    const int pskip = (!last && G > 64) ? 32 : 0;
                    for (int idx = (bx < pskip ? prow * 32 : (bx - pskip) * 512 + fresh_tid()); idx < prow * 32; idx += (G - pskip) * 512) {
                        const int p8 = prow * 8; const int g = __builtin_amdgcn_readfirstlane((idx >= p8) + (idx >= 2 * p8) + (idx >= 3 * p8)); const int rem = idx - g * p8; const int row = rem >> 3, c0 = g * 64 + (rem & 7) * 8, w2 = 1 << g, w = 2 << g;
                        int Ls, t; if (row < NLAT) { Ls = 2048; t = row & 2047; } else { Ls = 256; t = row & 255; }
                        const int base = row - t; const int lo = max(t - w2, 0), hi = min(t + w - w2, Ls);
                        float s[8];
#pragma unroll
                        for (int i = 0; i < 8; ++i) s[i] = 0.f;
                        v4u wq[16]; float wt[16];
#pragma unroll
                        for (int j = 0; j < 16; ++j) { wt[j] = 0.f; wq[j] = (v4u){0u, 0u, 0u, 0u}; if (j < w) { const int pos = t - w2 + j; const bool ok = pos >= 0 && pos < Ls; wt[j] = ok ? 1.0f : 0.0f; wq[j] = *(const v4u*)(UP + (size_t)(base + (ok ? pos : t)) * 256 + c0); } }
#pragma unroll
                        for (int j = 0; j < 16; ++j) if (j < w) { const v4u q = wq[j]; const float wj = wt[j];
                            s[0] += wj * __uint_as_float(q.x << 16); s[1] += wj * __uint_as_float(q.x & 0xffff0000u); s[2] += wj * __uint_as_float(q.y << 16); s[3] += wj * __uint_as_float(q.y & 0xffff0000u);
                            s[4] += wj * __uint_as_float(q.z << 16); s[5] += wj * __uint_as_float(q.z & 0xffff0000u); s[6] += wj * __uint_as_float(q.w << 16); s[7] += wj * __uint_as_float(q.w & 0xffff0000u); }
                        const v4u q = *(const v4u*)(UP + (size_t)row * 256 + c0); const float ic = 1.0f / (float)(hi - lo);
                        v4u o;
                        o.x = pk2(s[0] * ic - __uint_as_float(q.x << 16), s[1] * ic - __uint_as_float(q.x & 0xffff0000u));
                        o.y = pk2(s[2] * ic - __uint_as_float(q.y << 16), s[3] * ic - __uint_as_float(q.y & 0xffff0000u));
                        o.z = pk2(s[4] * ic - __uint_as_float(q.z << 16), s[5] * ic - __uint_as_float(q.z & 0xffff0000u));
                        o.w = pk2(s[6] * ic - __uint_as_float(q.w << 16), s[7] * ic - __uint_as_float(q.w & 0xffff0000u));
                        *(v4u*)(AB2 + (size_t)row * 1024 + 512 + c0) = o;
                    }
                }
                {   pg8::Gemm g{ACAT, VT, 2048, 8192, 4096}; pg8::StaticOrder S; S.init(2048, 8192, G, bx);
                    pg8::EpiDFT E{AB2, 0, 2048, 0.022097086912079608f};
                    pg8::gemm_phase<pg8::EpiDFT, pg8::StaticOrder, true, true>(L, g, S, E); }
                if (!last) { pg8::Gemm g{ACATC, VTC, 256, 8192, 512}; pg8::StaticOrder S; S.init(256, 8192, G, bx);
                    pg8::EpiDFT E{AB2, NLAT, 256, 0.0625f};
                    pg8::gemm_phase<pg8::EpiDFT, pg8::StaticOrder, true, true>(L, g, S, E); }
                }
                GSYNC();
                {   const int mrows = last ? NLAT : NROW;
                    pg8::Gemm g{AB2, WOUT + (size_t)l * 1024 * 1024, mrows, 1024, 1024}; pg8::StaticOrder S; S.init(mrows, 1024, G, bx);
                    pg8::EpiRes E{AB, LOP, modl + 5 * 1024, modl + 4 * 1024, modl + 7 * 1024, SSB + (size_t)(l * 3 + 2) * NROW, (LAS float*)(L + TAB_OFF), 1.0f, MODW};
                    { int b2 = blockIdx.x; asm volatile("" : "+s"(b2)); stagger(b2 < 128 ? 0 : STG_OUT); }
                    pg8::gemm_phase<pg8::EpiRes, pg8::StaticOrder, true, true>(L, g, S, E); }
                GSYNC();
            }
        }
    }
    const int ftf = fresh_tid(); const int lanef = ftf & 63;
    for (int row = vcu * 8 + __builtin_amdgcn_readfirstlane(ftf >> 6); row < NLAT; row += NGW) {
        const int pmr = row >> 8, rlc = row & 255;
        const v2u* hp = (const v2u*)(AB + ((size_t)(pmr * 16 + (lanef >> 4)) * 256 + rlc) * 64 + 4 * (lanef & 15)); const unsigned char* lp = LOP + ((size_t)(pmr * 4) * 256 + rlc) * 64 + lanef;
        f32x4 v[4]; float s = 0.f;
#pragma unroll
        for (int j = 0; j < 4; ++j) { const v2u h = hp[(size_t)j * 4 * 256 * 64 / 4]; const unsigned q = lp[(size_t)j * 256 * 64];
            const unsigned b0 = h.x << 16, b1 = h.x & 0xffff0000u, b2 = h.y << 16, b3 = h.y & 0xffff0000u;
            v[j].x = pg8::lo2_dec(b0, q & 0x3u); v[j].y = pg8::lo2_dec(b1, (q >> 2) & 0x3u); v[j].z = pg8::lo2_dec(b2, (q >> 4) & 0x3u); v[j].w = pg8::lo2_dec(b3, (q >> 6) & 0x3u);
            s += (v[j].x * v[j].x + v[j].y * v[j].y) + (v[j].z * v[j].z + v[j].w * v[j].w); }
        const float rstd = 1.0f / sqrtf(wave_sum(s) * (1.0f / DMODEL) + 1e-6f);
        f32x4* xr = (f32x4*)(args.out + (size_t)row * DMODEL);
#pragma unroll
        for (int j = 0; j < 4; ++j) { const f32x4 gv = ((const f32x4*)final_gain)[lanef + 64 * j]; xr[lanef + 64 * j] = v[j] * rstd * gv; }
    }
}

extern "C" void kernel_launch(void* const* d_in, const int* in_sizes, int n_in, void* d_out, int out_size, void* d_ws, size_t ws_size, hipStream_t stream) {
    static int grid = 0;
    if (grid == 0) {
        if (n_in != 18 || out_size != NLAT * DMODEL || ws_size < WS_END) { fprintf(stderr, "kernel_launch: unexpected shapes (n_in %d, out %d, ws %zu)\n", n_in, out_size, ws_size); grid = -1; return; }
        int dev = 0, cus = 0, per_cu = 0;
        hipGetDevice(&dev); hipDeviceGetAttribute(&cus, hipDeviceAttributeMultiprocessorCount, dev);
        hipFuncSetAttribute((const void*)fwd_mega, hipFuncAttributeMaxDynamicSharedMemorySize, LDS_BYTES);
        if (hipOccupancyMaxActiveBlocksPerMultiprocessor(&per_cu, (const void*)fwd_mega, 512, LDS_BYTES) != hipSuccess || per_cu < 1) { fprintf(stderr, "kernel_launch: occupancy query says %d\n", per_cu); per_cu = 1; }
        (void)hipGetLastError();
        grid = cus * (per_cu > 1 ? 1 : per_cu);
        if (grid <= 0) grid = 256;
    }
    if (grid < 0) return;
    if (hipMemsetAsync((char*)d_ws + WS_BAR, 0, 16384, stream) != hipSuccess) { fprintf(stderr, "kernel_launch: memset of the barrier words failed\n"); return; }
    Args a{};
    for (int i = 0; i < 18; ++i) a.in[i] = (const float*)d_in[i];
    a.out = (float*)d_out; a.ws = (unsigned char*)d_ws;
    void* params[] = {&a};
    hipError_t e = hipLaunchCooperativeKernel((const void*)fwd_mega, dim3(grid), dim3(512), params, LDS_BYTES, stream);
    if (e != hipSuccess) fprintf(stderr, "cooperative launch failed: %s (grid %d)\n", hipGetErrorString(e), grid);
}
```

```cpp
#include <hip/hip_runtime.h>
#include <hip/hip_cooperative_groups.h>
#include <hip/hip_bf16.h>
#include <cstdio>
#include <cstdint>
#include <cmath>
namespace cg = cooperative_groups;
constexpr int NLAT = 65536, NCTX = 8192, NROW = NLAT + NCTX, DMODEL = 1024, DFF = 2816, MODW = 9216, KVROWS = 2304;
constexpr float QC2 = 0.125f * 1.4426950408889634f;
__device__ __forceinline__ int fresh_tid() { int t = threadIdx.x; asm volatile("" : "+v"(t)); return t; }
namespace pg8 {
#define PG8_LAS __attribute__((address_space(3)))
typedef unsigned short bf16_t;
typedef short bf16x8 __attribute__((ext_vector_type(8)));
typedef float f32x4 __attribute__((ext_vector_type(4)));
typedef unsigned u32x4 __attribute__((ext_vector_type(4)));
constexpr int BM = 256, BK = 64, HALF = 128, HTB = HALF * BK * 2  , STAGE_BYTES = 8 * HTB, NXCD = 8, WGM = 8;

__host__ __device__ __forceinline__ int lds_byte(int r, int c) { const int st = (r >> 4) * 2 + (c >> 5), rr = r & 15, cc = c & 31, ob = rr * 64 + cc * 2; return st * 1024 + (ob ^ (((ob >> 9) & 1) << 5)); }
__host__ __device__ __forceinline__ void stage_rc(int b, int& R, int& C) { const int st = b / 1024, sb = b % 1024, swz = sb ^ (((sb >> 9) & 1) << 5); R = (st >> 1) * 16 + swz / 64; C = (st & 1) * 32 + (swz % 64) / 2; }
__host__ __device__ __forceinline__ int perm32(int rho) { const int n = rho >> 4, i = rho & 15; return 8 * (i >> 2) + 4 * n + (i & 3); }

struct Unit { int pm, pn; };
struct Gemm { const bf16_t* A; const bf16_t* Bt; int M, N, K; int ablk; };

struct StaticOrder {
    int nM, nN, nwg, G, c;
    __host__ __device__ void init(int M, int N, int G_, int c_) { nM = M / BM; nN = N / BM; nwg = nM * nN; G = G_; c = c_; }
    __host__ __device__ bool next(int i, Unit& u) const {
        const long L = (long)i * G + c; if (L >= nwg) return false;
        int wgid = (int)L; { const int q = nwg / NXCD, r = nwg % NXCD, xcd = wgid % NXCD, off = wgid / NXCD; wgid = (xcd < r ? xcd * (q + 1) : r * (q + 1) + (xcd - r) * q) + off; }
        const int nig = WGM * nN, gid = wgid / nig, fm = gid * WGM, gsz = (nM - fm) < WGM ? (nM - fm) : WGM;
        u.pm = fm + ((wgid % nig) % gsz); u.pn = (wgid % nig) / gsz; return true;
    }
    __device__ __forceinline__ void a_ready(const Unit&) const {}
    __device__ __forceinline__ void done(const Unit&) const {}
};

__device__ __forceinline__ unsigned cvt_pk_bf16(float lo, float hi) { unsigned r; asm volatile("v_cvt_pk_bf16_f32 %0, %1, %2" : "=v"(r) : "v"(lo), "v"(hi)); return r; }
typedef float f32x2 __attribute__((ext_vector_type(2)));
__device__ __forceinline__ unsigned f2bf1(float f) { unsigned u = __builtin_bit_cast(unsigned, f); return (u + 0x7fffu + ((u >> 16) & 1u)) >> 16; }
__device__ __forceinline__ float silu_f(float g) { return g * __builtin_amdgcn_rcpf(1.0f + __expf(-g)); }
struct EpiGU {
    static constexpr bool PERM = true, AFTER_DRAIN = false;
    bf16_t* H; const float* SS; const float* SWT;
    __device__ __forceinline__ void operator()(const f32x4 (&acc)[2][2][4][2], const Unit& u, int wr, int wc, int fr, int fq) const {
        asm volatile("" : "+v"(fr), "+v"(fq));
        const int row0 = u.pm * BM + wr * 64 + fr, col0 = u.pn * 128 + wc * 32 + 8 * fq;
        const int b = u.pm < 256 ? (u.pm >> 3) : 32;
        const float* swp = SWT + ((size_t)u.pn * 33 + b) * 256 + wc * 32 + 8 * fq;
        const f32x4 sg0 = *(const f32x4*)(swp), sg1 = *(const f32x4*)(swp + 4), su0 = *(const f32x4*)(swp + 128), su1 = *(const f32x4*)(swp + 132);
        float ssv[2][4];
#pragma unroll
        for (int ai = 0; ai < 2; ++ai)
#pragma unroll
            for (int m = 0; m < 4; ++m) ssv[ai][m] = SS[row0 + ai * HALF + m * 16];
#pragma unroll
        for (int ai = 0; ai < 2; ++ai)
#pragma unroll
            for (int m = 0; m < 4; ++m) {
                const float rs = __builtin_amdgcn_rsqf(ssv[ai][m] * (1.0f / 1024.0f) + 1e-6f);
                bf16_t* p = H + ((size_t)(u.pm * 44 + u.pn * 2 + (wc >> 1)) * 256 + (wr * 64 + fr + ai * HALF + m * 16)) * 64 + (wc & 1) * 32 + 8 * fq;
                const f32x2 rs2 = {rs, rs}; u32x4 w;
#define SILU2(G, U, SG, SU) ({ const f32x2 g_ = (G) * rs2 + (SG), u_ = (U) * rs2 + (SU); const f32x2 t_ = g_ * (-1.4426950408889634f); f32x2 d_; d_.x = __builtin_amdgcn_exp2f(t_.x); d_.y = __builtin_amdgcn_exp2f(t_.y); d_ = d_ + 1.0f; \
                    f32x2 r_; r_.x = __builtin_amdgcn_rcpf(d_.x); r_.y = __builtin_amdgcn_rcpf(d_.y); const f32x2 h_ = (g_ * u_) * r_; cvt_pk_bf16(h_.x, h_.y); })
                w.x = SILU2(acc[ai][0][m][0].xy, acc[ai][1][m][0].xy, sg0.xy, su0.xy); w.y = SILU2(acc[ai][0][m][0].zw, acc[ai][1][m][0].zw, sg0.zw, su0.zw);
                w.z = SILU2(acc[ai][0][m][1].xy, acc[ai][1][m][1].xy, sg1.xy, su1.xy); w.w = SILU2(acc[ai][0][m][1].zw, acc[ai][1][m][1].zw, sg1.zw, su1.zw);
#undef SILU2
                __builtin_nontemporal_store(w, (u32x4*)p);
            }
    }
};
__device__ __forceinline__ f32x4 clamp_m(f32x4 s) { f32x4 m = s + 1.0f;
#pragma unroll
    for (int e = 0; e < 4; ++e) m[e] = __builtin_fabsf(m[e]) < 1e-6f ? __builtin_copysignf(1e-6f, m[e]) : m[e];
    return m; }
typedef unsigned u32x2 __attribute__((ext_vector_type(2)));
__device__ __forceinline__ unsigned lo2_enc(float y, unsigned hb  ) { return ((__float_as_uint(y) - (hb + 0xffff8000u)) >> 14) & 0x3u; }
__device__ __forceinline__ float lo2_dec(unsigned hb  , unsigned f2) { return __uint_as_float((hb | (f2 << 14)) + 0xffffa000u); }
#define LO2_GET(lw_, p_) ((((p_) >= 7) ? ((lw_) >> (2 * (p_) - 14)) : ((lw_) << (14 - 2 * (p_)))) & 0xc000u)
#define LO2_PUT(t_, p_) ((((p_) <= 7) ? ((t_) >> (14 - 2 * (p_))) : ((t_) << (2 * (p_) - 14))) & (0x3u << (2 * (p_))))
struct EpiRes {
    static constexpr bool PERM = true, AFTER_DRAIN = false;
    bf16_t* HI; unsigned char* LO; const float* gate; const float* dsc; const float* nsc; float* SSn; PG8_LAS float* cst; float gs; int nstride;
    __device__ __forceinline__ void operator()(const f32x4 (&acc)[2][2][4][2], const Unit& u, int wr, int wc, int fr, int fq) const {
        asm volatile("" : "+v"(fr), "+v"(fq));
        const int pm = u.pm; const int b = pm < 256 ? (pm >> 3) : 32;
        const int rl = pm * BM + wr * 64 + fr, col0 = u.pn * BM + wc * 64 + 16 * fq;
        f32x4 gv[2][2], mev[2][2], rdv[2][2];
#pragma unroll
        for (int bj = 0; bj < 2; ++bj)
#pragma unroll
            for (int n = 0; n < 2; ++n) { gv[bj][n] = *(const f32x4*)(gate + (size_t)b * MODW + col0 + bj * 8 + n * 4) * gs;
                mev[bj][n] = clamp_m(*(const f32x4*)(nsc + (size_t)b * nstride + col0 + bj * 8 + n * 4));
                const f32x4 md = clamp_m(*(const f32x4*)(dsc + (size_t)b * MODW + col0 + bj * 8 + n * 4));
#pragma unroll
                for (int e = 0; e < 4; ++e) rdv[bj][n][e] = __builtin_amdgcn_rcpf(md[e]); }
        constexpr int PF = 1, NB = PF + 1;
        u32x4 RH[NB][2]; unsigned RL[NB];
        const int rloc0 = wr * 64 + fr; const size_t hib = ((size_t)(pm * 16 + u.pn * 4 + wc) * 256) * 64 + 16 * fq, lob = ((size_t)(pm * 4 + u.pn) * 256) * 64 + wc * 16 + 4 * fq;
#define HI_OFF(rloc_, bj_) (hib + (size_t)(rloc_) * 64 + (bj_) * 8)
#define LO_OFF(rloc_) (lob + (size_t)(rloc_) * 64)
#define RES_LOAD(slot, j_) do { const int rloc_ = rloc0 + ((j_) >> 2) * HALF + ((j_) & 3) * 16; \
            _Pragma("unroll") for (int bj = 0; bj < 2; ++bj) RH[slot][bj] = *(const u32x4*)(HI + HI_OFF(rloc_, bj)); RL[slot] = *(const unsigned*)(LO + LO_OFF(rloc_)); } while (0)
#pragma unroll
        for (int j = 0; j < PF; ++j) RES_LOAD(j % NB, j);
#pragma unroll
        for (int j = 0; j < 8; ++j) {
            if (j + PF < 8) RES_LOAD((j + PF) % NB, j + PF);
            asm volatile("" ::: "memory");
            const int ai = j >> 2, m = j & 3; const int r = rl + ai * HALF + m * 16; const int rloc = rloc0 + ai * HALF + m * 16;
            f32x2 ss2 = {0.f, 0.f}; unsigned wl = 0u;
#pragma unroll
            for (int bj = 0; bj < 2; ++bj) { u32x4 wh;
#pragma unroll
                for (int n = 0; n < 2; ++n) { const f32x4 me_ = mev[bj][n], rd_ = rdv[bj][n], gq = gv[bj][n], aq = acc[ai][bj][m][n];
                    const unsigned hw0 = RH[j % NB][bj][2 * n], hw1 = RH[j % NB][bj][2 * n + 1], lw = RL[j % NB];
                    f32x2 y01, y23;
                    y01.x = __uint_as_float(((hw0 << 16) | LO2_GET(lw, 8 * bj + 4 * n + 0)) + 0xffffa000u); y01.y = __uint_as_float(((hw0 & 0xffff0000u) | LO2_GET(lw, 8 * bj + 4 * n + 1)) + 0xffffa000u);
                    y23.x = __uint_as_float(((hw1 << 16) | LO2_GET(lw, 8 * bj + 4 * n + 2)) + 0xffffa000u); y23.y = __uint_as_float(((hw1 & 0xffff0000u) | LO2_GET(lw, 8 * bj + 4 * n + 3)) + 0xffffa000u);
                    const f32x2 o01 = y01 * rd_.xy + gq.xy * aq.xy, o23 = y23 * rd_.zw + gq.zw * aq.zw;
                    ss2 += o01 * o01; ss2 += o23 * o23;
                    y01 = o01 * me_.xy; y23 = o23 * me_.zw;
                    const unsigned h0 = cvt_pk_bf16(y01.x, y01.y), h1 = cvt_pk_bf16(y23.x, y23.y);
                    const unsigned t0 = __float_as_uint(y01.x) - ((h0 << 16) + 0xffff8000u), t1 = __float_as_uint(y01.y) - ((h0 & 0xffff0000u) + 0xffff8000u);
                    const unsigned t2 = __float_as_uint(y23.x) - ((h1 << 16) + 0xffff8000u), t3 = __float_as_uint(y23.y) - ((h1 & 0xffff0000u) + 0xffff8000u);
                    wh[2 * n] = h0; wh[2 * n + 1] = h1;
                    wl |= LO2_PUT(t0, 8 * bj + 4 * n + 0) | LO2_PUT(t1, 8 * bj + 4 * n + 1) | LO2_PUT(t2, 8 * bj + 4 * n + 2) | LO2_PUT(t3, 8 * bj + 4 * n + 3); }
                *(u32x4*)(HI + HI_OFF(rloc, bj)) = wh; }
            *(unsigned*)(LO + LO_OFF(rloc)) = wl;
            float ss = ss2.x + ss2.y;
            { ss += __shfl_xor(ss, 16); ss += __shfl_xor(ss, 32); if (fq == 0) unsafeAtomicAdd(SSn + r, ss); }
            asm volatile("" ::: "memory");
        }
#undef RES_LOAD
#undef HI_OFF
#undef LO_OFF
    }
};
struct EpiSW {
    static constexpr bool PERM = true, AFTER_DRAIN = false;
    float* SWT;
    __device__ __forceinline__ void operator()(const f32x4 (&acc)[2][2][4][2], const Unit& u, int wr, int wc, int fr, int fq) const {
        asm volatile("" : "+v"(fr), "+v"(fq));
        if (wr != 0) return;
#pragma unroll
        for (int m = 0; m < 3; ++m) { const int row = m * 16 + fr;
            if (row < 33) { float* p = SWT + ((size_t)u.pn * 33 + row) * 256 + wc * 32 + 8 * fq;
#pragma unroll
                for (int bj = 0; bj < 2; ++bj)
#pragma unroll
                    for (int n = 0; n < 2; ++n) *(f32x4*)(p + bj * HALF + 4 * n) = acc[0][bj][m][n]; } }
    }
};
struct SwOrder {
    int G, c, L;
    __device__ bool next(int i, Unit& u) const { const int j = i * G + c; if (c < 0 || j >= 50) return false; const int pn = j < 44 ? L * 44 + j : 176 + L * 6 + (j - 44); u.pn = pn;
        if (pn < 176) { const int mi = pn / 22; u.pm = (mi >> 1) * 3 + 2 * (mi & 1); } else u.pm = ((pn - 176) / 6) * 3 + 1; return true; }
    __device__ __forceinline__ void a_ready(const Unit&) const {}
    __device__ __forceinline__ void done(const Unit&) const {}
};
struct EpiIN {
    static constexpr bool PERM = true, AFTER_DRAIN = false;
    bf16_t *Q, *Kb, *Vb, *UP, *VT, *VTC; const float *qg, *kg, *ropeC, *ropeS; const float* SS; const float* SWT;
    __device__ __forceinline__ void operator()(const f32x4 (&acc)[2][2][4][2], const Unit& u, int wr, int wc, int fr, int fq) const {
        asm volatile("" : "+v"(fr), "+v"(fq));
        const int pn = u.pn, pm = u.pm; const bool lat = pm < 256;
        const int rbase = pm * BM + wr * 64 + fr;
        f32x4 sw[2][2]; float rsv[2][4];
        { const int b = lat ? (pm >> 3) : 32; const float* swp = SWT + ((size_t)pn * 33 + b) * 256 + wc * 32 + 8 * fq;
#pragma unroll
          for (int bj = 0; bj < 2; ++bj)
#pragma unroll
            for (int n = 0; n < 2; ++n) sw[bj][n] = *(const f32x4*)(swp + bj * HALF + 4 * n);
#pragma unroll
          for (int ai = 0; ai < 2; ++ai)
#pragma unroll
            for (int m = 0; m < 4; ++m) rsv[ai][m] = __builtin_amdgcn_rsqf(SS[rbase + ai * HALF + m * 16] * (1.0f / 1024.0f) + 1e-6f); }
#define ZV(ai, bj, m, n) (acc[ai][bj][m][n] * rsv[ai][m] + sw[bj][n])
        if (pn <= 2) {
            if (pn == 2 && wc >= 2) {
#pragma unroll
                for (int ai = 0; ai < 2; ++ai)
#pragma unroll
                    for (int m = 0; m < 4; ++m) { const int row = rbase + ai * HALF + m * 16;
                        const int kvrow = lat ? (row >> 11) * KVROWS + (row & 2047) : ((row - NLAT) >> 8) * KVROWS + 2048 + (row & 255);
                        bf16_t* p = Vb + (size_t)kvrow * 128 + (wc - 2) * 64 + 8 * fq;
#pragma unroll
                        for (int bj = 0; bj < 2; ++bj) { const f32x4 a = ZV(ai, bj, m, 0), c = ZV(ai, bj, m, 1); u32x4 w; w.x = cvt_pk_bf16(a[0], a[1]); w.y = cvt_pk_bf16(a[2], a[3]); w.z = cvt_pk_bf16(c[0], c[1]); w.w = cvt_pk_bf16(c[2], c[3]); *(u32x4*)(p + 32 * bj) = w; } }
            } else {
                const bool isq = pn < 2; const float* gp = isq ? qg : kg; const float osc = isq ? QC2 : 1.0f;
                f32x4 gn[2][2];
#pragma unroll
                for (int bj = 0; bj < 2; ++bj)
#pragma unroll
                    for (int n = 0; n < 2; ++n) gn[bj][n] = *(const f32x4*)(gp + 32 * bj + 8 * fq + 4 * n);
#pragma unroll
                for (int ai = 0; ai < 2; ++ai)
#pragma unroll
                    for (int m = 0; m < 4; ++m) { const int row = rbase + ai * HALF + m * 16;
                        float ss = 0.f;
#pragma unroll
                        for (int bj = 0; bj < 2; ++bj)
#pragma unroll
                            for (int n = 0; n < 2; ++n) { const f32x4 x = ZV(ai, bj, m, n); ss += (x[0] * x[0] + x[1] * x[1]) + (x[2] * x[2] + x[3] * x[3]); }
                        ss += __shfl_xor(ss, 16); ss += __shfl_xor(ss, 32);
                        const float rstd = __builtin_amdgcn_rsqf(ss * (1.0f / 64.0f) + 1e-6f);
                        f32x4 o1[2], o2[2];
#pragma unroll
                        for (int n = 0; n < 2; ++n) { o1[n] = ZV(ai, 0, m, n) * rstd * gn[0][n]; o2[n] = ZV(ai, 1, m, n) * rstd * gn[1][n]; }
                        if (lat) { const int t = row & 2047;
#pragma unroll
                            for (int n = 0; n < 2; ++n) { const f32x4 c = *(const f32x4*)(ropeC + t * 32 + 8 * fq + 4 * n), s = *(const f32x4*)(ropeS + t * 32 + 8 * fq + 4 * n);
                                const f32x4 a = o1[n] * c - o2[n] * s, bq = o1[n] * s + o2[n] * c; o1[n] = a; o2[n] = bq; } }
                        bf16_t* p;
                        if (isq) p = Q + (size_t)row * 512 + (4 * pn + wc) * 64 + 8 * fq;
                        else { const int kvrow = lat ? (row >> 11) * KVROWS + (row & 2047) : ((row - NLAT) >> 8) * KVROWS + 2048 + (row & 255); p = Kb + (size_t)kvrow * 128 + wc * 64 + 8 * fq; }
                        u32x4 w;
                        w.x = cvt_pk_bf16(o1[0][0] * osc, o1[0][1] * osc); w.y = cvt_pk_bf16(o1[0][2] * osc, o1[0][3] * osc); w.z = cvt_pk_bf16(o1[1][0] * osc, o1[1][1] * osc); w.w = cvt_pk_bf16(o1[1][2] * osc, o1[1][3] * osc);
                        *(u32x4*)p = w;
                        w.x = cvt_pk_bf16(o2[0][0] * osc, o2[0][1] * osc); w.y = cvt_pk_bf16(o2[0][2] * osc, o2[0][3] * osc); w.z = cvt_pk_bf16(o2[1][0] * osc, o2[1][1] * osc); w.w = cvt_pk_bf16(o2[1][2] * osc, o2[1][3] * osc);
                        *(u32x4*)(p + 32) = w; }
            }
        } else if (pn == 3) {
#pragma unroll
            for (int ai = 0; ai < 2; ++ai)
#pragma unroll
                for (int m = 0; m < 4; ++m) { const int row = rbase + ai * HALF + m * 16; bf16_t* p = UP + (size_t)row * 256 + wc * 32 + 8 * fq;
#pragma unroll
                    for (int bj = 0; bj < 2; ++bj) { const f32x4 a = ZV(ai, bj, m, 0), c = ZV(ai, bj, m, 1); u32x4 w; w.x = cvt_pk_bf16(a[0], a[1]); w.y = cvt_pk_bf16(a[2], a[3]); w.z = cvt_pk_bf16(c[0], c[1]); w.w = cvt_pk_bf16(c[2], c[3]); *(u32x4*)(p + HALF * bj) = w; } }
        } else {
            const int half = pn - 4;
#pragma unroll
            for (int ai = 0; ai < 2; ++ai)
#pragma unroll
                for (int m = 0; m < 4; ++m) { const int row = rbase + ai * HALF + m * 16;
                    if (lat) { const int b = row >> 11, t = row & 2047; bf16_t* p = VT + ((size_t)b * 256 + 32 * wc + 8 * fq) * 4096 + half * 2048 + t; asm volatile("" : "+v"(p)); __attribute__((address_space(1))) bf16_t* gp = (__attribute__((address_space(1))) bf16_t*)p;
#pragma unroll
                        for (int bj = 0; bj < 2; ++bj)
#pragma unroll
                            for (int n = 0; n < 2; ++n)
#pragma unroll
                                for (int e = 0; e < 4; ++e) gp[(size_t)(128 * bj + 4 * n + e) * 4096] = (bf16_t)f2bf1(ZV(ai, bj, m, n)[e]); }
                    else { const int b = (row - NLAT) >> 8, t = row & 255; bf16_t* p = VTC + ((size_t)b * 256 + 32 * wc + 8 * fq) * 512 + half * 256 + t; asm volatile("" : "+v"(p)); __attribute__((address_space(1))) bf16_t* gp = (__attribute__((address_space(1))) bf16_t*)p;
#pragma unroll
                        for (int bj = 0; bj < 2; ++bj)
#pragma unroll
                            for (int n = 0; n < 2; ++n)
#pragma unroll
                                for (int e = 0; e < 4; ++e) gp[(size_t)(128 * bj + 4 * n + e) * 512] = (bf16_t)f2bf1(ZV(ai, bj, m, n)[e]); } }
        }
    }
#undef ZV
};
struct EpiDFT {
    static constexpr bool PERM = true, AFTER_DRAIN = false;
    bf16_t* AM; int rowbase, L; float sc;
    __device__ __forceinline__ void operator()(const f32x4 (&acc)[2][2][4][2], const Unit& u, int wr, int wc, int fr, int fq) const {
        asm volatile("" : "+v"(fr), "+v"(fq));
        const int r0 = rowbase + u.pn * L + u.pm * BM + wr * 64 + fr;
#pragma unroll
        for (int ai = 0; ai < 2; ++ai)
#pragma unroll
            for (int m = 0; m < 4; ++m) { bf16_t* p = AM + (size_t)(r0 + ai * HALF + m * 16) * DMODEL + 768 + wc * 32 + 8 * fq;
#pragma unroll
                for (int bj = 0; bj < 2; ++bj) { const f32x4 a = acc[ai][bj][m][0] * sc, c = acc[ai][bj][m][1] * sc; u32x4 w; w.x = cvt_pk_bf16(a[0], a[1]); w.y = cvt_pk_bf16(a[2], a[3]); w.z = cvt_pk_bf16(c[0], c[1]); w.w = cvt_pk_bf16(c[2], c[3]); *(u32x4*)(p + HALF * bj) = w; } }
    }
};
struct EpiDummy {
    static constexpr bool PERM = true, AFTER_DRAIN = false;
    float* X;
    __device__ __forceinline__ void operator()(const f32x4 (&acc)[2][2][4][2], const Unit& u, int wr, int wc, int fr, int fq) const {
        f32x4 t = {0.f, 0.f, 0.f, 0.f};
#pragma unroll
        for (int ai = 0; ai < 2; ++ai)
#pragma unroll
            for (int bj = 0; bj < 2; ++bj)
#pragma unroll
                for (int m = 0; m < 4; ++m)
#pragma unroll
                    for (int n = 0; n < 2; ++n) t += acc[ai][bj][m][n];
        if (t[0] + t[1] + t[2] + t[3] == 12345.6789f) X[0] = 1.0f;
    }
};
template <class Epi, class Sched, bool ALIGN_EPI = false, bool SP2 = false>
__device__ __forceinline__ void gemm_phase(PG8_LAS unsigned char* lds, const Gemm g, const Sched& S, const Epi& E) {
    const int tid = fresh_tid(), wid = __builtin_amdgcn_readfirstlane(tid >> 6), lane = tid & 63, wr = wid >> 2, wc = wid & 3, fr = lane & 15, fq = lane >> 4;
    const int K = g.K, nt = K / BK;
    const int pitchA = g.ablk ? BK : K;
    unsigned voffA[2], voffB[2];
#pragma unroll
    for (int i = 0; i < 2; ++i) { int R, C; stage_rc(tid * 16 + i * 8192, R, C); const int Rb = Epi::PERM ? ((R & ~31) + perm32(R & 31)) : R;
        voffA[i] = (unsigned)(R * pitchA + C) * 2u; voffB[i] = (unsigned)(Rb * K + C) * 2u; }
    const size_t kstep = (size_t)(BK * 2);
    const size_t hstep = (size_t)HALF * K * 2;
    const size_t kstepA = g.ablk ? (size_t)BM * BK * 2 : kstep, hstepA = (size_t)HALF * pitchA * 2;
    const size_t tstep = 2 * hstep;
    const unsigned ldsw = (unsigned)wid * 1024u;
    const int aoff = lds_byte(wr * 64 + fr, fq * 8), boff = lds_byte(wc * 32 + fr, fq * 8);
#define PG8_SA(b, h) (((b) * 2 + (h)) * HTB)
#define PG8_SB(b, h) ((4 + (b) * 2 + (h)) * HTB)
#define PG8_STAGE(bufoff, gbase, voff) do { _Pragma("unroll") for (int _i = 0; _i < 2; ++_i) \
        __builtin_amdgcn_global_load_lds((const unsigned*)((const char*)(gbase) + (voff)[_i]), (PG8_LAS unsigned*)(lds + (bufoff) + ldsw + _i * 8192), 16, 0, 0); } while (0)
#define PG8_LDA(dst, b, h) do { _Pragma("unroll") for (int m = 0; m < 4; ++m) _Pragma("unroll") for (int k = 0; k < 2; ++k) dst[m][k] = *(const PG8_LAS bf16x8*)(lds + PG8_SA(b, h) + aoff + m * 2048 + k * 1024); } while (0)
#define PG8_LDB(dst, b, h) do { _Pragma("unroll") for (int n = 0; n < 2; ++n) _Pragma("unroll") for (int k = 0; k < 2; ++k) dst[n][k] = *(const PG8_LAS bf16x8*)(lds + PG8_SB(b, h) + boff + n * 2048 + k * 1024); } while (0)
#define PG8_MMA(ai, bj, At, Bt) do { __builtin_amdgcn_s_setprio(1); _Pragma("unroll") for (int m = 0; m < 4; ++m) _Pragma("unroll") for (int n = 0; n < 2; ++n) _Pragma("unroll") for (int k = 0; k < 2; ++k) \
        acc[ai][bj][m][n] = __builtin_amdgcn_mfma_f32_16x16x32_bf16(Bt[n][k], At[m][k], acc[ai][bj][m][n], 0, 0, 0); __builtin_amdgcn_s_setprio(0); } while (0)
#define PG8_WAIT_V(n) asm volatile("s_waitcnt vmcnt(" #n ")" ::: "memory")
#define PG8_WAIT_L(n) asm volatile("s_waitcnt lgkmcnt(" #n ")" ::: "memory")
#define PG8_BAR __builtin_amdgcn_s_barrier()
#define PG8_SCHED __builtin_amdgcn_sched_barrier(0)
    Unit cur, nxt; int ui = 0;
    if (!S.next(0, cur)) return;
    f32x4 acc[2][2][4][2];
#pragma unroll
    for (int a = 0; a < 2; ++a)
#pragma unroll
        for (int b = 0; b < 2; ++b)
#pragma unroll
            for (int m = 0; m < 4; ++m)
#pragma unroll
                for (int n = 0; n < 2; ++n) acc[a][b][m][n] = (f32x4){0.f, 0.f, 0.f, 0.f};
    bf16x8 At[4][2], B0[2][2], B1[2][2];
    const char* cA = (const char*)g.A + (size_t)cur.pm * tstep; const char* cB = (const char*)g.Bt + (size_t)cur.pn * tstep;
    S.a_ready(cur);
    if constexpr (SP2) {
        PG8_STAGE(PG8_SB(0, 0), cB, voffB); PG8_STAGE(PG8_SB(0, 1), cB + hstep, voffB); PG8_STAGE(PG8_SA(0, 0), cA, voffA); PG8_STAGE(PG8_SA(0, 1), cA + hstepA, voffA);
        if (wr == 1) PG8_BAR;
        PG8_WAIT_V(2); PG8_BAR;
        PG8_STAGE(PG8_SB(1, 0), cB + kstep, voffB); PG8_STAGE(PG8_SA(1, 0), cA + kstepA, voffA); PG8_STAGE(PG8_SB(1, 1), cB + hstep + kstep, voffB);
        PG8_WAIT_V(6); PG8_BAR;
    } else {
        PG8_STAGE(PG8_SB(0, 0), cB, voffB); PG8_STAGE(PG8_SA(0, 0), cA, voffA); PG8_STAGE(PG8_SB(0, 1), cB + hstep, voffB); PG8_STAGE(PG8_SA(0, 1), cA + hstepA, voffA);
        if (wr == 1) PG8_BAR;
        PG8_WAIT_V(4); PG8_BAR;
        PG8_STAGE(PG8_SB(1, 0), cB + kstep, voffB); PG8_STAGE(PG8_SA(1, 0), cA + kstepA, voffA); PG8_STAGE(PG8_SB(1, 1), cB + hstep + kstep, voffB);
        PG8_WAIT_V(6); PG8_BAR;
    }
    for (;;) {
        const bool has_next = S.next(ui + 1, nxt);
        const char* nA = has_next ? (const char*)g.A + (size_t)nxt.pm * tstep : cA; const char* nB = has_next ? (const char*)g.Bt + (size_t)nxt.pn * tstep : cB;
        for (int t = 0; t < nt; t += 2) {
            const bool last = (t == nt - 2);
            const char* a1 = cA + (size_t)(t + 1) * kstepA;
            const char* a2 = last ? nA : cA + (size_t)(t + 2) * kstepA; const char* b2 = last ? nB : cB + (size_t)(t + 2) * kstep;
            const char* a3 = a2 + kstepA; const char* b3 = b2 + kstep;
            if (last && has_next) S.a_ready(nxt);
            if constexpr (SP2) {
            PG8_LDB(B0, 0, 0); PG8_LDB(B1, 0, 1); PG8_SCHED; PG8_LDA(At, 0, 0); PG8_STAGE(PG8_SA(1, 1), a1 + hstepA, voffA);
            PG8_WAIT_V(8); PG8_WAIT_L(0); PG8_BAR; PG8_MMA(0, 0, At, B0); PG8_MMA(0, 1, At, B1); PG8_BAR; PG8_SCHED;
            PG8_LDA(At, 0, 1); PG8_STAGE(PG8_SB(0, 0), b2, voffB); PG8_STAGE(PG8_SB(0, 1), b2 + hstep, voffB); PG8_STAGE(PG8_SA(0, 0), a2, voffA);
            PG8_WAIT_V(8); PG8_WAIT_L(0); PG8_BAR; PG8_MMA(1, 0, At, B0); PG8_MMA(1, 1, At, B1); PG8_BAR; PG8_SCHED;
            PG8_LDB(B0, 1, 0); PG8_LDB(B1, 1, 1); PG8_SCHED; PG8_LDA(At, 1, 0); PG8_STAGE(PG8_SA(0, 1), a2 + hstepA, voffA);
            PG8_WAIT_V(8); PG8_WAIT_L(0); PG8_BAR; PG8_MMA(0, 0, At, B0); PG8_MMA(0, 1, At, B1); PG8_BAR; PG8_SCHED;
            PG8_LDA(At, 1, 1); PG8_STAGE(PG8_SB(1, 0), b3, voffB); PG8_STAGE(PG8_SB(1, 1), b3 + hstep, voffB); PG8_STAGE(PG8_SA(1, 0), a3, voffA);
            PG8_WAIT_V(8); PG8_WAIT_L(0); PG8_BAR; PG8_MMA(1, 0, At, B0); PG8_MMA(1, 1, At, B1); PG8_BAR; PG8_SCHED;
            } else {
            PG8_LDB(B0, 0, 0); PG8_SCHED; PG8_LDA(At, 0, 0); PG8_STAGE(PG8_SA(1, 1), a1 + hstepA, voffA);
            PG8_WAIT_L(8); PG8_BAR; PG8_WAIT_L(0); PG8_MMA(0, 0, At, B0); PG8_BAR; PG8_SCHED;
            PG8_LDB(B1, 0, 1); PG8_STAGE(PG8_SB(0, 0), b2, voffB);
            PG8_BAR; PG8_WAIT_L(0); PG8_MMA(0, 1, At, B1); PG8_BAR;
            PG8_LDA(At, 0, 1); PG8_STAGE(PG8_SA(0, 0), a2, voffA);
            PG8_BAR; PG8_WAIT_L(0); PG8_MMA(1, 0, At, B0); PG8_BAR; PG8_SCHED;
            PG8_STAGE(PG8_SB(0, 1), b2 + hstep, voffB);
            PG8_WAIT_V(6); PG8_BAR; PG8_MMA(1, 1, At, B1); PG8_BAR;
            PG8_LDB(B0, 1, 0); PG8_SCHED; PG8_LDA(At, 1, 0); PG8_STAGE(PG8_SA(0, 1), a2 + hstepA, voffA);
            PG8_WAIT_L(8); PG8_BAR; PG8_WAIT_L(0); PG8_MMA(0, 0, At, B0); PG8_BAR; PG8_SCHED;
            PG8_LDB(B1, 1, 1); PG8_STAGE(PG8_SB(1, 0), b3, voffB);
            PG8_BAR; PG8_WAIT_L(0); PG8_MMA(0, 1, At, B1); PG8_BAR;
            PG8_LDA(At, 1, 1); PG8_STAGE(PG8_SA(1, 0), a3, voffA);
            PG8_BAR; PG8_WAIT_L(0); PG8_MMA(1, 0, At, B0); PG8_BAR; PG8_SCHED;
            PG8_STAGE(PG8_SB(1, 1), b3 + hstep, voffB);
            PG8_WAIT_V(6); PG8_BAR; PG8_MMA(1, 1, At, B1); PG8_BAR;
            }
        }
        if constexpr (ALIGN_EPI) { if (wr == 0) PG8_BAR; }
        if constexpr (!Epi::AFTER_DRAIN) { E(acc, cur, wr, wc, fr, fq); S.done(cur); }
        if (!has_next) break;
#pragma unroll
        for (int a = 0; a < 2; ++a)
#pragma unroll
            for (int b = 0; b < 2; ++b)
#pragma unroll
                for (int m = 0; m < 4; ++m)
#pragma unroll
                    for (int n = 0; n < 2; ++n) acc[a][b][m][n] = (f32x4){0.f, 0.f, 0.f, 0.f};
        cur = nxt; cA = nA; cB = nB; ++ui;
        if constexpr (ALIGN_EPI) { if (wr == 1) PG8_BAR; }
    }
    PG8_WAIT_V(0);
    if constexpr (!ALIGN_EPI) { if (wr == 0) PG8_BAR; }
    PG8_BAR;
    if constexpr (Epi::AFTER_DRAIN) { E.fused(acc, cur, wr, wc, fr, fq, lds, wid, lane); S.done(cur); }
#undef PG8_SA
#undef PG8_SB
#undef PG8_STAGE
#undef PG8_LDA
#undef PG8_LDB
#undef PG8_MMA
#undef PG8_WAIT_V
#undef PG8_WAIT_L
#undef PG8_BAR
#undef PG8_SCHED
}
}
#include <hip/hip_bf16.h>
#include <cmath>
namespace attn_body {
using bf16=__hip_bfloat16;
using bf16x8=__attribute__((ext_vector_type(8)))short;
using s16x4=__attribute__((ext_vector_type(4)))short;
using f32x16=__attribute__((ext_vector_type(16)))float;
using u32x4=__attribute__((ext_vector_type(4)))unsigned;
constexpr int D=64,QP=512,KVP=128,OP=1024;
constexpr int NW=8,QBLK=32,QB=QBLK*NW,KVBLK=64;
__device__ __forceinline__ int crow(int r,int hi){return (r&3)+8*(r>>2)+4*hi;}
#define SBAR() __builtin_amdgcn_sched_barrier(0)
constexpr int NSLOT=3, SLOTB=8192;
constexpr int LDS_K=0, LDS_V=NSLOT*SLOTB, LDS_WS=2*NSLOT*SLOTB, LDS_OST=LDS_WS+NW*64*4, LDS_BYTES=LDS_OST+NW*4096;
constexpr float C2=0.125f*1.4426950408889634f;
__device__ __forceinline__ void glds16(const void*gsrc,unsigned lds_dst){unsigned keep;
  asm volatile("s_mov_b32 %0, m0\n\ts_mov_b32 m0, %2\n\ts_nop 0\n\tglobal_load_lds_dwordx4 %1, off\n\ts_mov_b32 m0, %0":"=&s"(keep):"v"(gsrc),"s"(lds_dst):"memory");}
__device__ __forceinline__ float max3f(float a,float b,float c){float r;asm("v_max3_f32 %0, %1, %2, %3":"=v"(r):"v"(a),"v"(b),"v"(c));return r;}
__device__ __forceinline__ float max2f(float a,float b){float r;asm("v_max_f32_e32 %0, %1, %2":"=v"(r):"v"(a),"v"(b));return r;}
__device__ __forceinline__ float fadd_s(float a,float b){float r;asm("v_add_f32_e32 %0, %1, %2":"=v"(r):"v"(a),"v"(b));return r;}
__device__ __forceinline__ float fsub_s(float a,float b){float r;asm("v_sub_f32_e32 %0, %1, %2":"=v"(r):"v"(a),"v"(b));return r;}
typedef float f32x2_t __attribute__((ext_vector_type(2))); typedef __bf16 bf16x2_t __attribute__((ext_vector_type(2)));
__device__ __forceinline__ unsigned cvtpk_s(float lo,float hi){f32x2_t v={lo,hi};bf16x2_t b=__builtin_convertvector(v,bf16x2_t);return __builtin_bit_cast(unsigned,b);}
#define WAIT_BAR(N) asm volatile("s_waitcnt vmcnt(" #N ") lgkmcnt(0)\n\ts_barrier":::"memory")

__device__ __forceinline__ void qkt(f32x16&p0,f32x16&p1,const char*Kslot,const bf16x8*qr,const f32x16&negm,int r32,int hi){
  const char*kb=Kslot+hi*1024+r32*16;
  #pragma unroll
  for(int d0=0;d0<4;++d0){
    const bf16x8 b0=*reinterpret_cast<const bf16x8*>(kb+d0*2048);
    const bf16x8 b1=*reinterpret_cast<const bf16x8*>(kb+d0*2048+512);
    if(d0==0){p0=__builtin_amdgcn_mfma_f32_32x32x16_bf16(b0,qr[0],negm,0,0,0);p1=__builtin_amdgcn_mfma_f32_32x32x16_bf16(b1,qr[0],negm,0,0,0);}
    else{p0=__builtin_amdgcn_mfma_f32_32x32x16_bf16(b0,qr[d0],p0,0,0,0);p1=__builtin_amdgcn_mfma_f32_32x32x16_bf16(b1,qr[d0],p1,0,0,0);}}
}
typedef __attribute__((address_space(3))) const char* lds_cptr;
typedef short v4i16_t __attribute__((ext_vector_type(4)));
__device__ __forceinline__ void kload8(bf16x8*kf,lds_cptr kp){
  kf[0]=*(const __attribute__((address_space(3))) bf16x8*)(kp);      kf[1]=*(const __attribute__((address_space(3))) bf16x8*)(kp+512);
  kf[2]=*(const __attribute__((address_space(3))) bf16x8*)(kp+2048); kf[3]=*(const __attribute__((address_space(3))) bf16x8*)(kp+2560);
  kf[4]=*(const __attribute__((address_space(3))) bf16x8*)(kp+4096); kf[5]=*(const __attribute__((address_space(3))) bf16x8*)(kp+4608);
  kf[6]=*(const __attribute__((address_space(3))) bf16x8*)(kp+6144); kf[7]=*(const __attribute__((address_space(3))) bf16x8*)(kp+6656);
}
__device__ __forceinline__ void kload2(bf16x8*kf,lds_cptr kp,int j){ kf[2*j]=*(const __attribute__((address_space(3))) bf16x8*)(kp+j*2048); kf[2*j+1]=*(const __attribute__((address_space(3))) bf16x8*)(kp+j*2048+512); }
__device__ __forceinline__ s16x4 vtr(lds_cptr p){ return __builtin_bit_cast(s16x4,__builtin_amdgcn_ds_read_tr16_b64_v4i16((__attribute__((address_space(3))) v4i16_t*)p)); }
__device__ __forceinline__ float rowmax(const f32x16&p0,const f32x16&p1){
  float a=max3f(p0[0],p0[1],p1[0]),b=max3f(p0[2],p0[3],p1[1]);a=max3f(a,p1[2],p1[3]);
  #pragma unroll
  for(int r=4;r<16;r+=4){a=max3f(a,p0[r],p0[r+1]);b=max3f(b,p0[r+2],p0[r+3]);a=max3f(a,p1[r],p1[r+1]);b=max3f(b,p1[r+2],p1[r+3]);}
  const float m=max2f(a,b);
  auto rr=__builtin_amdgcn_permlane32_swap(__float_as_uint(m),__float_as_uint(m),false,false);
  return max2f(__uint_as_float(rr[0]),__uint_as_float(rr[1]));
}
__device__ __forceinline__ void pv(f32x16*o,int vb,bf16x8 pa0,bf16x8 pa1,bf16x8 pa2,bf16x8 pa3){
  #pragma unroll
  for(int d0=0;d0<2;++d0){s16x4 lo[4],hi[4];
    #pragma unroll
    for(int ks=0;ks<4;++ks){
      asm volatile("ds_read_b64_tr_b16 %0,%1 offset:%c2":"=&v"(lo[ks]):"v"(vb),"i"(d0*4096+ks*1024):"memory");
      asm volatile("ds_read_b64_tr_b16 %0,%1 offset:%c2":"=&v"(hi[ks]):"v"(vb),"i"(d0*4096+ks*1024+512):"memory");}
    asm volatile("s_waitcnt lgkmcnt(0)":::"memory");SBAR();
    #define PK(k) (bf16x8){lo[k][0],lo[k][1],lo[k][2],lo[k][3],hi[k][0],hi[k][1],hi[k][2],hi[k][3]}
    o[d0]=__builtin_amdgcn_mfma_f32_32x32x16_bf16(pa0,PK(0),o[d0],0,0,0);
    o[d0]=__builtin_amdgcn_mfma_f32_32x32x16_bf16(pa1,PK(1),o[d0],0,0,0);
    o[d0]=__builtin_amdgcn_mfma_f32_32x32x16_bf16(pa2,PK(2),o[d0],0,0,0);
    o[d0]=__builtin_amdgcn_mfma_f32_32x32x16_bf16(pa3,PK(3),o[d0],0,0,0);
    #undef PK
  }
}

#ifndef ATTN_STORE16
#define ATTN_STORE16(p,v) (*(u32x4*)(p)=(v))
#endif
template<int THRL> __device__ __forceinline__ void attn_unit(const bf16*Qb,const bf16*Kh,const bf16*Vh,bf16*Ob,const int NT,char*shm){
  const int tid=fresh_tid(),lane=tid&63,r32=lane&31,hi=lane>>5; const int wid=__builtin_amdgcn_readfirstlane(tid>>6);
  const bf16*Qw=Qb+(long)(wid*QBLK)*QP;
  const unsigned lds0=(unsigned)(uintptr_t)shm;
  float*wsf=(float*)(shm+LDS_WS)+wid*64;
  const bf16*ksrc=Kh+(long)lane*KVP+wid*8;
  const bf16*vsrc=Vh+(long)(16*(wid&3)+(lane>>2))*KVP+(wid>>2)*32+(lane&3)*8;
  const unsigned kdst=lds0+LDS_K+wid*1024, vdst=lds0+LDS_V+wid*1024;
  #define DMA_K(t,slot) glds16(ksrc+(long)(t)*KVBLK*KVP,(unsigned)__builtin_amdgcn_readfirstlane(kdst+(slot)))
  #define DMA_V(t,slot) glds16(vsrc+(long)(t)*KVBLK*KVP,(unsigned)__builtin_amdgcn_readfirstlane(vdst+(slot)))
  const int vb0=(int)(lds0+LDS_V)+((lane>>4)&1)*32+(lane&3)*8+(4*hi+((lane&15)>>2))*64;
  const char*Kbase=shm+LDS_K; bf16x8 kf[8];
  const lds_cptr shm3=(lds_cptr)shm; const lds_cptr kp0=shm3+LDS_K+hi*1024+r32*16; const lds_cptr vp0=shm3+LDS_V+((lane>>4)&1)*32+(lane&3)*8+(4*hi+((lane&15)>>2))*64;
  DMA_K(0,0);DMA_V(0,0);DMA_K(1,SLOTB);
  bf16x8 qr[4];
  #pragma unroll
  for(int d0=0;d0<4;++d0)qr[d0]=*reinterpret_cast<const bf16x8*>(&Qw[(long)r32*QP+d0*16+hi*8]);
  float mhat=0.f,l_reg=0.f;f32x16 o[2];o[0]=f32x16{};o[1]=f32x16{};f32x16 negm=f32x16{};asm volatile("":"+v"(negm));
  const int qrel=wid*QBLK+r32;
  #define CMASK(P0,P1,t) do{}while(0)
  bool resc=false;
  #define START(P0,P1) do{ const float rm=rowmax(P0,P1); resc=false; \
    { const float dl=rm; mhat=fadd_s(mhat,dl); \
      _Pragma("unroll") for(int r=0;r<16;++r){P0[r]=fsub_s(P0[r],dl);P1[r]=fsub_s(P1[r],dl);} \
      _Pragma("unroll") for(int r=0;r<16;++r)negm[r]=-mhat; asm volatile("":"+v"(negm)); } \
    _Pragma("unroll") for(int r=0;r<16;++r)P0[r]=__builtin_amdgcn_exp2f(P0[r]); }while(0)
  #define RESC() do{ if(resc){ asm volatile("s_waitcnt lgkmcnt(0)":::"memory"); \
      _Pragma("unroll") for(int d_=0;d_<2;++d_) _Pragma("unroll") for(int r=0;r<16;++r)o[d_][r]*=wsf[crow(r,hi)]; } }while(0)
  f32x16 pA0,pA1,pB0,pB1;
  int sl_prev=0,sl_cur=0,sl_next=SLOTB;
  #define ROT() do{sl_prev=sl_cur;sl_cur=sl_next;sl_next=(sl_next==(NSLOT-1)*SLOTB)?0:sl_next+SLOTB;}while(0)
  DMA_K(2,2*SLOTB);
  WAIT_BAR(3);
  qkt(pA0,pA1,Kbase,qr,negm,r32,hi);asm volatile("s_nop 15\n\ts_nop 7":"+v"(pA0),"+v"(pA1));CMASK(pA0,pA1,0);
  START(pA0,pA1);
  _Pragma("unroll") for(int r=0;r<16;++r)pA1[r]=__builtin_amdgcn_exp2f(pA1[r]);
  WAIT_BAR(0);
  DMA_K(3,0);DMA_V(1,SLOTB);
  ROT();
  kload8(kf,kp0+sl_cur);
  WAIT_BAR(2);
  s16x4 vlo[8],vhi[8]; u32x4 pw0,pw1,pw2,pw3;
  #define PKW(P,B) cvtpk_s(P[B],P[B+1])
  #define PAF(k) __builtin_bit_cast(bf16x8,pw##k)
  #define VFR(i) (bf16x8){vlo[i][0],vlo[i][1],vlo[i][2],vlo[i][3],vhi[i][0],vhi[i][1],vhi[i][2],vhi[i][3]}
  #define PIN(x) asm volatile("":"+v"(x))
  #define MX3(a,b,c) __builtin_fmaxf(__builtin_fmaxf((a),(b)),(c))
  #define GAPA(MF,A0,A1,A2,A3,W0,W1,PW) do{ MF; sacc+=A0; sacc+=A1; sacc+=A2; sacc+=A3; PIN(sacc); W0; W1; PIN(PW); SBAR(); }while(0)
  #define EX(v) __builtin_amdgcn_exp2f(v)
  #define GAPB(MF,X,B) do{ MF; X[B]=EX(X[B]); X[B+1]=EX(X[B+1]); X[B+2]=EX(X[B+2]); X[B+3]=EX(X[B+3]); PIN(X); SBAR(); }while(0)
  #define VRD(i) do{ vlo[i]=vtr(vp_+(((i)>>2)*4096+((i)&3)*1024)); vhi[i]=vtr(vp_+(((i)>>2)*4096+((i)&3)*1024+512)); }while(0)
  #define KRD(G,j) do{ if(G){ kload2(kf,kp0+sl_next,j); SBAR(); } }while(0)
  #define STEP(C0,C1,P0,P1,t,GK,GV,GL) do{ SBAR(); \
    const lds_cptr vp_=vp0+sl_prev; \
    VRD(0); SBAR(); float sacc=(P0[0]+P0[1]); \
    GAPA(C0=__builtin_amdgcn_mfma_f32_32x32x16_bf16(kf[0],qr[0],negm,0,0,0), P0[2],P0[3],P0[4],P0[5],     pw0[0]=PKW(P0,0), pw0[1]=PKW(P0,2), pw0); \
    VRD(4); SBAR(); GAPA(C1=__builtin_amdgcn_mfma_f32_32x32x16_bf16(kf[1],qr[0],negm,0,0,0), P0[6],P0[7],P0[8],P0[9],     pw0[2]=PKW(P0,4), pw0[3]=PKW(P0,6), pw0); \
    VRD(1); SBAR(); GAPA(C0=__builtin_amdgcn_mfma_f32_32x32x16_bf16(kf[2],qr[1],C0,0,0,0),   P0[10],P0[11],P0[12],P0[13], pw1[0]=PKW(P0,8), pw1[1]=PKW(P0,10), pw1); \
    VRD(5); SBAR(); GAPA(C1=__builtin_amdgcn_mfma_f32_32x32x16_bf16(kf[3],qr[1],C1,0,0,0),   P0[14],P0[15],P1[0],P1[1],   pw1[2]=PKW(P0,12),pw1[3]=PKW(P0,14), pw1); \
    VRD(2); SBAR(); GAPA(C0=__builtin_amdgcn_mfma_f32_32x32x16_bf16(kf[4],qr[2],C0,0,0,0),   P1[2],P1[3],P1[4],P1[5],     pw2[0]=PKW(P1,0), pw2[1]=PKW(P1,2), pw2); \
    VRD(6); SBAR(); GAPA(C1=__builtin_amdgcn_mfma_f32_32x32x16_bf16(kf[5],qr[2],C1,0,0,0),   P1[6],P1[7],P1[8],P1[9],     pw2[2]=PKW(P1,4), pw2[3]=PKW(P1,6), pw2); \
    VRD(3); SBAR(); GAPA(C0=__builtin_amdgcn_mfma_f32_32x32x16_bf16(kf[6],qr[3],C0,0,0,0),   P1[10],P1[11],P1[12],P1[13], pw3[0]=PKW(P1,8), pw3[1]=PKW(P1,10), pw3); \
    VRD(7); SBAR(); GAPA(C1=__builtin_amdgcn_mfma_f32_32x32x16_bf16(kf[7],qr[3],C1,0,0,0),   P1[14],P1[15],0.f,0.f,       pw3[2]=PKW(P1,12),pw3[3]=PKW(P1,14), pw3); \
    l_reg+=sacc; \
    if(GK){DMA_K((t)+3,sl_cur);} if(GV){DMA_V((t)+1,sl_next);} \
    CMASK(C0,C1,t); \
    { float a=MX3(C0[0],C0[1],C1[0]),b=MX3(C0[2],C0[3],C1[1]); a=MX3(a,C1[2],C1[3]); \
      _Pragma("unroll") for(int r=4;r<16;r+=4){a=MX3(a,C0[r],C0[r+1]);b=MX3(b,C0[r+2],C0[r+3]);a=MX3(a,C1[r],C1[r+1]);b=MX3(b,C1[r+2],C1[r+3]);} \
      float rm=__builtin_fmaxf(a,b); { auto rr=__builtin_amdgcn_permlane32_swap(__float_as_uint(rm),__float_as_uint(rm),false,false); rm=__builtin_fmaxf(__uint_as_float(rr[0]),__uint_as_float(rr[1])); } \
      resc=false; \
      if(__builtin_expect(__any(rm>(float)THRL),0)){ const float dl=__builtin_fmaxf(rm,0.f); mhat+=dl; \
        _Pragma("unroll") for(int r=0;r<16;++r){C0[r]-=dl;C1[r]-=dl;} \
        _Pragma("unroll") for(int r=0;r<16;++r)negm[r]=-mhat; asm volatile("":"+v"(negm)); \
        const float f=__builtin_amdgcn_exp2f(-dl); l_reg*=f; if(hi==0)wsf[r32]=f; resc=true; } } \
    SBAR(); \
    GAPB(o[0]=__builtin_amdgcn_mfma_f32_32x32x16_bf16(PAF(0),VFR(0),o[0],0,0,0), C0,0); \
    GAPB(o[1]=__builtin_amdgcn_mfma_f32_32x32x16_bf16(PAF(0),VFR(4),o[1],0,0,0), C0,4); \
    KRD(GL,0); GAPB(o[0]=__builtin_amdgcn_mfma_f32_32x32x16_bf16(PAF(1),VFR(1),o[0],0,0,0), C0,8); \
    KRD(GL,1); GAPB(o[1]=__builtin_amdgcn_mfma_f32_32x32x16_bf16(PAF(1),VFR(5),o[1],0,0,0), C0,12); \
    KRD(GL,2); GAPB(o[0]=__builtin_amdgcn_mfma_f32_32x32x16_bf16(PAF(2),VFR(2),o[0],0,0,0), C1,0); \
    KRD(GL,3); GAPB(o[1]=__builtin_amdgcn_mfma_f32_32x32x16_bf16(PAF(2),VFR(6),o[1],0,0,0), C1,4); \
    GAPB(o[0]=__builtin_amdgcn_mfma_f32_32x32x16_bf16(PAF(3),VFR(3),o[0],0,0,0), C1,8); \
    GAPB(o[1]=__builtin_amdgcn_mfma_f32_32x32x16_bf16(PAF(3),VFR(7),o[1],0,0,0), C1,12); \
    }while(0)
  int t=1;
  #undef CMASK
  #define CMASK(P0,P1,t) do{}while(0)
  for(;t+5<NT;t+=2){
    STEP(pB0,pB1,pA0,pA1,t,true,true,true);     WAIT_BAR(2); RESC(); ROT();
    STEP(pA0,pA1,pB0,pB1,t+1,true,true,true);   WAIT_BAR(2); RESC(); ROT();
  }
  #undef CMASK
  #define CMASK(P0,P1,t) do{}while(0)
  #define ENDW(tt) do{ if((tt)+3<NT){WAIT_BAR(2);} else if((tt)+2<NT){WAIT_BAR(1);} else {WAIT_BAR(0);} }while(0)
  for(;t+1<NT;t+=2){
    STEP(pB0,pB1,pA0,pA1,t,(t+3<NT),(t+1<NT),(t+1<NT));       ENDW(t);   RESC(); ROT();
    STEP(pA0,pA1,pB0,pB1,t+1,(t+4<NT),(t+2<NT),(t+2<NT));     ENDW(t+1); RESC(); ROT();
  }
  STEP(pB0,pB1,pA0,pA1,NT-1,false,false,false); RESC();
  { float sacc=pB0[0]+pB0[1]; _Pragma("unroll") for(int r=2;r<16;++r)sacc+=pB0[r]; _Pragma("unroll") for(int r=0;r<16;++r)sacc+=pB1[r]; l_reg+=sacc;
    pw0=(u32x4){PKW(pB0,0),PKW(pB0,2),PKW(pB0,4),PKW(pB0,6)};pw1=(u32x4){PKW(pB0,8),PKW(pB0,10),PKW(pB0,12),PKW(pB0,14)};pw2=(u32x4){PKW(pB1,0),PKW(pB1,2),PKW(pB1,4),PKW(pB1,6)};pw3=(u32x4){PKW(pB1,8),PKW(pB1,10),PKW(pB1,12),PKW(pB1,14)};
    SBAR(); pv(o,vb0+sl_cur,PAF(0),PAF(1),PAF(2),PAF(3)); }
  #undef PKW
  #undef PAF
  #undef VFR
  #undef PIN
  #undef MX3
  #undef GAPA
  #undef GAPB
  #undef EX
  #undef VRD
  #undef KRD
  #undef STEP
  #undef ENDW
  {auto rr=__builtin_amdgcn_permlane32_swap(__float_as_uint(l_reg),__float_as_uint(l_reg),false,false);l_reg=__uint_as_float(rr[0])+__uint_as_float(rr[1]);}
  if(hi==0)wsf[32+r32]=l_reg;asm volatile("s_waitcnt lgkmcnt(0)":::"memory");
  float rli[16];
  #pragma unroll
  for(int r=0;r<16;++r)rli[r]=__builtin_amdgcn_rcpf(wsf[32+crow(r,hi)]);
  bf16*Ow=Ob+(long)(wid*QBLK)*OP;
  { bf16*stg=(bf16*)(shm+LDS_OST)+wid*2048;
    #pragma unroll
    for(int r=0;r<16;++r){const int orow=crow(r,hi);
      #pragma unroll
      for(int d0=0;d0<2;++d0)stg[orow*64+d0*32+r32]=__float2bfloat16(o[d0][r]*rli[r]);}
    asm volatile("s_waitcnt lgkmcnt(0)":::"memory");
    #pragma unroll
    for(int i=0;i<4;++i){const int row=i*8+(lane>>3),ch=lane&7; const u32x4 v=*(const u32x4*)(stg+row*64+ch*8); ATTN_STORE16(Ow+(long)row*OP+ch*8,v);} }
  asm volatile("s_waitcnt lgkmcnt(0)\n\ts_barrier":::"memory");
  #undef DMA_K
  #undef DMA_V
  #undef CMASK
  #undef START
  #undef RESC
  #undef ROT
}
constexpr int ATTN_LDS_BYTES=LDS_BYTES;
#undef SBAR
#undef WAIT_BAR
}
#define LAS __attribute__((address_space(3)))
typedef unsigned short bf16;
typedef float f32x4 __attribute__((ext_vector_type(4)));
typedef unsigned v4u __attribute__((ext_vector_type(4)));
typedef unsigned v2u __attribute__((ext_vector_type(2)));
constexpr size_t MiB = 1u << 20;
constexpr size_t WS_MOD = 1 * MiB;
constexpr size_t WS_ROPE = 6 * MiB;
constexpr size_t WS_ACAT = 7 * MiB;
constexpr size_t WS_ACATC = 23 * MiB;
constexpr size_t WS_WGU = 24 * MiB;
constexpr size_t WS_WIN = 112 * MiB;
constexpr size_t WS_WDN = 124 * MiB;
constexpr size_t WS_WOUT = 168 * MiB;
constexpr size_t WS_ZERO = 0;
constexpr size_t WS_A = 176 * MiB;
constexpr size_t WS_HID = 320 * MiB;
constexpr size_t WS_Q = WS_HID;
constexpr size_t WS_K = WS_HID + 72 * MiB;
constexpr size_t WS_V = WS_HID + 90 * MiB;
constexpr size_t WS_UP = WS_HID + 108 * MiB;
constexpr size_t WS_VT = WS_HID + 144 * MiB;
constexpr size_t WS_VTC = WS_HID + 208 * MiB;
constexpr size_t WS_VTF = WS_HID + 216 * MiB;
constexpr size_t WS_MODP = WS_HID;
constexpr size_t WS_A2 = 716 * MiB;
constexpr size_t WS_SS = 860 * MiB;
constexpr size_t WS_SH = 864 * MiB;
constexpr size_t WS_SWT = 870 * MiB;
constexpr size_t WS_LO = 878 * MiB;
constexpr size_t WS_END = 950 * MiB;
constexpr int LDS_BYTES = 147456, TAB_OFF = 131072;

#define XB_TMO      128
#define XB_XCNT(j)  (256  + 64 * (j))
#define XB_XSUB(j)  (1280 + 64 * (j))
#define XB_XGEN(j)  (2304 + 64 * (j))
#define XB_TOP      3328
#define XB_TOPGEN   3392
#define XCD_BAR_WORDS 3456
#define XB_SPIN_CAP (1u << 18)

__device__ __forceinline__ unsigned xb_ld(unsigned* p)              { return __hip_atomic_load(p, __ATOMIC_RELAXED, __HIP_MEMORY_SCOPE_AGENT); }
__device__ __forceinline__ unsigned xb_add(unsigned* p, unsigned v) { return __hip_atomic_fetch_add(p, v, __ATOMIC_RELAXED, __HIP_MEMORY_SCOPE_AGENT); }
__device__ __forceinline__ unsigned xb_xcc_id() { return (unsigned)__builtin_amdgcn_s_getreg((3 << 11) | 20) & 0xFu; }
#define XB_SPIN(cond, bar) do { unsigned _sp = 0; while (cond) { __builtin_amdgcn_s_sleep(1); \
    if ((++_sp & 255u) == 0u) { if (xb_ld(&(bar)[XB_TMO])) break; if (_sp > XB_SPIN_CAP) { atomicAdd(&(bar)[XB_TMO], 1u); break; } } } } while (0)

struct XcdBarrier {
    unsigned* bar; unsigned x;
    volatile LAS unsigned* st;
};

__device__ __forceinline__ XcdBarrier xcd_barrier_post(unsigned* bar, volatile LAS unsigned* st) {
    XcdBarrier b; b.bar = bar; b.x = xb_xcc_id(); b.st = st;
    if (threadIdx.x == 0) (void)xb_add(&bar[XB_XCNT(b.x)], 1u);
    return b;
}
__device__ __forceinline__ void xcd_barrier_complete(unsigned* bar, unsigned x, unsigned& nloc, unsigned& nx) {
    const unsigned G = gridDim.x * gridDim.y * gridDim.z;
    unsigned sum, cnt, mine, sp = 0u;
    for (;;) {
        sum = 0u; cnt = 0u; mine = 0u;
#pragma unroll
        for (unsigned j = 0; j < 16; ++j) { const unsigned c = xb_ld(&bar[XB_XCNT(j)]); sum += c; cnt += (c > 0u) ? 1u : 0u; mine = (j == x) ? c : mine; }
        if (sum == G) break;
        __builtin_amdgcn_s_sleep(1);
        if ((++sp & 255u) == 0u) { if (xb_ld(&bar[XB_TMO])) break; if (sp > XB_SPIN_CAP) { atomicAdd(&bar[XB_TMO], 1u); break; } }
    }
    nloc = mine > 0u ? mine : 1u; nx = cnt > 0u ? cnt : 1u;
}

__device__ __forceinline__ void xcd_barrier(const XcdBarrier& b) {
    asm volatile("s_waitcnt vmcnt(0)" ::: "memory");
    __syncthreads();
    if (threadIdx.x == 0) {
        unsigned* bar = b.bar;
        __builtin_amdgcn_s_waitcnt(0);
        unsigned nloc = b.st[0], nx = b.st[1];
        if (nloc == 0u) { xcd_barrier_complete(bar, b.x, nloc, nx); b.st[0] = nloc; b.st[1] = nx; }
        const unsigned old = xb_add(&bar[XB_XSUB(b.x)], 1u);
        const unsigned gen = old / nloc;
        if (old + 1u == (gen + 1u) * nloc) {
            __builtin_amdgcn_fence(__ATOMIC_RELEASE, "agent");
            asm volatile("s_waitcnt vmcnt(0)" ::: "memory");
            const unsigned og = xb_add(&bar[XB_TOP], 1u);
            const unsigned tg = og / nx;
            if (og + 1u == (tg + 1u) * nx) xb_add(&bar[XB_TOPGEN], 1u);
            else XB_SPIN(xb_ld(&bar[XB_TOPGEN]) == tg, bar);
            __builtin_amdgcn_fence(__ATOMIC_ACQUIRE, "agent");
            xb_add(&bar[XB_XGEN(b.x)], 1u);
            asm volatile("s_waitcnt vmcnt(0)" ::: "memory");
        } else {
            XB_SPIN(xb_ld(&bar[XB_XGEN(b.x)]) == gen, bar);
            __builtin_amdgcn_fence(__ATOMIC_ACQUIRE, "agent");
            asm volatile("s_waitcnt vmcnt(0)" ::: "memory");
        }
    }
    __syncthreads();
}

#ifndef PROBE
#define PROBE 0
#endif
#if PROBE == 6
#define GSYNC() do { xcd_barrier(mk_xbar(args.ws, L)); xcd_barrier(mk_xbar(args.ws, L)); } while (0)
#else
#define GSYNC() xcd_barrier(mk_xbar(args.ws, L))
#endif
constexpr size_t WS_BAR = 65536;
constexpr int XB_LDS_OFF = TAB_OFF + 12288;
__device__ __forceinline__ XcdBarrier mk_xbar(unsigned char* ws, LAS unsigned char* L) { asm volatile("" : "+s"(ws)); XcdBarrier b; b.bar = (unsigned*)(ws + WS_BAR); b.x = xb_xcc_id(); b.st = (volatile LAS unsigned*)(L + XB_LDS_OFF); return b; }
struct Args { const float* in[18]; float* out; unsigned char* ws; };
constexpr int I_GU = 16 * 176, I_DN = 44 * 32, I_IN = 16 * 32, I_OUT = 8 * 32;

__device__ __forceinline__ void stagger(int ticks) {
    if (ticks > 0) { const unsigned long long t0 = __builtin_amdgcn_s_memrealtime(); while ((long long)(__builtin_amdgcn_s_memrealtime() - t0) < (long long)ticks) __builtin_amdgcn_s_sleep(8); }
}
#ifndef STG_GU
#define STG_GU 0
#endif
#ifndef STG_DN
#define STG_DN 0
#endif
#ifndef STG_OUT
#define STG_OUT 0
#endif
__device__ __forceinline__ float wave_sum(float v) {
#pragma unroll
    for (int o = 1; o < 64; o <<= 1) v += __shfl_xor(v, o);
    return v;
}
__device__ __forceinline__ unsigned pk2(float lo, float hi) { return pg8::cvt_pk_bf16(lo, hi); }
__device__ __forceinline__ int map_row(int mode, int n) {
    if (mode == 0) return n;
    if (mode == 3) return 256 * (n >> 8) + 128 * ((n >> 3) & 1) + 32 * ((n >> 6) & 3) + 8 * ((n >> 4) & 3) + (n & 7);
    if (mode == 1) { const int isu = n >= DFF ? 1 : 0; const int j = n - isu * DFF; return 256 * (j >> 7) + 128 * isu + (j & 127); }
    if (n < 512) { const int h = n >> 6, d = n & 63; return 256 * (h >> 2) + 128 * (d >> 5) + 32 * (h & 3) + (d & 31); }
    if (n < 768) { const int wc = (n - 512) >> 6, d = n & 63; return 512 + 128 * (d >> 5) + 32 * wc + (d & 31); }
    return n;
}
__device__ __forceinline__ void transpose_item(const float* W, int ldw, bf16* WT, int ldt, int mode, LAS float* scr, int kb, int nb, int lane) {
    const int k0 = 64 * kb, n0 = 32 * nb;
#pragma unroll 8
    for (int i = 0; i < 32; ++i) { const int kk = 2 * i + (lane >> 5); scr[kk * 33 + (lane & 31)] = W[(size_t)(k0 + kk) * ldw + n0 + (lane & 31)]; }
    asm volatile("s_waitcnt lgkmcnt(0)" ::: "memory");
    const int c = lane & 7;
#pragma unroll
    for (int j = 0; j < 4; ++j) { const int n = (lane >> 3) + 8 * j; const LAS float* s = scr + (8 * c) * 33 + n;
        v4u o; o.x = pk2(s[0 * 33], s[1 * 33]); o.y = pk2(s[2 * 33], s[3 * 33]); o.z = pk2(s[4 * 33], s[5 * 33]); o.w = pk2(s[6 * 33], s[7 * 33]);
        *(v4u*)(WT + (size_t)map_row(mode, n0 + n) * ldt + k0 + 8 * c) = o; }
    asm volatile("s_waitcnt lgkmcnt(0)" ::: "memory");
}
__device__ __forceinline__ void norm_rows(const float* srcL, const float* srcC, bf16* A, const float* modl, int sidx, int nrows, int gw_, int NGW) {
    const int ft = fresh_tid(); const int lane = ft & 63; const int gw = gw_ + __builtin_amdgcn_readfirstlane(ft >> 6);
    for (int row = gw; row < nrows; row += NGW) {
        const float* xr = row < NLAT ? srcL + (size_t)row * DMODEL : srcC + (size_t)(row - NLAT) * DMODEL;
        const int b = row < NLAT ? (row >> 11) : 32;
        const float* sh = modl + (size_t)b * MODW + sidx * 1024; const float* sc = sh + 1024;
        f32x4 v[4]; float s = 0.f;
#pragma unroll
        for (int j = 0; j < 4; ++j) { v[j] = ((const f32x4*)xr)[lane + 64 * j]; s += (v[j].x * v[j].x + v[j].y * v[j].y) + (v[j].z * v[j].z + v[j].w * v[j].w); }
        const float rstd = 1.0f / sqrtf(wave_sum(s) * (1.0f / DMODEL) + 1e-6f);
        v2u* o8 = (v2u*)(A + (size_t)row * DMODEL) + lane;
#pragma unroll
        for (int j = 0; j < 4; ++j) { const f32x4 shv = ((const f32x4*)sh)[lane + 64 * j], scv = ((const f32x4*)sc)[lane + 64 * j];
            const f32x4 o = v[j] * rstd * (scv + 1.0f) + shv; v2u w; w.x = pk2(o.x, o.y); w.y = pk2(o.z, o.w); o8[64 * j] = w; }
    }
}

__global__ void __launch_bounds__(512, 2) fwd_mega(Args args) {
    extern __shared__ __attribute__((aligned(16))) unsigned char lds[];
    cg::grid_group grid = cg::this_grid();
    LAS unsigned char* L = (LAS unsigned char*)lds;
    const int tid = threadIdx.x, lane = tid & 63, wave = __builtin_amdgcn_readfirstlane(tid >> 6);
    const int G = gridDim.x, bx = blockIdx.x; const int vcu = (G % 8 == 0) ? (bx % 8) * (G / 8) + bx / 8 : bx;
    const int gw = vcu * 8 + wave, NGW = G * 8; const int gtid = bx * 512 + tid, NTHR = G * 512;
    unsigned char* ws = args.ws;
    if (tid < 2) ((volatile LAS unsigned*)(L + XB_LDS_OFF))[tid] = 0u;
    __syncthreads();
    (void)xcd_barrier_post((unsigned*)(ws + WS_BAR), (volatile LAS unsigned*)(L + XB_LDS_OFF));
    const float* x_in = args.in[0]; const float* c_in = args.in[1]; const float* ctx_in = args.in[2]; const float* cctx_in = args.in[3];
    const float* ada_w = args.in[4]; const float* ada_b = args.in[5];
    const float* w_in = args.in[8]; const float* q_gain = args.in[9]; const float* k_gain = args.in[10];
    const float* pool_w = args.in[11]; const float* pool_scale = args.in[12]; const float* fft_w = args.in[13]; const float* w_out = args.in[14];
    const float* final_gain = args.in[17];
    float* ZERO = (float*)(ws + WS_ZERO); unsigned char* LOP = ws + WS_LO;
    float* MOD = (float*)(ws + WS_MOD); float* MODP = (float*)(ws + WS_MODP);
    float* ROPEC = (float*)(ws + WS_ROPE); float* ROPES = ROPEC + 2048 * 32;
    bf16* ACAT = (bf16*)(ws + WS_ACAT); bf16* ACATC = (bf16*)(ws + WS_ACATC);
    bf16* WGU = (bf16*)(ws + WS_WGU); bf16* WDN = (bf16*)(ws + WS_WDN); bf16* WIN = (bf16*)(ws + WS_WIN); bf16* WOUT = (bf16*)(ws + WS_WOUT);
    bf16* AB = (bf16*)(ws + WS_A); bf16* AB2 = (bf16*)(ws + WS_A2); bf16* HID = (bf16*)(ws + WS_HID);
    float* SSB = (float*)(ws + WS_SS); bf16* SH = (bf16*)(ws + WS_SH); float* SWT = (float*)(ws + WS_SWT);
    bf16* QB_ = (bf16*)(ws + WS_Q); bf16* KB_ = (bf16*)(ws + WS_K); bf16* VB_ = (bf16*)(ws + WS_V); bf16* UP = (bf16*)(ws + WS_UP); bf16* VT = (bf16*)(ws + WS_VT); bf16* VTC = (bf16*)(ws + WS_VTC);

#if PROBE == 4
    for (int prep_ = 0; prep_ < 2; ++prep_) {
#else
    {
#endif
#define TRANSPOSE_ITEM(it_) do { int r = (it_); \
        if (r < 8 * I_GU) { const int mi = r / I_GU; r %= I_GU; const int l_ = mi >> 1, f_ = mi & 1; \
            transpose_item(args.in[f_ ? 15 : 6] + (size_t)l_ * 1024 * 5632, 5632, WGU + (size_t)mi * 5632 * 1024, 1024, 1, scr, r / 176, r % 176, lane_); } \
        else if (r < 8 * I_GU + 8 * I_DN) { r -= 8 * I_GU; const int mi = r / I_DN; r %= I_DN; const int l_ = mi >> 1, f_ = mi & 1; \
            transpose_item(args.in[f_ ? 16 : 7] + (size_t)l_ * 2816 * 1024, 1024, WDN + (size_t)mi * 1024 * 2816, 2816, 3, scr, r / 32, r % 32, lane_); } \
        else if (r < 8 * I_GU + 8 * I_DN + 4 * I_IN) { r -= 8 * I_GU + 8 * I_DN; const int l_ = r / I_IN; r %= I_IN; \
            transpose_item(w_in + (size_t)l_ * 1024 * 1280, 1280, WIN + (size_t)l_ * 1536 * 1024, 1024, 2, scr, r / 32, r % 32, lane_); } \
        else { r -= 8 * I_GU + 8 * I_DN + 4 * I_IN; const int l_ = r / I_OUT; r %= I_OUT; \
            transpose_item(w_out + (size_t)l_ * 1024 * 1024, 1024, WOUT + (size_t)l_ * 1024 * 1024, 1024, 3, scr, r / 32, r % 32, lane_); } } while (0)
    {   LAS float* scr = (LAS float*)(L + wave * 16384); const int lane_ = lane;
        for (int k = gw; k < 2 * I_GU + 2 * I_DN + I_IN + I_OUT; k += NGW) {
            const int it = k < 2 * I_GU ? k : k < 2 * I_GU + 2 * I_DN ? 8 * I_GU + (k - 2 * I_GU) : k < 2 * I_GU + 2 * I_DN + I_IN ? 8 * I_GU + 8 * I_DN + (k - 2 * I_GU - 2 * I_DN) : 8 * I_GU + 8 * I_DN + 4 * I_IN + (k - 2 * I_GU - 2 * I_DN - I_IN);
            TRANSPOSE_ITEM(it); }
    }
    __syncthreads();
    LAS float* T2048 = (LAS float*)(L + TAB_OFF); LAS float* T64 = T2048 + 2048;
    for (int i = tid; i < 2048; i += 512) T2048[i] = cospif((float)i * (1.0f / 1024.0f));
    if (tid < 64) T64[tid] = cospif((float)tid * (1.0f / 32.0f));
    __syncthreads();
#define FOLD_CH(idx) do { \
        const int k = idx & 1023; const int hi_ = __builtin_amdgcn_readfirstlane(idx >> 10); const int l = hi_ >> 8, cc = hi_ & 255, g = cc >> 6, cp = cc & 63; \
        const float* src = w_in + ((size_t)l * 1024 + k) * 1280 + 1024 + 64 * g; \
        float ac = 0.f, as = 0.f; \
        _Pragma("unroll 4") \
        for (int c4 = 0; c4 < 16; ++c4) { const f32x4 w = *(const f32x4*)(src + 4 * c4); \
        _Pragma("unroll") \
            for (int e = 0; e < 4; ++e) { const int m = (4 * c4 + e) * cp; ac += w[e] * T64[m & 63]; as += w[e] * T64[(m - 16) & 63]; } } \
        bf16* d = WIN + (size_t)l * 1536 * 1024 + k; \
        d[(size_t)(1024 + cc) * 1024] = (bf16)pg8::f2bf1(ac * 0.125f); d[(size_t)(1280 + cc) * 1024] = (bf16)pg8::f2bf1(as * 0.125f); \
    } while (0)
#define FOLD_POOL(idx) do { \
        const int n = idx & 1023; const int hi_ = __builtin_amdgcn_readfirstlane(idx >> 10); \
        const int l = hi_ >> 5, gc = hi_ & 31, g = gc >> 3, c0 = (gc & 7) * 8; \
        const float* wo = w_out + (size_t)l * 1024 * 1024 + (size_t)(512 + 64 * g) * 1024 + n; \
        const float* ps = pool_scale + l * 256 + 64 * g; const float* pw = pool_w + ((size_t)(l * 4 + g) * 64 + c0) * 64; \
        float a[8]; \
        _Pragma("unroll") \
        for (int i = 0; i < 8; ++i) a[i] = 0.f; \
        for (int d0 = 0; d0 < 64; d0 += 8) { float w[8]; \
        _Pragma("unroll") \
            for (int dd = 0; dd < 8; ++dd) w[dd] = wo[(size_t)(d0 + dd) * 1024]; \
        _Pragma("unroll") \
            for (int dd = 0; dd < 8; ++dd) { const float ww = ps[d0 + dd] * w[dd]; \
        _Pragma("unroll") \
                for (int i = 0; i < 8; ++i) a[i] += pw[i * 64 + d0 + dd] * ww; } } \
        v4u o; o.x = pk2(a[0], a[1]); o.y = pk2(a[2], a[3]); o.z = pk2(a[4], a[5]); o.w = pk2(a[6], a[7]); \
        *(v4u*)(WOUT + (size_t)l * 1024 * 1024 + (size_t)map_row(3, n) * 1024 + 512 + 64 * g + c0) = o; \
    } while (0)
#define FOLD_FFT(idx) do { \
        const int n = idx & 1023; const int hi_ = __builtin_amdgcn_readfirstlane(idx >> 10); \
        const int l = hi_ >> 5, i0 = (hi_ & 31) * 8; \
        const float* wo = w_out + (size_t)l * 1024 * 1024 + (size_t)768 * 1024 + n; \
        const float* fw = fft_w + (size_t)l * 65536 + (size_t)i0 * 256; \
        float a[8]; \
        _Pragma("unroll") \
        for (int i = 0; i < 8; ++i) a[i] = 0.f; \
        for (int j0 = 0; j0 < 256; j0 += 8) { float w[8]; \
        _Pragma("unroll") \
            for (int jj = 0; jj < 8; ++jj) w[jj] = wo[(size_t)(j0 + jj) * 1024]; \
        _Pragma("unroll") \
            for (int i = 0; i < 8; ++i) \
        _Pragma("unroll") \
                for (int jj = 0; jj < 8; ++jj) a[i] += fw[i * 256 + j0 + jj] * w[jj]; } \
        v4u o; o.x = pk2(a[0], a[1]); o.y = pk2(a[2], a[3]); o.z = pk2(a[4], a[5]); o.w = pk2(a[6], a[7]); \
        *(v4u*)(WOUT + (size_t)l * 1024 * 1024 + (size_t)map_row(3, n) * 1024 + 768 + i0) = o; \
    } while (0)
    for (int idx = bx * 512 + fresh_tid(); idx < 262144; idx += NTHR) FOLD_CH(idx);
    for (int idx = bx * 512 + fresh_tid(); idx < 32768; idx += NTHR) FOLD_POOL(idx);
    for (int idx = bx * 512 + fresh_tid(); idx < 32768; idx += NTHR) FOLD_FFT(idx);
    for (int idx = bx * 512 + fresh_tid(); idx < 13 * NROW / 4; idx += NTHR) { ((f32x4*)SSB)[idx] = (f32x4){0.f, 0.f, 0.f, 0.f}; if (idx < 256) ((f32x4*)ZERO)[idx] = (f32x4){0.f, 0.f, 0.f, 0.f}; }
    for (int idx = bx * 512 + fresh_tid(); idx < 65536; idx += NTHR) {
        const int t = idx >> 5, i = idx & 31; const int pos = i < 16 ? (t >> 6) : (t & 63);
        const float inv = powf(10000.0f, -(float)(i & 15) * (1.0f / 16.0f)); const float ang = (float)pos * inv;
        ROPEC[idx] = cosf(ang); ROPES[idx] = sinf(ang);
    }
    for (int idx = bx * 512 + fresh_tid(); idx < 2048 * 256; idx += NTHR) {
        const int kp = idx >> 8, ch = idx & 255; unsigned w[4];
#pragma unroll
        for (int e2 = 0; e2 < 4; ++e2) { unsigned pr[2];
#pragma unroll
            for (int q = 0; q < 2; ++q) { const int np = ch * 8 + e2 * 2 + q; const int m = np <= 1024 ? (kp * np) & 2047 : (kp * (np - 1024) + 512) & 2047; pr[q] = pg8::f2bf1(T2048[m]); }
            w[e2] = pr[0] | (pr[1] << 16); }
        v4u o; o.x = w[0]; o.y = w[1]; o.z = w[2]; o.w = w[3];
        *(v4u*)(ACAT + (size_t)kp * 2048 + ch * 8) = o;
    }
    for (int idx = bx * 512 + fresh_tid(); idx < 256 * 64; idx += NTHR) {
        const int kp = idx >> 6, ch = idx & 63; unsigned w[4];
#pragma unroll
        for (int e2 = 0; e2 < 4; ++e2) { unsigned pr[2];
#pragma unroll
            for (int q = 0; q < 2; ++q) { const int np = ch * 8 + e2 * 2 + q; const int m = np < 256 ? (8 * kp * np) & 2047 : (8 * kp * (np - 256) + 512) & 2047; pr[q] = pg8::f2bf1(T2048[m]); }
            w[e2] = pr[0] | (pr[1] << 16); }
        v4u o; o.x = w[0]; o.y = w[1]; o.z = w[2]; o.w = w[3];
        *(v4u*)(ACATC + (size_t)kp * 512 + ch * 8) = o;
    }
    {
        LAS float* sc = (LAS float*)L;
        for (int task = bx; task < 576; task += G) {
            const int ks = task / 72, cb = task % 72;
            __syncthreads();
            for (int e = tid; e < 128 * 33; e += 512) { const int kk = e / 33, b = e % 33; const int k = ks * 128 + kk;
                const float cv = b < 32 ? c_in[b * 1024 + k] : cctx_in[k]; sc[kk * 36 + b] = cv / (1.0f + expf(-cv)); }
            __syncthreads();
            const int j = cb * 512 + tid; const int l = j / MODW, jj = j % MODW;
            const float* wp = ada_w + ((size_t)l * 1024 + ks * 128) * MODW + jj;
            typedef float f32x2v __attribute__((ext_vector_type(2)));
            f32x2v a2[16]; float a32 = 0.f;
#pragma unroll
            for (int b = 0; b < 16; ++b) a2[b] = (f32x2v){0.f, 0.f};
            for (int k0 = 0; k0 < 128; k0 += 8) { float wv[8];
#pragma unroll
                for (int kq = 0; kq < 8; ++kq) wv[kq] = wp[(size_t)(k0 + kq) * MODW];
#pragma unroll
                for (int kq = 0; kq < 8; ++kq) { const f32x2v w2 = {wv[kq], wv[kq]}; const int kk = k0 + kq;
#pragma unroll
                    for (int q = 0; q < 8; ++q) { const f32x4 s = *(const LAS f32x4*)(sc + kk * 36 + 4 * q); a2[2 * q] += w2 * s.xy; a2[2 * q + 1] += w2 * s.zw; }
                    a32 += wv[kq] * sc[kk * 36 + 32]; } }
            float a[33];
#pragma unroll
            for (int b = 0; b < 16; ++b) { a[2 * b] = a2[b].x; a[2 * b + 1] = a2[b].y; }
            a[32] = a32;
#pragma unroll
            for (int b = 0; b < 33; ++b) MODP[((size_t)ks * 33 + b) * 36864 + j] = a[b];
        }
    }
    grid.sync();

    for (int idx = bx * 512 + fresh_tid(); idx < 33 * 36864; idx += NTHR) {
        const int b = idx / 36864, j = idx % 36864, l = j / MODW, jj = j % MODW;
        float s = ada_b[j];
#pragma unroll
        for (int ks = 0; ks < 8; ++ks) s += MODP[((size_t)ks * 33 + b) * 36864 + j];
        MOD[((size_t)l * 33 + b) * MODW + jj] = s;
        const int which = jj >> 10;
        if (which == 0 || which == 3 || which == 6) SH[((size_t)(l * 3 + which / 3) * 256 + b) * 1024 + (jj & 1023)] = (bf16)pg8::f2bf1(s);
    }
    GSYNC();
    {   pg8::Gemm g{SH, WGU, 12 * 256, 51200, 1024}; pg8::SwOrder S{G, bx, 0}; pg8::EpiSW E{SWT};
        pg8::gemm_phase<pg8::EpiSW, pg8::SwOrder, true, true>(L, g, S, E); }
    {   const int ft = fresh_tid(); const int ln = ft & 63;
        for (int row = vcu * 8 + __builtin_amdgcn_readfirstlane(ft >> 6); row < NROW; row += NGW) {
            const float* xr = row < NLAT ? x_in + (size_t)row * DMODEL : ctx_in + (size_t)(row - NLAT) * DMODEL;
            const int b = row < NLAT ? (row >> 11) : 32; const float* sc = MOD + (size_t)b * MODW + 1024;
            float s = 0.f; const int pmr = row >> 8, rlc = row & 255;
            v2u* o8 = (v2u*)(AB + ((size_t)(pmr * 16 + (ln >> 4)) * 256 + rlc) * 64 + 4 * (ln & 15)); unsigned char* l8 = LOP + ((size_t)(pmr * 4) * 256 + rlc) * 64 + ln;
#pragma unroll
            for (int j = 0; j < 4; ++j) { const f32x4 v = ((const f32x4*)xr)[ln + 64 * j]; s += (v.x * v.x + v.y * v.y) + (v.z * v.z + v.w * v.w);
                const f32x4 o = v * pg8::clamp_m(((const f32x4*)sc)[ln + 64 * j]); v2u w; w.x = pk2(o.x, o.y); w.y = pk2(o.z, o.w); o8[(size_t)j * 4 * 256 * 64 / 4] = w;
                const unsigned b0 = w.x << 16, b1 = w.x & 0xffff0000u, b2 = w.y << 16, b3 = w.y & 0xffff0000u;
                const unsigned w8 = pg8::lo2_enc(o.x, b0) | (pg8::lo2_enc(o.y, b1) << 2) | (pg8::lo2_enc(o.z, b2) << 4) | (pg8::lo2_enc(o.w, b3) << 6);
                l8[(size_t)j * 256 * 64] = (unsigned char)w8; }
            s = wave_sum(s); if (ln == 0) SSB[row] = s;
        }
    }
    GSYNC();

    }
    for (int l = 0; l < 4; ++l) {
        const bool last = (l == 3);
        const float* modl = MOD + (size_t)l * 33 * MODW;
        for (int f = 0; f < 2; ++f) {
            const bool first = (l == 0 && f == 0);
            const int nrows = (last && f == 1) ? NLAT : NROW;
            {   pg8::Gemm g{AB, WGU + (size_t)(l * 2 + f) * 5632 * 1024, nrows, 5632, 1024, 1}; pg8::StaticOrder S; S.init(nrows, 5632, G, bx);
                pg8::EpiGU E{HID, SSB + (size_t)(l * 3 + 2 * f) * NROW, SWT + (size_t)((l * 2 + f) * 22) * 33 * 256};
                { int b2 = blockIdx.x; asm volatile("" : "+s"(b2)); stagger(nrows == NROW ? (b2 < 96 ? 0 : b2 < 192 ? STG_GU : b2 < 224 ? STG_GU / 2 : STG_GU * 3 / 2) : (b2 < 128 ? 0 : STG_GU)); }
                pg8::gemm_phase<pg8::EpiGU, pg8::StaticOrder, true, true>(L, g, S, E);
#if PROBE == 1
                pg8::gemm_phase<pg8::EpiGU, pg8::StaticOrder, true, true>(L, g, S, E);
#endif
            }
            GSYNC();
            {   pg8::Gemm g{HID, WDN + (size_t)(l * 2 + f) * 1024 * 2816, nrows, 1024, 2816, 1}; pg8::StaticOrder S; S.init(nrows, 1024, G, bx);
                const float* dsc = modl + (f == 0 ? 1 : 7) * 1024;
                const float* nsc = f == 0 ? modl + 4 * 1024 : (last ? ZERO : modl + (size_t)33 * MODW + 1 * 1024);
                float* ssn = f == 0 ? SSB + (size_t)(l * 3 + 1) * NROW : SSB + (size_t)((l + 1) * 3) * NROW;
                pg8::EpiRes E{AB, LOP, modl + (f == 0 ? 2 : 8) * 1024, dsc, nsc, ssn, (LAS float*)(L + TAB_OFF), 0.5f, (f == 1 && last) ? 0 : MODW};
                { int b2 = blockIdx.x; asm volatile("" : "+s"(b2)); stagger(b2 < 128 ? 0 : STG_DN); }
                pg8::gemm_phase<pg8::EpiRes, pg8::StaticOrder, true, true>(L, g, S, E);
#if PROBE == 5
                pg8::EpiDummy ED{(float*)(ws + WS_SWT)};
                pg8::gemm_phase<pg8::EpiDummy, pg8::StaticOrder, true, true>(L, g, S, ED);
#endif
            }
            if (!last && bx >= (G >> 1)) {
                const int hb = G >> 1, nW = G - hb;
                const int ftt = fresh_tid(); const int lane_ = ftt & 63; const int wv = __builtin_amdgcn_readfirstlane(ftt >> 6);
                LAS float* scr = (LAS float*)(L + wv * 16384); const int Ln = l + 1;
                if (f == 0) { for (int k = (bx - hb) * 8 + wv; k < 2 * I_GU + I_IN; k += nW * 8) { const int it = k < 2 * I_GU ? Ln * 2 * I_GU + k : 8 * I_GU + 8 * I_DN + Ln * I_IN + (k - 2 * I_GU); TRANSPOSE_ITEM(it); }
                    LAS float* T64 = (LAS float*)(L + TAB_OFF) + 2048; __syncthreads(); if (ftt < 64) T64[ftt] = cospif((float)ftt * (1.0f / 32.0f)); __syncthreads();
                    for (int idx = Ln * 262144 + (bx - hb) * 512 + ftt; idx < (Ln + 1) * 262144; idx += nW * 512) FOLD_CH(idx); }
                else { for (int idx = Ln * 32768 + (bx - hb) * 512 + ftt; idx < (Ln + 1) * 32768; idx += nW * 512) { FOLD_POOL(idx); FOLD_FFT(idx); }
                    for (int k = (bx - hb) * 8 + wv; k < 2 * I_DN + I_OUT; k += nW * 8) { const int it = k < 2 * I_DN ? 8 * I_GU + Ln * 2 * I_DN + k : 8 * I_GU + 8 * I_DN + 4 * I_IN + Ln * I_OUT + (k - 2 * I_DN); TRANSPOSE_ITEM(it); }
                    __syncthreads();
                    pg8::Gemm g2{SH, WGU, 12 * 256, 51200, 1024}; pg8::SwOrder S2{nW, bx - hb, Ln}; pg8::EpiSW E2{SWT};
                    pg8::gemm_phase<pg8::EpiSW, pg8::SwOrder, true, true>(L, g2, S2, E2); }
            }
            GSYNC();
            if (f == 0) {
                {   pg8::Gemm g{AB, WIN + (size_t)l * 1536 * 1024, NROW, 1536, 1024, 1}; pg8::StaticOrder S; S.init(NROW, 1536, G, bx);
                    pg8::EpiIN E{QB_, KB_, VB_, UP, VT, VTC, q_gain + l * 64, k_gain + l * 64, ROPEC, ROPES, SSB + (size_t)(l * 3 + 1) * NROW, SWT + (size_t)(176 + l * 6) * 33 * 256};
                    pg8::gemm_phase<pg8::EpiIN, pg8::StaticOrder, true, true>(L, g, S, E);
#if PROBE == 3
                    pg8::gemm_phase<pg8::EpiIN, pg8::StaticOrder, true, true>(L, g, S, E);
#endif
                }
                GSYNC();
#if PROBE == 2
                for (int rep_ = 0; rep_ < 2; ++rep_) {
#else
                {
#endif
                {
                    bf16* VTF = (bf16*)(ws + WS_VTF);
                    for (int idx = bx * 512 + fresh_tid(); idx < 8192 * 256; idx += NTHR) {
                        const int row = idx >> 8, ch = idx & 255, n0 = ch * 8, nn = n0 & 1023; const bf16* v1 = VT + (size_t)row * 4096; const bf16* vb = ch < 128 ? v1 : v1 + 2048; const float sg = ch < 128 ? 1.0f : -1.0f;
                        const v4u F = *(const v4u*)(vb + nn), Gm = *(const v4u*)(vb + 2040 - nn); float o[8];
                        const unsigned fw[4] = {F.x, F.y, F.z, F.w}, gw_[4] = {Gm.x, Gm.y, Gm.z, Gm.w};
#pragma unroll
                        for (int e = 1; e < 8; ++e) { const unsigned fwv = fw[e >> 1], gwv = gw_[(8 - e) >> 1];
                            const float a = __uint_as_float((e & 1) ? (fwv & 0xffff0000u) : (fwv << 16)), bm = __uint_as_float(((8 - e) & 1) ? (gwv & 0xffff0000u) : (gwv << 16)); o[e] = a + sg * bm; }
                        if (nn > 0) o[0] = __uint_as_float(F.x << 16) + sg * __uint_as_float((unsigned)vb[2048 - nn] << 16);
                        else o[0] = __uint_as_float((unsigned)v1[ch == 0 ? 0 : 1024] << 16);
                        v4u w; w.x = pk2(o[0], o[1]); w.y = pk2(o[2], o[3]); w.z = pk2(o[4], o[5]); w.w = pk2(o[6], o[7]);
                        *(v4u*)(VTF + (size_t)row * 2048 + n0) = w; }
                }
                GSYNC();
                for (int v = vcu; v < 256; v += G) {
                    const int p = v >> 2, s = v & 3, b = p >> 1, kvh = p & 1, h = 4 * kvh + s;
                    const attn_body::bf16* Kh = (const attn_body::bf16*)KB_ + (size_t)b * KVROWS * 128 + kvh * 64;
                    const attn_body::bf16* Vh = (const attn_body::bf16*)VB_ + (size_t)b * KVROWS * 128 + kvh * 64;
                    for (int qb = 0; qb < 8; ++qb) { const size_t r0 = (size_t)b * 2048 + qb * 256;
                        attn_body::attn_unit<8>((const attn_body::bf16*)QB_ + r0 * 512 + h * 64, Kh, Vh, (attn_body::bf16*)AB2 + r0 * 1024 + h * 64, 36, (char*)lds); }
                    if (!last) { const int cb = v >> 3, ch = v & 7; const size_t r0 = (size_t)NLAT + cb * 256;
                        const attn_body::bf16* Kc = (const attn_body::bf16*)KB_ + ((size_t)cb * KVROWS + 2048) * 128 + (ch >> 2) * 64;
                        const attn_body::bf16* Vc = (const attn_body::bf16*)VB_ + ((size_t)cb * KVROWS + 2048) * 128 + (ch >> 2) * 64;
                        attn_body::attn_unit<8>((const attn_body::bf16*)QB_ + r0 * 512 + ch * 64, Kc, Vc, (attn_body::bf16*)AB2 + r0 * 1024 + ch * 64, 4, (char*)lds); }
                }
                {   const int prow = last ? NLAT : NROW;
                    const int pskip = (!last && G > 64) ? 32 : 0;
                    for (int idx = (bx < pskip ? prow * 32 : (bx - pskip) * 512 + fresh_tid()); idx < prow * 32; idx += (G - pskip) * 512) {
                        const int p8 = prow * 8; const int g = __builtin_amdgcn_readfirstlane((idx >= p8) + (idx >= 2 * p8) + (idx >= 3 * p8)); const int rem = idx - g * p8; const int row = rem >> 3, c0 = g * 64 + (rem & 7) * 8, w2 = 1 << g, w = 2 << g;
                        int Ls, t; if (row < NLAT) { Ls = 2048; t = row & 2047; } else { Ls = 256; t = row & 255; }
                        const int base = row - t; const int lo = max(t - w2, 0), hi = min(t + w - w2, Ls);
                        float s[8];
#pragma unroll
                        for (int i = 0; i < 8; ++i) s[i] = 0.f;
                        v4u wq[16]; float wt[16];
#pragma unroll
                        for (int j = 0; j < 16; ++j) { wt[j] = 0.f; wq[j] = (v4u){0u, 0u, 0u, 0u}; if (j < w) { const int pos = t - w2 + j; const bool ok = pos >= 0 && pos < Ls; wt[j] = ok ? 1.0f : 0.0f; wq[j] = *(const v4u*)(UP + (size_t)(base + (ok ? pos : t)) * 256 + c0); } }
#pragma unroll
                        for (int j = 0; j < 16; ++j) if (j < w) { const v4u q = wq[j]; const float wj = wt[j];
                            s[0] += wj * __uint_as_float(q.x << 16); s[1] += wj * __uint_as_float(q.x & 0xffff0000u); s[2] += wj * __uint_as_float(q.y << 16); s[3] += wj * __uint_as_float(q.y & 0xffff0000u);
                            s[4] += wj * __uint_as_float(q.z << 16); s[5] += wj * __uint_as_float(q.z & 0xffff0000u); s[6] += wj * __uint_as_float(q.w << 16); s[7] += wj * __uint_as_float(q.w & 0xffff0000u); }
                        const v4u q = *(const v4u*)(UP + (size_t)row * 256 + c0); const float ic = 1.0f / (float)(hi - lo);
                        v4u o;
                        o.x = pk2(s[0] * ic - __uint_as_float(q.x << 16), s[1] * ic - __uint_as_float(q.x & 0xffff0000u));
                        o.y = pk2(s[2] * ic - __uint_as_float(q.y << 16), s[3] * ic - __uint_as_float(q.y & 0xffff0000u));
                        o.z = pk2(s[4] * ic - __uint_as_float(q.z << 16), s[5] * ic - __uint_as_float(q.z & 0xffff0000u));
                        o.w = pk2(s[6] * ic - __uint_as_float(q.w << 16), s[7] * ic - __uint_as_float(q.w & 0xffff0000u));
                        *(v4u*)(AB2 + (size_t)row * 1024 + 512 + c0) = o;
                    }
                }
                {   pg8::Gemm g{ACAT, (const bf16*)(ws + WS_VTF), 2048, 8192, 2048}; pg8::StaticOrder S; S.init(2048, 8192, G, bx);
                    pg8::EpiDFT E{AB2, 0, 2048, 0.022097086912079608f};
                    pg8::gemm_phase<pg8::EpiDFT, pg8::StaticOrder, true, true>(L, g, S, E); }
                if (!last) { pg8::Gemm g{ACATC, VTC, 256, 8192, 512}; pg8::StaticOrder S; S.init(256, 8192, G, bx);
                    pg8::EpiDFT E{AB2, NLAT, 256, 0.0625f};
                    pg8::gemm_phase<pg8::EpiDFT, pg8::StaticOrder, true, true>(L, g, S, E); }
                }
                GSYNC();
                {   const int mrows = last ? NLAT : NROW;
                    pg8::Gemm g{AB2, WOUT + (size_t)l * 1024 * 1024, mrows, 1024, 1024}; pg8::StaticOrder S; S.init(mrows, 1024, G, bx);
                    pg8::EpiRes E{AB, LOP, modl + 5 * 1024, modl + 4 * 1024, modl + 7 * 1024, SSB + (size_t)(l * 3 + 2) * NROW, (LAS float*)(L + TAB_OFF), 1.0f, MODW};
                    { int b2 = blockIdx.x; asm volatile("" : "+s"(b2)); stagger(b2 < 128 ? 0 : STG_OUT); }
                    pg8::gemm_phase<pg8::EpiRes, pg8::StaticOrder, true, true>(L, g, S, E); }
                GSYNC();
            }
        }
    }
    const int ftf = fresh_tid(); const int lanef = ftf & 63;
    for (int row = vcu * 8 + __builtin_amdgcn_readfirstlane(ftf >> 6); row < NLAT; row += NGW) {
        const int pmr = row >> 8, rlc = row & 255;
        const v2u* hp = (const v2u*)(AB + ((size_t)(pmr * 16 + (lanef >> 4)) * 256 + rlc) * 64 + 4 * (lanef & 15)); const unsigned char* lp = LOP + ((size_t)(pmr * 4) * 256 + rlc) * 64 + lanef;
        f32x4 v[4]; float s = 0.f;
#pragma unroll
        for (int j = 0; j < 4; ++j) { const v2u h = hp[(size_t)j * 4 * 256 * 64 / 4]; const unsigned q = lp[(size_t)j * 256 * 64];
            const unsigned b0 = h.x << 16, b1 = h.x & 0xffff0000u, b2 = h.y << 16, b3 = h.y & 0xffff0000u;
            v[j].x = pg8::lo2_dec(b0, q & 0x3u); v[j].y = pg8::lo2_dec(b1, (q >> 2) & 0x3u); v[j].z = pg8::lo2_dec(b2, (q >> 4) & 0x3u); v[j].w = pg8::lo2_dec(b3, (q >> 6) & 0x3u);
            s += (v[j].x * v[j].x + v[j].y * v[j].y) + (v[j].z * v[j].z + v[j].w * v[j].w); }
        const float rstd = 1.0f / sqrtf(wave_sum(s) * (1.0f / DMODEL) + 1e-6f);
        f32x4* xr = (f32x4*)(args.out + (size_t)row * DMODEL);
#pragma unroll
        for (int j = 0; j < 4; ++j) { const f32x4 gv = ((const f32x4*)final_gain)[lanef + 64 * j]; xr[lanef + 64 * j] = v[j] * rstd * gv; }
    }
}

extern "C" void kernel_launch(void* const* d_in, const int* in_sizes, int n_in, void* d_out, int out_size, void* d_ws, size_t ws_size, hipStream_t stream) {
    static int grid = 0;
    if (grid == 0) {
        if (n_in != 18 || out_size != NLAT * DMODEL || ws_size < WS_END) { fprintf(stderr, "kernel_launch: unexpected shapes (n_in %d, out %d, ws %zu)\n", n_in, out_size, ws_size); grid = -1; return; }
        int dev = 0, cus = 0, per_cu = 0;
        hipGetDevice(&dev); hipDeviceGetAttribute(&cus, hipDeviceAttributeMultiprocessorCount, dev);
        hipFuncSetAttribute((const void*)fwd_mega, hipFuncAttributeMaxDynamicSharedMemorySize, LDS_BYTES);
        if (hipOccupancyMaxActiveBlocksPerMultiprocessor(&per_cu, (const void*)fwd_mega, 512, LDS_BYTES) != hipSuccess || per_cu < 1) { fprintf(stderr, "kernel_launch: occupancy query says %d\n", per_cu); per_cu = 1; }
        (void)hipGetLastError();
        grid = cus * (per_cu > 1 ? 1 : per_cu);
        if (grid <= 0) grid = 256;
    }
    if (grid < 0) return;
    if (hipMemsetAsync((char*)d_ws + WS_BAR, 0, 16384, stream) != hipSuccess) { fprintf(stderr, "kernel_launch: memset of the barrier words failed\n"); return; }
    Args a{};
    for (int i = 0; i < 18; ++i) a.in[i] = (const float*)d_in[i];
    a.out = (float*)d_out; a.ws = (unsigned char*)d_ws;
    void* params[] = {&a};
    hipError_t e = hipLaunchCooperativeKernel((const void*)fwd_mega, dim3(grid), dim3(512), params, LDS_BYTES, stream);
    if (e != hipSuccess) fprintf(stderr, "cooperative launch failed: %s (grid %d)\n", hipGetErrorString(e), grid);
}
```
